# Optimizing an MI355X kernel written in HIP

```python
import jax, jax.numpy as jnp
from jax import lax
import numpy as np

D_MODEL = 1024
BATCH = 4
SEQ = 4096
DEPTH = 2

CHUNK = 64
N_EVEN = (DEPTH + 1) // 2
N_ODD = DEPTH // 2
EPS = 1e-6
ROPE_THETA = 10000.0

GM_GROUPS = 4
GM_GROUP_DIM = 128
GM_WIDTH = GM_GROUPS * GM_GROUP_DIM
GM_BLOCK = 128
MLA_HEADS = 8
MLA_Q_RANK = 384
MLA_KV_RANK = 256
MLA_NOPE = 64
MLA_ROPE = 32
MLA_V = 64
MLA_QK = MLA_NOPE + MLA_ROPE
ATTN_BLOCK = 128
EVEN_IN = 2 * GM_WIDTH + MLA_Q_RANK + MLA_KV_RANK + MLA_ROPE
EVEN_MIX = GM_WIDTH + MLA_HEADS * MLA_V
RET_HEADS = 4
RET_QK = 256
RET_V = 512
ODD_IN = 2 * RET_HEADS * RET_QK + 2 * RET_HEADS * RET_V
ODD_MIX = RET_HEADS * RET_V
D_FF = -(-8 * D_MODEL // (3 * 256)) * 256

kernel_name = "hybrid_gmlp_mla_retention_trunk"


def rmsnorm(x, g):
    xf = x.astype(jnp.float32)
    y = xf * lax.rsqrt(jnp.mean(xf * xf, axis=-1, keepdims=True) + EPS)
    return (y * g.astype(jnp.float32)).astype(x.dtype)


def rope(x, pos):
    half = x.shape[-1] // 2
    inv = ROPE_THETA ** (-jnp.arange(half, dtype=jnp.float32) / half)
    ang = pos.astype(jnp.float32)[:, None] * inv[None, :]
    cos = jnp.cos(ang)[None, :, None, :]
    sin = jnp.sin(ang)[None, :, None, :]
    xf = x.astype(jnp.float32)
    x1, x2 = xf[..., :half], xf[..., half:]
    return jnp.concatenate([x1 * cos - x2 * sin, x2 * cos + x1 * sin], axis=-1).astype(x.dtype)


def spatial_gating(u, v, v_norm, w_s, b_s):
    B, S, _ = u.shape
    n = S // GM_BLOCK
    v = rmsnorm(v.reshape(B, S, GM_GROUPS, GM_GROUP_DIM), v_norm)
    cid = jnp.arange(GM_BLOCK) // CHUNK
    w = jnp.where((cid[None, :] <= cid[:, None])[None], w_s, 0)
    vb = v.reshape(B, n, GM_BLOCK, GM_GROUPS, GM_GROUP_DIM)
    s = jnp.einsum('gts,bnsgc->bntgc', w, vb) + b_s.T[:, :, None]
    ub = u.reshape(B, n, GM_BLOCK, GM_GROUPS, GM_GROUP_DIM)
    return (ub * s).reshape(B, S, GM_WIDTH)


def block_causal_attention(q, k, v):
    S = q.shape[1]
    scale = MLA_QK ** -0.5
    chunk_id = jnp.arange(S) // CHUNK
    outs = []
    for start in range(0, S, ATTN_BLOCK):
        end = start + ATTN_BLOCK
        s = jnp.einsum('bqhd,bkhd->bhqk', q[:, start:end], k[:, :end]).astype(jnp.float32) * scale
        mask = chunk_id[None, :end] <= chunk_id[start:end, None]
        p = jax.nn.softmax(jnp.where(mask, s, -jnp.inf), axis=-1).astype(v.dtype)
        outs.append(jnp.einsum('bhqk,bkhd->bqhd', p, v[:, :end]))
    return jnp.concatenate(outs, axis=1)


def mla(c_q, c_kv, k_pe, q_a_norm, w_uq, kv_a_norm, w_ukv, q_norm, k_norm, pos):
    B, S, _ = c_q.shape
    q = (rmsnorm(c_q, q_a_norm) @ w_uq).reshape(B, S, MLA_HEADS, MLA_QK)
    kv = (rmsnorm(c_kv, kv_a_norm) @ w_ukv).reshape(B, S, MLA_HEADS, MLA_NOPE + MLA_V)
    k = jnp.concatenate([kv[..., :MLA_NOPE],
                         jnp.broadcast_to(k_pe[:, :, None, :], (B, S, MLA_HEADS, MLA_ROPE))], axis=-1)
    v = kv[..., MLA_NOPE:]
    q = rmsnorm(q, q_norm)
    k = rmsnorm(k, k_norm)
    q = jnp.concatenate([q[..., :MLA_NOPE], rope(q[..., MLA_NOPE:], pos)], axis=-1)
    k = jnp.concatenate([k[..., :MLA_NOPE], rope(k[..., MLA_NOPE:], pos)], axis=-1)
    o = block_causal_attention(q, k, v)
    return o.reshape(B, S, MLA_HEADS * MLA_V)


def even_mixer(h, w_in, gm_v_norm, gm_w_s, gm_b_s, q_a_norm, w_uq, kv_a_norm, w_ukv,
               q_norm, k_norm, w_out, pos):
    z = h @ w_in
    o1 = GM_WIDTH
    o2 = 2 * GM_WIDTH
    o3 = o2 + MLA_Q_RANK
    o4 = o3 + MLA_KV_RANK
    u = jax.nn.gelu(z[..., :o1])
    v = jax.nn.gelu(z[..., o1:o2])
    a = spatial_gating(u, v, gm_v_norm, gm_w_s, gm_b_s)
    b = mla(z[..., o2:o3], z[..., o3:o4], z[..., o4:], q_a_norm, w_uq, kv_a_norm, w_ukv,
            q_norm, k_norm, pos)
    return jnp.concatenate([a, b], axis=-1) @ w_out


def retention(q, k, v):
    B, S, H, dk = q.shape
    dv = v.shape[-1]
    n = S // CHUNK
    lg = jnp.log(1.0 - 2.0 ** (-5.0 - jnp.arange(H, dtype=jnp.float32)))
    j = jnp.arange(CHUNK, dtype=jnp.float32)
    diff = j[:, None] - j[None, :]
    dmask = jnp.where(diff >= 0, jnp.exp(lg[:, None, None] * jnp.maximum(diff, 0.0)), 0.0)
    xi = jnp.exp(lg[:, None] * (j + 1.0))[None, :, :, None]
    zeta = jnp.exp(lg[:, None] * (CHUNK - 1.0 - j))[None, :, :, None]
    g_chunk = jnp.exp(lg * CHUNK)[None, :, None, None]

    def to_chunks(t):
        return t.astype(jnp.float32).reshape(B, n, CHUNK, H, -1).transpose(1, 0, 3, 2, 4)

    qc = to_chunks(q)
    kc = to_chunks(k) * (dk ** -0.5)
    vc = to_chunks(v)

    def step(state, inp):
        qi, ki, vi = inp
        a = jnp.einsum('bhjd,bhmd->bhjm', qi, ki) * dmask
        o = jnp.einsum('bhjm,bhme->bhje', a, vi) + jnp.einsum('bhjd,bhde->bhje', qi, state) * xi
        state = state * g_chunk + jnp.einsum('bhmd,bhme->bhde', ki * zeta, vi)
        return state, o

    state0 = jnp.zeros((B, H, dk, dv), jnp.float32)
    _, o = lax.scan(step, state0, (qc, kc, vc))
    return o.transpose(1, 0, 3, 2, 4).reshape(B, S, H, dv)


def odd_mixer(h, w_in, out_norm, w_out, pos):
    B, S, _ = h.shape
    nq = RET_HEADS * RET_QK
    nv = RET_HEADS * RET_V
    z = h @ w_in
    q = rope(z[..., :nq].reshape(B, S, RET_HEADS, RET_QK), pos)
    k = rope(z[..., nq:2 * nq].reshape(B, S, RET_HEADS, RET_QK), pos)
    v = z[..., 2 * nq:2 * nq + nv].reshape(B, S, RET_HEADS, RET_V)
    g = z[..., 2 * nq + nv:]
    o = rmsnorm(retention(q, k, v), out_norm)
    o = o.reshape(B, S, nv).astype(h.dtype) * jax.nn.silu(g)
    return o @ w_out


def swiglu(h, w_gate, w_up, w_down):
    return (jax.nn.silu(h @ w_gate) * (h @ w_up)) @ w_down


def setup_inputs(seed: int = 0) -> dict:
    key = jax.random.key(seed)
    ks = jax.random.split(key, 24)
    f32 = jnp.float32

    def w(k, shape, fan_in):
        return jax.random.normal(k, shape, f32) * (fan_in ** -0.5)

    def gain(k, shape):
        return 1.0 + 0.1 * jax.random.normal(k, shape, f32)

    return {
        "x": jax.random.normal(ks[0], (BATCH, SEQ, D_MODEL), f32),
        "norm_mix": gain(ks[1], (DEPTH, D_MODEL)),
        "norm_ffn": gain(ks[2], (DEPTH, D_MODEL)),
        "even_w_in": w(ks[3], (N_EVEN, D_MODEL, EVEN_IN), D_MODEL),
        "gm_v_norm": gain(ks[4], (N_EVEN, GM_GROUPS, GM_GROUP_DIM)),
        "gm_w_s": w(ks[5], (N_EVEN, GM_GROUPS, GM_BLOCK, GM_BLOCK), GM_BLOCK),
        "gm_b_s": gain(ks[6], (N_EVEN, GM_GROUPS, GM_BLOCK)),
        "mla_q_a_norm": gain(ks[7], (N_EVEN, MLA_Q_RANK)),
        "mla_w_uq": w(ks[8], (N_EVEN, MLA_Q_RANK, MLA_HEADS * MLA_QK), MLA_Q_RANK),
        "mla_kv_a_norm": gain(ks[9], (N_EVEN, MLA_KV_RANK)),
        "mla_w_ukv": w(ks[10], (N_EVEN, MLA_KV_RANK, MLA_HEADS * (MLA_NOPE + MLA_V)), MLA_KV_RANK),
        "mla_q_norm": gain(ks[11], (N_EVEN, MLA_QK)),
        "mla_k_norm": gain(ks[12], (N_EVEN, MLA_QK)),
        "even_w_out": w(ks[13], (N_EVEN, EVEN_MIX, D_MODEL), EVEN_MIX),
        "odd_w_in": w(ks[14], (N_ODD, D_MODEL, ODD_IN), D_MODEL),
        "ret_out_norm": gain(ks[15], (N_ODD, RET_HEADS, RET_V)),
        "odd_w_out": w(ks[16], (N_ODD, ODD_MIX, D_MODEL), ODD_MIX),
        "ffn_w_gate": w(ks[17], (DEPTH, D_MODEL, D_FF), D_MODEL),
        "ffn_w_up": w(ks[18], (DEPTH, D_MODEL, D_FF), D_MODEL),
        "ffn_w_down": w(ks[19], (DEPTH, D_FF, D_MODEL), D_FF),
    }


def reference(x, norm_mix, norm_ffn, even_w_in, gm_v_norm, gm_w_s, gm_b_s,
              mla_q_a_norm, mla_w_uq, mla_kv_a_norm, mla_w_ukv, mla_q_norm, mla_k_norm,
              even_w_out, odd_w_in, ret_out_norm, odd_w_out,
              ffn_w_gate, ffn_w_up, ffn_w_down):
    pos = jnp.arange(x.shape[1])
    for l in range(DEPTH):
        i = l // 2
        h = rmsnorm(x, norm_mix[l])
        if l % 2 == 0:
            mix = even_mixer(h, even_w_in[i], gm_v_norm[i], gm_w_s[i], gm_b_s[i],
                             mla_q_a_norm[i], mla_w_uq[i], mla_kv_a_norm[i], mla_w_ukv[i],
                             mla_q_norm[i], mla_k_norm[i], even_w_out[i], pos)
        else:
            mix = odd_mixer(h, odd_w_in[i], ret_out_norm[i], odd_w_out[i], pos)
        x = x + mix
        h = rmsnorm(x, norm_ffn[l])
        x = x + swiglu(h, ffn_w_gate[l], ffn_w_up[l], ffn_w_down[l])
    return x
```

```cpp
#include <hip/hip_runtime.h>
#include <hip/hip_cooperative_groups.h>
#include <cstdio>
#include <cstdint>
namespace cg = cooperative_groups;

constexpr int BATCH = 4, SEQ = 4096, DM = 1024, M_ = BATCH * SEQ;
constexpr int CHUNK = 64;
constexpr float EPS = 1e-6f;
constexpr int GM_G = 4, GM_D = 128, GM_W = 512, GM_BLK = 128;
constexpr int MH = 8, MQR = 384, MKVR = 256, MNOPE = 64, MROPE = 32, MV = 64, MQK = 96;
constexpr int EVEN_IN = 1696, ZLD = 1792;
constexpr int RH = 4, RQK = 256, RV = 512, ODD_IN = 6144;
constexpr int DFF = 2816;
constexpr int ZO_U = 0, ZO_V = 512, ZO_CQ = 1024, ZO_CKV = 1408, ZO_KPE = 1664;

typedef unsigned short bf16_t;
typedef short bf16x8 __attribute__((ext_vector_type(8)));
typedef float f32x4 __attribute__((ext_vector_type(4)));
typedef float f32x16 __attribute__((ext_vector_type(16)));
typedef unsigned u32x4 __attribute__((ext_vector_type(4)));
typedef unsigned u32x2 __attribute__((ext_vector_type(2)));

__device__ __forceinline__ float bf2f(bf16_t v) { return __uint_as_float(((unsigned)v) << 16); }
__device__ __forceinline__ bf16_t f2bf(float f) { unsigned u = __float_as_uint(f); return (bf16_t)((u + 0x7fffu + ((u >> 16) & 1u)) >> 16); }
__device__ __forceinline__ unsigned pk2(float lo, float hi) { return (unsigned)f2bf(lo) | ((unsigned)f2bf(hi) << 16); }
__device__ __forceinline__ float gelu_tanh(float x) {
    const float u = 0.7978845608028654f * (x + 0.044715f * x * x * x);
    return x / (1.f + __expf(-2.f * u));
}
__device__ __forceinline__ float silu_f(float x) { return x / (1.f + __expf(-x)); }
__device__ __forceinline__ float wave_sum(float v) {
#pragma unroll
    for (int o = 1; o < 64; o <<= 1) v += __shfl_xor(v, o);
    return v;
}

constexpr size_t MiB = 1u << 20;
constexpr size_t WS_CTL = 0;
constexpr size_t WS_SS = 1 * MiB;
constexpr size_t ZERO_BYTES = 2 * MiB;
constexpr size_t WS_RS0 = 2 * MiB;
constexpr size_t WS_COSM = 2 * MiB + 256 * 1024;
constexpr size_t WS_SINM = 2 * MiB + 512 * 1024;
constexpr size_t WS_COSR = 3 * MiB;
constexpr size_t WS_SINR = 5 * MiB;
constexpr size_t WS_WSP = 7 * MiB;
constexpr size_t WS_W = 8 * MiB;
constexpr size_t WS_XB = 64 * MiB;
constexpr size_t WS_ARENA = 96 * MiB;
constexpr size_t WS_ZB = 96 * MiB;
constexpr size_t WS_QRAW = 152 * MiB;
constexpr size_t WS_KVRAW = 176 * MiB;
constexpr size_t WS_MIX = 208 * MiB;
constexpr size_t WS_ACT = 96 * MiB;
constexpr size_t WS_QP = 96 * MiB;
constexpr size_t WS_KPP = 128 * MiB;
constexpr size_t WS_VO = 160 * MiB;
constexpr size_t WS_AMAT = 224 * MiB;
constexpr size_t WS_END = 256 * MiB;

struct Ptrs {
    const float* in[20];
    float* out;
    unsigned char* ws;
};
#define IN_X 0
#define IN_NORM_MIX 1
#define IN_NORM_FFN 2
#define IN_EVEN_W_IN 3
#define IN_GM_V_NORM 4
#define IN_GM_W_S 5
#define IN_GM_B_S 6
#define IN_Q_A_NORM 7
#define IN_W_UQ 8
#define IN_KV_A_NORM 9
#define IN_W_UKV 10
#define IN_Q_NORM 11
#define IN_K_NORM 12
#define IN_EVEN_W_OUT 13
#define IN_ODD_W_IN 14
#define IN_RET_OUT_NORM 15
#define IN_ODD_W_OUT 16
#define IN_FFN_GATE 17
#define IN_FFN_UP 18
#define IN_FFN_DOWN 19

__device__ __forceinline__ float* ws_f32(const Ptrs& p, size_t off) { return (float*)(p.ws + off); }
__device__ __forceinline__ bf16_t* ws_bf(const Ptrs& p, size_t off) { return (bf16_t*)(p.ws + off); }
namespace nv {

__global__ __launch_bounds__(256) void k_xprep(Ptrs p) {
    const int lane = threadIdx.x & 63, w = threadIdx.x >> 6;
    const int row = blockIdx.x * 4 + w;
    const float* xr = p.in[IN_X] + (size_t)row * DM;
    bf16_t* xb = ws_bf(p, WS_XB) + (size_t)row * DM;
    float s = 0.f;
    for (int j = 0; j < 4; ++j) {
        const f32x4 v = *(const f32x4*)(xr + j * 256 + lane * 4);
        s += v.x * v.x + v.y * v.y + v.z * v.z + v.w * v.w;
        u32x2 o; o.x = pk2(v.x, v.y); o.y = pk2(v.z, v.w);
        *(u32x2*)(xb + j * 256 + lane * 4) = o;
    }
    s = wave_sum(s);
    if (lane == 0) ws_f32(p, WS_RS0)[row] = rsqrtf(s * (1.f / DM) + EPS);
}
__device__ __forceinline__ void rope_entry(int pos, int i, int half, float& c, float& s) {
    const double inv = exp(-(double)i / (double)half * 9.210340371976184  );
    double a = (double)pos * inv;
    const double twopi = 6.283185307179586476925;
    a -= twopi * rint(a / twopi);
    c = cosf((float)a); s = sinf((float)a);
}
__global__ __launch_bounds__(256) void k_tables(Ptrs p) {
    const int idx = blockIdx.x * 256 + threadIdx.x;
    if (idx < SEQ * 128) { const int pos = idx >> 7, i = idx & 127; float c, s; rope_entry(pos, i, 128, c, s); ws_f32(p, WS_COSR)[idx] = c; ws_f32(p, WS_SINR)[idx] = s; }
    if (idx < SEQ * 16) { const int pos = idx >> 4, i = idx & 15; float c, s; rope_entry(pos, i, 16, c, s); ws_f32(p, WS_COSM)[idx] = c; ws_f32(p, WS_SINM)[idx] = s; }
}

template <class BF, class EPI, bool PAIR>
__global__ __launch_bounds__(256) void ngemm(const bf16_t* A, int lda, int K, BF bf, EPI epi) {
    const int lane = threadIdx.x & 63, w = threadIdx.x >> 6;
    const int row0 = (blockIdx.y * 4 + w) * 32, n0 = blockIdx.x * 32;
    const int i = lane & 31, kk = lane >> 5;
    f32x16 acc0 = {}, acc1 = {};
    const bf16_t* ap = A + (size_t)(row0 + i) * lda;
    for (int k = 0; k < K; k += 8) {
        const bf16x8 av = *(const bf16x8*)(ap + k);
#pragma unroll
        for (int s = 0; s < 4; ++s) {
            const float a = bf2f((bf16_t)(kk ? av[2 * s + 1] : av[2 * s]));
            const int kx = k + 2 * s + kk;
            acc0 = __builtin_amdgcn_mfma_f32_32x32x2f32(a, bf.f0(kx, n0 + i), acc0, 0, 0, 0);
            if (PAIR) acc1 = __builtin_amdgcn_mfma_f32_32x32x2f32(a, bf.f1(kx, n0 + i), acc1, 0, 0, 0);
        }
    }
#pragma unroll
    for (int r = 0; r < 16; ++r) { const int row = row0 + (r & 3) + 8 * (r >> 2) + 4 * kk; epi(row, n0 + i, acc0[r], acc1[r]); }
}
struct BfPlain { const float* W; int ldw; int pad; const float* gain;
    __device__ __forceinline__ float f0(int k, int n) const { const float w = W[(size_t)k * ldw + n]; return gain ? gain[k] * w : w; }
    __device__ __forceinline__ float f1(int k, int n) const { return 0.f; } };
struct BfPair { const float* W0; const float* W1; int ldw; int pad; const float* gain;
    __device__ __forceinline__ float f0(int k, int n) const { return gain[k] * W0[(size_t)k * ldw + n]; }
    __device__ __forceinline__ float f1(int k, int n) const { return gain[k] * W1[(size_t)k * ldw + n]; } };
struct BfRope { const float* W; const float* gain;
    __device__ __forceinline__ float f0(int k, int pidx) const { return gain[k] * W[(size_t)k * ODD_IN + (pidx >> 7) * 256 + (pidx & 127)]; }
    __device__ __forceinline__ float f1(int k, int pidx) const { return gain[k] * W[(size_t)k * ODD_IN + (pidx >> 7) * 256 + (pidx & 127) + 128]; } };

struct EpiZ0 { bf16_t* zb; const float* rs0;
    __device__ __forceinline__ void operator()(int row, int n, float a0, float) const { float v = rs0[row] * a0; if (n < 1024) v = gelu_tanh(v); zb[(size_t)row * ZLD + n] = f2bf(v); } };
struct EpiStore { bf16_t* O; int ldo; int pad;
    __device__ __forceinline__ void operator()(int row, int n, float a0, float) const { O[(size_t)row * ldo + n] = f2bf(a0); } };
struct EpiResid { const float* base; float* out; bf16_t* xb;
    __device__ __forceinline__ void operator()(int row, int n, float a0, float) const { const float v = base[(size_t)row * DM + n] + a0; out[(size_t)row * DM + n] = v; xb[(size_t)row * DM + n] = f2bf(v); } };
struct EpiSwiglu { bf16_t* act; const float* ss;
    __device__ __forceinline__ void operator()(int row, int n, float a0, float a1) const { const float rs = rsqrtf(ss[row] * (1.f / DM) + EPS); act[(size_t)row * DFF + n] = f2bf(silu_f(rs * a0) * (rs * a1)); } };
struct EpiRopeQK { bf16_t* qp; bf16_t* kpp; const float* ss; const float* cosr; const float* sinr;
    __device__ __forceinline__ void operator()(int row, int pidx, float a0, float a1) const {
        const float rs = rsqrtf(ss[row] * (1.f / DM) + EPS); const float x1 = rs * a0, x2 = rs * a1;
        const int hh = pidx >> 7, i = pidx & 127, h = hh & 3, pos = row & (SEQ - 1), j = row & 63;
        const float c = cosr[pos * 128 + i], s = sinr[pos * 128 + i];
        const float y1 = x1 * c - x2 * s, y2 = x2 * c + x1 * s;
        const float lg = logf(1.f - exp2f(-5.f - (float)h));
        float sc; bf16_t* d;
        if (hh < 4) { sc = expf(lg * (float)(j + 1)); d = qp; } else { sc = expf(-lg * (float)(j + 1)) * 0.0625f; d = kpp; }
        d[(size_t)row * 1024 + h * 256 + i] = f2bf(y1 * sc); d[(size_t)row * 1024 + h * 256 + i + 128] = f2bf(y2 * sc); } };
struct EpiV { bf16_t* v; const float* ss;
    __device__ __forceinline__ void operator()(int row, int n, float a0, float) const { const float rs = rsqrtf(ss[row] * (1.f / DM) + EPS); v[(size_t)row * 2048 + n] = f2bf(rs * a0); } };
struct EpiGate { bf16_t* o; const float* ss; const float* ssr;
    __device__ __forceinline__ void operator()(int row, int n, float a0, float) const {
        const float rs = rsqrtf(ss[row] * (1.f / DM) + EPS); const int h = n >> 9;
        const float rinv = rsqrtf(ssr[(size_t)h * M_ + row] * (1.f / RV) + EPS);
        const size_t idx = (size_t)row * 2048 + n; o[idx] = f2bf(bf2f(o[idx]) * rinv * silu_f(rs * a0)); } };

__global__ __launch_bounds__(256) void k_rowss(const float* x, float* ss) {
    const int lane = threadIdx.x & 63, w = threadIdx.x >> 6; const int row = blockIdx.x * 4 + w;
    const float* xr = x + (size_t)row * DM; float s = 0.f;
    for (int j = 0; j < 4; ++j) { const f32x4 v = *(const f32x4*)(xr + j * 256 + lane * 4); s += v.x * v.x + v.y * v.y + v.z * v.z + v.w * v.w; }
    s = wave_sum(s); if (lane == 0) ss[row] = s;
}

__global__ __launch_bounds__(256) void k_gating(Ptrs p) {
    __shared__ float vn[128 * 128];
    const int item = blockIdx.x, g = item & 3, blk = item >> 2;
    const int row0 = blk * 128, t = threadIdx.x;
    const bf16_t* zb = ws_bf(p, WS_ZB);
    const float* vnorm = p.in[IN_GM_V_NORM] + g * 128;
    { const int r = t >> 1, hf = t & 1; const bf16_t* vr = zb + (size_t)(row0 + r) * ZLD + ZO_V + g * 128 + hf * 64;
      float s = 0.f; float tmp[64];
#pragma unroll
      for (int c = 0; c < 64; ++c) { tmp[c] = bf2f(vr[c]); s += tmp[c] * tmp[c]; }
      s += __shfl_xor(s, 1);
      const float rn = rsqrtf(s * (1.f / 128.f) + EPS);
#pragma unroll
      for (int c = 0; c < 64; ++c) vn[r * 128 + hf * 64 + c] = tmp[c] * rn * vnorm[hf * 64 + c]; }
    __syncthreads();
    const float* W = p.in[IN_GM_W_S] + (size_t)g * 128 * 128; const float* bs = p.in[IN_GM_B_S] + g * 128;
    bf16_t* mix = ws_bf(p, WS_MIX);
    const int c = t & 127;
    for (int i = 0; i < 64; ++i) {
        const int tt = (t >> 7) + 2 * i; const int smax = (tt < 64) ? 64 : 128;
        float acc = 0.f;
        for (int s = 0; s < smax; ++s) acc += W[tt * 128 + s] * vn[s * 128 + c];
        acc += bs[tt];
        const float u = bf2f(zb[(size_t)(row0 + tt) * ZLD + ZO_U + g * 128 + c]);
        mix[(size_t)(row0 + tt) * 1024 + g * 128 + c] = f2bf(u * acc);
    }
}

__global__ __launch_bounds__(256) void k_mla_norm(Ptrs p) {
    const int lane = threadIdx.x & 63, w = threadIdx.x >> 6; const int row = blockIdx.x * 4 + w, pos = row & (SEQ - 1);
    bf16_t* zr = ws_bf(p, WS_ZB) + (size_t)row * ZLD; bf16_t* qr = ws_bf(p, WS_QRAW) + (size_t)row * 768; bf16_t* kvr = ws_bf(p, WS_KVRAW) + (size_t)row * 1024;
    float s = 0.f; for (int j = 0; j < 6; ++j) { const float v = bf2f(zr[ZO_CQ + j * 64 + lane]); s += v * v; }
    const float r_q = rsqrtf(wave_sum(s) * (1.f / MQR) + EPS);
    s = 0.f; for (int j = 0; j < 4; ++j) { const float v = bf2f(zr[ZO_CKV + j * 64 + lane]); s += v * v; }
    const float r_kv = rsqrtf(wave_sum(s) * (1.f / MKVR) + EPS);
    const float* qn = p.in[IN_Q_NORM]; const float* kn = p.in[IN_K_NORM];
    const float* cm = ws_f32(p, WS_COSM) + pos * 16; const float* sm = ws_f32(p, WS_SINM) + pos * 16;
    const float cs = cm[lane & 15], sn = sm[lane & 15];
    const float kpe = (lane < 32) ? bf2f(zr[ZO_KPE + lane]) : 0.f;
    for (int h = 0; h < MH; ++h) {
        { const float y0 = r_q * bf2f(qr[h * 96 + lane]); const float y1 = (lane < 32) ? r_q * bf2f(qr[h * 96 + 64 + lane]) : 0.f;
          const float rn = rsqrtf(wave_sum(y0 * y0 + y1 * y1) * (1.f / MQK) + EPS);
          const float a0 = y0 * rn * qn[lane]; const float a1 = (lane < 32) ? y1 * rn * qn[64 + lane] : 0.f;
          const float pa = __shfl_xor(a1, 16);
          const float ro = (lane < 16) ? a1 * cs - pa * sn : a1 * cs + pa * sn;
          qr[h * 96 + lane] = f2bf(a0); if (lane < 32) qr[h * 96 + 64 + lane] = f2bf(ro); }
        { const float y0 = r_kv * bf2f(kvr[h * 128 + lane]); const float y1 = kpe;
          const float rn = rsqrtf(wave_sum(y0 * y0 + y1 * y1) * (1.f / MQK) + EPS);
          const float a0 = y0 * rn * kn[lane]; const float a1 = (lane < 32) ? y1 * rn * kn[64 + lane] : 0.f;
          const float pa = __shfl_xor(a1, 16);
          const float ro = (lane < 16) ? a1 * cs - pa * sn : a1 * cs + pa * sn;
          zr[h * 96 + lane] = f2bf(a0); if (lane < 32) zr[h * 96 + 64 + lane] = f2bf(ro);
          kvr[h * 128 + 64 + lane] = f2bf(r_kv * bf2f(kvr[h * 128 + 64 + lane])); }
    }
}

__global__ __launch_bounds__(64) void k_attn(Ptrs p) {
    const int c = blockIdx.x, h = blockIdx.y, b = blockIdx.z, t = threadIdx.x;
    const int row = b * SEQ + c * 64 + t;
    const bf16_t* qp = ws_bf(p, WS_QRAW) + (size_t)row * 768 + h * 96;
    float q[96], o[64];
#pragma unroll
    for (int d = 0; d < 96; ++d) q[d] = bf2f(qp[d]);
#pragma unroll
    for (int e = 0; e < 64; ++e) o[e] = 0.f;
    float m = -1e30f, l = 0.f; const float scale = 0.10206207261596575f;
    const int nk = 64 * (c + 1);
    const bf16_t* kb = ws_bf(p, WS_ZB) + (size_t)b * SEQ * ZLD + h * 96;
    const bf16_t* vb = ws_bf(p, WS_KVRAW) + (size_t)b * SEQ * 1024 + h * 128 + 64;
    for (int j = 0; j < nk; ++j) {
        const bf16_t* kr = kb + (size_t)j * ZLD; float s = 0.f;
#pragma unroll
        for (int d = 0; d < 96; d += 8) { const bf16x8 kv = *(const bf16x8*)(kr + d);
#pragma unroll
            for (int u = 0; u < 8; ++u) s += q[d + u] * bf2f((bf16_t)kv[u]); }
        s *= scale;
        const float mn = fmaxf(m, s), al = __expf(m - mn), pj = __expf(s - mn);
        l = l * al + pj; m = mn;
        const bf16_t* vr = vb + (size_t)j * 1024;
#pragma unroll
        for (int e = 0; e < 64; e += 8) { const bf16x8 vv = *(const bf16x8*)(vr + e);
#pragma unroll
            for (int u = 0; u < 8; ++u) o[e + u] = o[e + u] * al + pj * bf2f((bf16_t)vv[u]); }
    }
    const float il = 1.f / l; bf16_t* mo = ws_bf(p, WS_MIX) + (size_t)row * 1024 + 512 + h * 64;
#pragma unroll
    for (int e = 0; e < 64; ++e) mo[e] = f2bf(o[e] * il);
}

__global__ __launch_bounds__(256) void k_amat(Ptrs p) {
    const int item = blockIdx.x, chunk = item & 63, bh = item >> 6, b = bh >> 2, h = bh & 3;
    const int row0 = b * SEQ + chunk * 64;
    const bf16_t* qp = ws_bf(p, WS_QP) + (size_t)row0 * 1024 + h * 256; const bf16_t* kp = ws_bf(p, WS_KPP) + (size_t)row0 * 1024 + h * 256;
    bf16_t* A = ws_bf(p, WS_AMAT) + (size_t)item * 4096;
    for (int e = threadIdx.x; e < 4096; e += 256) {
        const int j = e >> 6, m = e & 63; float s = 0.f;
        if (j >= m) { const bf16_t* a = qp + (size_t)j * 1024; const bf16_t* bb = kp + (size_t)m * 1024;
            for (int d = 0; d < 256; d += 8) { const bf16x8 x = *(const bf16x8*)(a + d), y = *(const bf16x8*)(bb + d);
#pragma unroll
                for (int u = 0; u < 8; ++u) s += bf2f((bf16_t)x[u]) * bf2f((bf16_t)y[u]); } }
        A[e] = f2bf(s);
    }
}

__global__ __launch_bounds__(256) void k_scan(Ptrs p) {
    __shared__ float St[256 * 32]; __shared__ float As[64 * 64]; __shared__ float Vs[64 * 32];
    const int item = blockIdx.x, sl = item & 15, bh = item >> 4, b = bh >> 2, h = bh & 3, t = threadIdx.x;
    const float g = expf(64.f * logf(1.f - exp2f(-5.f - (float)h)));
    for (int i = t; i < 256 * 32; i += 256) St[i] = 0.f;
    bf16_t* vo = ws_bf(p, WS_VO); float* ssr = ws_f32(p, WS_SS) + 3 * M_;
    const int e = t & 31;
    for (int chunk = 0; chunk < 64; ++chunk) {
        const int row0 = b * SEQ + chunk * 64;
        const bf16_t* A = ws_bf(p, WS_AMAT) + (size_t)(bh * 64 + chunk) * 4096;
        __syncthreads();
        for (int i = t; i < 4096; i += 256) As[i] = bf2f(A[i]);
        for (int i = t; i < 2048; i += 256) Vs[i] = bf2f(vo[(size_t)(row0 + (i >> 5)) * 2048 + h * 512 + sl * 32 + (i & 31)]);
        __syncthreads();
        const bf16_t* qp = ws_bf(p, WS_QP) + (size_t)row0 * 1024 + h * 256; const bf16_t* kp = ws_bf(p, WS_KPP) + (size_t)row0 * 1024 + h * 256;
        float ov[8];
        for (int i = 0; i < 8; ++i) { const int j = (t >> 5) + 8 * i; float acc = 0.f;
            for (int m = 0; m < 64; ++m) acc += As[j * 64 + m] * Vs[m * 32 + e];
            const bf16_t* qr = qp + (size_t)j * 1024;
            for (int d = 0; d < 256; ++d) acc += bf2f(qr[d]) * St[d * 32 + e];
            ov[i] = acc; }
        __syncthreads();
        for (int i = 0; i < 32; ++i) { const int d = (t >> 5) + 8 * i; float acc = St[d * 32 + e];
            for (int m = 0; m < 64; ++m) acc += bf2f(kp[(size_t)m * 1024 + d]) * Vs[m * 32 + e];
            St[d * 32 + e] = g * acc; }
        for (int i = 0; i < 8; ++i) { const int j = (t >> 5) + 8 * i; const float o = ov[i];
            vo[(size_t)(row0 + j) * 2048 + h * 512 + sl * 32 + e] = f2bf(o);
            float sq = o * o;
#pragma unroll
            for (int off = 1; off < 32; off <<= 1) sq += __shfl_xor(sq, off);
            if (e == 0) atomicAdd(&ssr[(size_t)h * M_ + row0 + j], sq); }
    }
}

enum Phase { PH_PREP = 0, PH_IN0, PH_MLAUP, PH_MLANORM, PH_ATTN, PH_OUT0, PH_FFN0A, PH_FFN0B, PH_IN1, PH_AMAT, PH_SCAN, PH_GATE, PH_OUT1, PH_FFN1A, PH_FFN1B, PH_COUNT };

static void run_phase(int ph, const Ptrs& p, hipStream_t st) {
    unsigned char* ws = p.ws; float* ssb = (float*)(ws + WS_SS);
    float* ss1 = ssb, * ss2 = ssb + M_, * ss3 = ssb + 2 * M_, * ssr = ssb + 3 * M_;
    bf16_t* xb = (bf16_t*)(ws + WS_XB); bf16_t* zb = (bf16_t*)(ws + WS_ZB); bf16_t* mix = (bf16_t*)(ws + WS_MIX); bf16_t* act = (bf16_t*)(ws + WS_ACT);
    const dim3 blk(256);
    switch (ph) {
    case PH_PREP: hipLaunchKernelGGL(k_xprep, dim3(M_ / 4), blk, 0, st, p); hipLaunchKernelGGL(k_tables, dim3(SEQ * 128 / 256), blk, 0, st, p); break;
    case PH_IN0: hipLaunchKernelGGL((ngemm<BfPlain, EpiZ0, false>), dim3(EVEN_IN / 32, M_ / 128), blk, 0, st, xb, DM, DM, BfPlain{p.in[IN_EVEN_W_IN], EVEN_IN, 0, p.in[IN_NORM_MIX]}, EpiZ0{zb, (const float*)(ws + WS_RS0)}); break;
    case PH_MLAUP:
        hipLaunchKernelGGL((ngemm<BfPlain, EpiStore, false>), dim3(768 / 32, M_ / 128), blk, 0, st, zb + ZO_CQ, ZLD, MQR, BfPlain{p.in[IN_W_UQ], 768, 0, p.in[IN_Q_A_NORM]}, EpiStore{(bf16_t*)(ws + WS_QRAW), 768, 0});
        hipLaunchKernelGGL((ngemm<BfPlain, EpiStore, false>), dim3(1024 / 32, M_ / 128), blk, 0, st, zb + ZO_CKV, ZLD, MKVR, BfPlain{p.in[IN_W_UKV], 1024, 0, p.in[IN_KV_A_NORM]}, EpiStore{(bf16_t*)(ws + WS_KVRAW), 1024, 0});
        hipLaunchKernelGGL(k_gating, dim3(BATCH * 32 * 4), blk, 0, st, p); break;
    case PH_MLANORM: hipLaunchKernelGGL(k_mla_norm, dim3(M_ / 4), blk, 0, st, p); break;
    case PH_ATTN: hipLaunchKernelGGL(k_attn, dim3(64, MH, BATCH), dim3(64), 0, st, p); break;
    case PH_OUT0: hipLaunchKernelGGL((ngemm<BfPlain, EpiResid, false>), dim3(DM / 32, M_ / 128), blk, 0, st, mix, 1024, 1024, BfPlain{p.in[IN_EVEN_W_OUT], DM, 0, nullptr}, EpiResid{p.in[IN_X], p.out, xb});
        hipLaunchKernelGGL(k_rowss, dim3(M_ / 4), blk, 0, st, (const float*)p.out, ss1); break;
    case PH_FFN0A: hipLaunchKernelGGL((ngemm<BfPair, EpiSwiglu, true>), dim3(DFF / 32, M_ / 128), blk, 0, st, xb, DM, DM, BfPair{p.in[IN_FFN_GATE], p.in[IN_FFN_UP], DFF, 0, p.in[IN_NORM_FFN]}, EpiSwiglu{act, ss1}); break;
    case PH_FFN0B: hipLaunchKernelGGL((ngemm<BfPlain, EpiResid, false>), dim3(DM / 32, M_ / 128), blk, 0, st, act, DFF, DFF, BfPlain{p.in[IN_FFN_DOWN], DM, 0, nullptr}, EpiResid{p.out, p.out, xb});
        hipLaunchKernelGGL(k_rowss, dim3(M_ / 4), blk, 0, st, (const float*)p.out, ss2); break;
    case PH_IN1:
        hipLaunchKernelGGL((ngemm<BfRope, EpiRopeQK, true>), dim3(1024 / 32, M_ / 128), blk, 0, st, xb, DM, DM, BfRope{p.in[IN_ODD_W_IN], p.in[IN_NORM_MIX] + DM},
                           EpiRopeQK{(bf16_t*)(ws + WS_QP), (bf16_t*)(ws + WS_KPP), ss2, (const float*)(ws + WS_COSR), (const float*)(ws + WS_SINR)});
        hipLaunchKernelGGL((ngemm<BfPlain, EpiV, false>), dim3(2048 / 32, M_ / 128), blk, 0, st, xb, DM, DM, BfPlain{p.in[IN_ODD_W_IN] + 2048, ODD_IN, 0, p.in[IN_NORM_MIX] + DM}, EpiV{(bf16_t*)(ws + WS_VO), ss2}); break;
    case PH_AMAT: hipLaunchKernelGGL(k_amat, dim3(16 * 64), blk, 0, st, p); break;
    case PH_SCAN: hipLaunchKernelGGL(k_scan, dim3(256), blk, 0, st, p); break;
    case PH_GATE: hipLaunchKernelGGL((ngemm<BfPlain, EpiGate, false>), dim3(2048 / 32, M_ / 128), blk, 0, st, xb, DM, DM, BfPlain{p.in[IN_ODD_W_IN] + 4096, ODD_IN, 0, p.in[IN_NORM_MIX] + DM}, EpiGate{(bf16_t*)(ws + WS_VO), ss2, ssr}); break;
    case PH_OUT1: hipLaunchKernelGGL((ngemm<BfPlain, EpiResid, false>), dim3(DM / 32, M_ / 128), blk, 0, st, (const bf16_t*)(ws + WS_VO), 2048, 2048, BfPlain{p.in[IN_ODD_W_OUT], DM, 0, p.in[IN_RET_OUT_NORM]}, EpiResid{p.out, p.out, xb});
        hipLaunchKernelGGL(k_rowss, dim3(M_ / 4), blk, 0, st, (const float*)p.out, ss3); break;
    case PH_FFN1A: hipLaunchKernelGGL((ngemm<BfPair, EpiSwiglu, true>), dim3(DFF / 32, M_ / 128), blk, 0, st, xb, DM, DM, BfPair{p.in[IN_FFN_GATE] + (size_t)DM * DFF, p.in[IN_FFN_UP] + (size_t)DM * DFF, DFF, 0, p.in[IN_NORM_FFN] + DM}, EpiSwiglu{act, ss3}); break;
    case PH_FFN1B: hipLaunchKernelGGL((ngemm<BfPlain, EpiResid, false>), dim3(DM / 32, M_ / 128), blk, 0, st, act, DFF, DFF, BfPlain{p.in[IN_FFN_DOWN] + (size_t)DFF * DM, DM, 0, nullptr}, EpiResid{p.out, p.out, xb}); break;
    default: break;
    }
}
}
extern "C" void kernel_launch(void* const* d_in, const int* in_sizes, int n_in, void* d_out, int out_size, void* d_ws, size_t ws_size, hipStream_t stream) {
    if (n_in != 20 || out_size != M_ * DM || ws_size < WS_END) { fprintf(stderr, "kernel_launch: unexpected shapes n_in %d out %d ws %zu\n", n_in, out_size, ws_size); return; }
    Ptrs p{};
    for (int i = 0; i < 20; ++i) p.in[i] = (const float*)d_in[i];
    p.out = (float*)d_out; p.ws = (unsigned char*)d_ws;
    (void)hipMemsetAsync(d_ws, 0, ZERO_BYTES, stream);
    for (int ph = 0; ph < nv::PH_COUNT; ++ph) nv::run_phase(ph, p, stream);
}
```

```cpp
#define USE_CG_SYNC 0
#include <hip/hip_runtime.h>
#include <hip/hip_cooperative_groups.h>
#include <cstdio>
#include <cstdint>
namespace cg = cooperative_groups;

constexpr int BATCH = 4, SEQ = 4096, DM = 1024, M_ = BATCH * SEQ;
constexpr int CHUNK = 64;
constexpr float EPS = 1e-6f;
constexpr int GM_G = 4, GM_D = 128, GM_W = 512, GM_BLK = 128;
constexpr int MH = 8, MQR = 384, MKVR = 256, MNOPE = 64, MROPE = 32, MV = 64, MQK = 96;
constexpr int EVEN_IN = 1696, ZLD = 1792;
constexpr int RH = 4, RQK = 256, RV = 512, ODD_IN = 6144;
constexpr int DFF = 2816;
constexpr int ZO_U = 0, ZO_V = 512, ZO_CQ = 1024, ZO_CKV = 1408, ZO_KPE = 1664;

typedef unsigned short bf16_t;
typedef short bf16x8 __attribute__((ext_vector_type(8)));
typedef float f32x4 __attribute__((ext_vector_type(4)));
typedef float f32x16 __attribute__((ext_vector_type(16)));
typedef unsigned u32x4 __attribute__((ext_vector_type(4)));
typedef unsigned u32x2 __attribute__((ext_vector_type(2)));

__device__ __forceinline__ float bf2f(bf16_t v) { return __uint_as_float(((unsigned)v) << 16); }
__device__ __forceinline__ bf16_t f2bf(float f) { unsigned u = __float_as_uint(f); return (bf16_t)((u + 0x7fffu + ((u >> 16) & 1u)) >> 16); }
__device__ __forceinline__ unsigned pk2(float lo, float hi) { return (unsigned)f2bf(lo) | ((unsigned)f2bf(hi) << 16); }
__device__ __forceinline__ float gelu_tanh(float x) {
    const float u = 0.7978845608028654f * (x + 0.044715f * x * x * x);
    return x / (1.f + __expf(-2.f * u));
}
__device__ __forceinline__ float silu_f(float x) { return x / (1.f + __expf(-x)); }
__device__ __forceinline__ float wave_sum(float v) {
#pragma unroll
    for (int o = 1; o < 64; o <<= 1) v += __shfl_xor(v, o);
    return v;
}

constexpr size_t MiB = 1u << 20;
constexpr size_t WS_CTL = 0;
constexpr size_t WS_SS = 1 * MiB;
constexpr size_t ZERO_BYTES = 2 * MiB;
constexpr size_t WS_RS0 = 2 * MiB;
constexpr size_t WS_INVR = 2 * MiB + 128 * 1024;
constexpr size_t WS_INVM = 2 * MiB + 128 * 1024 + 1024;
constexpr size_t WS_COSR = 3 * MiB;
constexpr size_t WS_SINR = 5 * MiB;
constexpr size_t WS_WSP = 7 * MiB;
constexpr size_t WS_W = 8 * MiB;
constexpr size_t WS_XB = 64 * MiB;
constexpr size_t WS_ARENA = 96 * MiB;
constexpr size_t WS_ZB = 96 * MiB;
constexpr size_t WS_QRAW = 152 * MiB;
constexpr size_t WS_KVRAW = 176 * MiB;
constexpr size_t WS_MIX = 208 * MiB;
constexpr size_t WS_VB = 240 * MiB;
constexpr size_t WS_ACT = 96 * MiB;
constexpr size_t WS_QP = 96 * MiB;
constexpr size_t WS_KPP = 128 * MiB;
constexpr size_t WS_VO = 160 * MiB;
constexpr size_t WS_AMAT = 224 * MiB;
constexpr size_t WS_SSP = 232 * MiB;
constexpr size_t WS_SSQ = 3 * MiB;
constexpr size_t WS_END = 256 * MiB;

struct Ptrs {
    const float* in[20];
    float* out;
    unsigned char* ws;
};
#define IN_X 0
#define IN_NORM_MIX 1
#define IN_NORM_FFN 2
#define IN_EVEN_W_IN 3
#define IN_GM_V_NORM 4
#define IN_GM_W_S 5
#define IN_GM_B_S 6
#define IN_Q_A_NORM 7
#define IN_W_UQ 8
#define IN_KV_A_NORM 9
#define IN_W_UKV 10
#define IN_Q_NORM 11
#define IN_K_NORM 12
#define IN_EVEN_W_OUT 13
#define IN_ODD_W_IN 14
#define IN_RET_OUT_NORM 15
#define IN_ODD_W_OUT 16
#define IN_FFN_GATE 17
#define IN_FFN_UP 18
#define IN_FFN_DOWN 19

__device__ __forceinline__ float* ws_f32(const Ptrs& p, size_t off) { return (float*)(p.ws + off); }
__device__ __forceinline__ bf16_t* ws_bf(const Ptrs& p, size_t off) { return (bf16_t*)(p.ws + off); }
namespace nv {
enum Phase { PH_PREP = 0, PH_IN0, PH_MLAUP, PH_GATING, PH_MLANORM, PH_ATTN, PH_OUT0, PH_FFN0A, PH_FFN0B, PH_IN1, PH_AMAT, PH_SCAN, PH_GATE, PH_OUT1, PH_FFN1A, PH_FFN1B, PH_COUNT };
}

namespace pg8 {
#define PG8_LAS __attribute__((address_space(3)))
constexpr int BM = 256, BK = 64, HALF = 128, HTB = HALF * BK * 2  , STAGE_BYTES = 8 * HTB, NXCD = 8, WGM = 8;

__host__ __device__ __forceinline__ int lds_byte(int r, int c) { const int st = (r >> 4) * 2 + (c >> 5), rr = r & 15, cc = c & 31, ob = rr * 64 + cc * 2; return st * 1024 + (ob ^ (((ob >> 9) & 1) << 5)); }
__host__ __device__ __forceinline__ void stage_rc(int b, int& R, int& C) { const int st = b / 1024, sb = b % 1024, swz = sb ^ (((sb >> 9) & 1) << 5); R = (st >> 1) * 16 + swz / 64; C = (st & 1) * 32 + (swz % 64) / 2; }
__host__ __device__ __forceinline__ int perm32(int rho) { const int n = rho >> 4, i = rho & 15; return 8 * (i >> 2) + 4 * n + (i & 3); }

struct Unit { int pm, pn; };
struct Gemm { const bf16_t* A; const bf16_t* Bt; int lda, ldb, K; };

struct StaticOrder {
    int nM, nN, nwg, G, c;
    __host__ __device__ void init(int M, int N, int G_, int c_) { nM = M / BM; nN = N / BM; nwg = nM * nN; G = G_; c = c_; }
    __host__ __device__ bool next(int i, Unit& u) const {
        const long L = (long)i * G + c; if (L >= nwg) return false;
        int wgid = (int)L; { const int q = nwg / NXCD, r = nwg % NXCD, xcd = wgid % NXCD, off = wgid / NXCD; wgid = (xcd < r ? xcd * (q + 1) : r * (q + 1) + (xcd - r) * q) + off; }
        const int nig = WGM * nN, gid = wgid / nig, fm = gid * WGM, gsz = (nM - fm) < WGM ? (nM - fm) : WGM;
        u.pm = fm + ((wgid % nig) % gsz); u.pn = (wgid % nig) / gsz; return true;
    }
    __device__ __forceinline__ void a_ready(const Unit&) const {}
    __device__ __forceinline__ void done(const Unit&) const {}
};

__device__ __forceinline__ unsigned cvt_pk_bf16(float lo, float hi) { unsigned r; asm volatile("v_cvt_pk_bf16_f32 %0, %1, %2" : "=v"(r) : "v"(lo), "v"(hi)); return r; }
__device__ __forceinline__ u32x4 pack8(const f32x4 v0, const f32x4 v1) { u32x4 w; w.x = cvt_pk_bf16(v0[0], v0[1]); w.y = cvt_pk_bf16(v0[2], v0[3]); w.z = cvt_pk_bf16(v1[0], v1[1]); w.w = cvt_pk_bf16(v1[2], v1[3]); return w; }
__device__ __forceinline__ float gelu_fast(float x) {
    const float u2 = x * (1.5957691216057308f + 0.07135481627260025f * x * x);
    return x * __builtin_amdgcn_rcpf(1.f + __builtin_amdgcn_exp2f(-1.4426950408889634f * u2)); }
__device__ __forceinline__ float sigmoid_fast(float x) { return __builtin_amdgcn_rcpf(1.f + __builtin_amdgcn_exp2f(-1.4426950408889634f * x)); }
__device__ __forceinline__ f32x4 gelu4(f32x4 v) { return (f32x4){gelu_fast(v[0]), gelu_fast(v[1]), gelu_fast(v[2]), gelu_fast(v[3])}; }


struct EpiZ0 { static constexpr bool PERM = true, AFTER_DRAIN = false; bf16_t* zb; const float* rs0;
    __device__ __forceinline__ void operator()(const f32x4 (&acc)[2][2][4][2], const Unit& u, int wr, int wc, int fr, int fq) const {
        const int row0 = u.pm * BM + wr * 64 + fr, col0 = u.pn * BM + wc * 32 + 8 * fq; const bool act = u.pn < 4;
#pragma unroll
        for (int ai = 0; ai < 2; ++ai)
#pragma unroll
            for (int m = 0; m < 4; ++m) { const int row = row0 + ai * HALF + m * 16; const float rs = rs0[row]; bf16_t* rowp = zb + (size_t)row * ZLD + col0;
#pragma unroll
                for (int bj = 0; bj < 2; ++bj) { f32x4 v0 = acc[ai][bj][m][0] * rs, v1 = acc[ai][bj][m][1] * rs; if (act) { v0 = gelu4(v0); v1 = gelu4(v1); }
                    *(u32x4*)(rowp + bj * HALF) = pack8(v0, v1); } }
    } };
struct EpiStore { static constexpr bool PERM = true, AFTER_DRAIN = false; bf16_t* O; int ldo; int pad;
    __device__ __forceinline__ void operator()(const f32x4 (&acc)[2][2][4][2], const Unit& u, int wr, int wc, int fr, int fq) const {
        const int row0 = u.pm * BM + wr * 64 + fr, col0 = u.pn * BM + wc * 32 + 8 * fq;
#pragma unroll
        for (int ai = 0; ai < 2; ++ai)
#pragma unroll
            for (int m = 0; m < 4; ++m) { bf16_t* rowp = O + (size_t)(row0 + ai * HALF + m * 16) * ldo + col0;
#pragma unroll
                for (int bj = 0; bj < 2; ++bj) *(u32x4*)(rowp + bj * HALF) = pack8(acc[ai][bj][m][0], acc[ai][bj][m][1]); }
    } };
template <bool FIRST, bool LAST> struct EpiResid { static constexpr bool PERM = !LAST, AFTER_DRAIN = false; const float* basef; float* out; bf16_t* xb; float* ss;
    __device__ __forceinline__ void operator()(const f32x4 (&acc)[2][2][4][2], const Unit& u, int wr, int wc, int fr, int fq) const {
        const int row0 = u.pm * BM + wr * 64 + fr;
        if constexpr (!LAST) {
            const int col0 = u.pn * BM + wc * 32 + 8 * fq;
            u32x4 rb[2][4][2];
#pragma unroll
            for (int ai = 0; ai < 2; ++ai)
#pragma unroll
                for (int m = 0; m < 4; ++m)
#pragma unroll
                    for (int bj = 0; bj < 2; ++bj) rb[ai][m][bj] = *(const u32x4*)(xb + (size_t)(row0 + ai * HALF + m * 16) * DM + col0 + bj * HALF);
#pragma unroll
            for (int ai = 0; ai < 2; ++ai)
#pragma unroll
                for (int m = 0; m < 4; ++m) { const int row = row0 + ai * HALF + m * 16; bf16_t* rowp = xb + (size_t)row * DM + col0; float sq = 0.f;
#pragma unroll
                    for (int bj = 0; bj < 2; ++bj) { const u32x4 b = rb[ai][m][bj];
                        f32x4 v0 = (f32x4){__uint_as_float(b.x << 16), __uint_as_float(b.x & 0xffff0000u), __uint_as_float(b.y << 16), __uint_as_float(b.y & 0xffff0000u)} + acc[ai][bj][m][0];
                        f32x4 v1 = (f32x4){__uint_as_float(b.z << 16), __uint_as_float(b.z & 0xffff0000u), __uint_as_float(b.w << 16), __uint_as_float(b.w & 0xffff0000u)} + acc[ai][bj][m][1];
                        *(u32x4*)(rowp + bj * HALF) = pack8(v0, v1);
                        sq += (v0[0] * v0[0] + v0[1] * v0[1]) + (v0[2] * v0[2] + v0[3] * v0[3]) + (v1[0] * v1[0] + v1[1] * v1[1]) + (v1[2] * v1[2] + v1[3] * v1[3]); }
                    sq += __shfl_xor(sq, 16); sq += __shfl_xor(sq, 32); if (fq == 0) atomicAdd(ss + row, sq);
                    if (m & 1) asm volatile("" ::: "memory"); }
        } else {
            const int col0 = u.pn * BM + wc * 32 + 4 * fq;
            u32x2 rb[2][4][2][2];
#pragma unroll
            for (int ai = 0; ai < 2; ++ai)
#pragma unroll
                for (int m = 0; m < 4; ++m)
#pragma unroll
                    for (int bj = 0; bj < 2; ++bj)
#pragma unroll
                        for (int n = 0; n < 2; ++n) rb[ai][m][bj][n] = *(const u32x2*)(xb + (size_t)(row0 + ai * HALF + m * 16) * DM + col0 + bj * HALF + n * 16);
#pragma unroll
            for (int ai = 0; ai < 2; ++ai)
#pragma unroll
                for (int m = 0; m < 4; ++m) { const int row = row0 + ai * HALF + m * 16; const size_t off = (size_t)row * DM + col0;
#pragma unroll
                    for (int bj = 0; bj < 2; ++bj)
#pragma unroll
                        for (int n = 0; n < 2; ++n) { const size_t o2 = off + bj * HALF + n * 16; const u32x2 b = rb[ai][m][bj][n];
                            const f32x4 v = (f32x4){__uint_as_float(b.x << 16), __uint_as_float(b.x & 0xffff0000u), __uint_as_float(b.y << 16), __uint_as_float(b.y & 0xffff0000u)} + acc[ai][bj][m][n];
                            *(f32x4*)(out + o2) = v; }
                    if (m & 1) asm volatile("" ::: "memory"); }
        }
    } };
struct EpiSwiglu { static constexpr bool PERM = true, AFTER_DRAIN = false; bf16_t* act; const float* ss;
    __device__ __forceinline__ void operator()(const f32x4 (&acc)[2][2][4][2], const Unit& u, int wr, int wc, int fr, int fq) const {
        const int row0 = u.pm * BM + wr * 64 + fr, col0 = u.pn * HALF + wc * 32 + 8 * fq;
#pragma unroll
        for (int ai = 0; ai < 2; ++ai)
#pragma unroll
            for (int m = 0; m < 4; ++m) { const int row = row0 + ai * HALF + m * 16; const float rs = __builtin_amdgcn_rsqf(ss[row] * (1.f / DM) + EPS);
                f32x4 o[2];
#pragma unroll
                for (int n = 0; n < 2; ++n) { const f32x4 g = acc[ai][0][m][n] * rs, up = acc[ai][1][m][n] * rs;
#pragma unroll
                    for (int j = 0; j < 4; ++j) o[n][j] = g[j] * sigmoid_fast(g[j]) * up[j]; }
                *(u32x4*)(act + (size_t)row * DFF + col0) = pack8(o[0], o[1]); }
    } };
struct EpiIn1 { static constexpr bool PERM = true, AFTER_DRAIN = false; bf16_t* qp; bf16_t* kpp; bf16_t* v; const float* ss; const float* inv2pi; const float* unused_;
    __device__ __forceinline__ void operator()(const f32x4 (&acc)[2][2][4][2], const Unit& u, int wr, int wc, int fr, int fq) const {
        const int row0 = u.pm * BM + wr * 64 + fr;
        if (u.pn < 8) {
            const int h = u.pn & 3, d0 = wc * 32 + 8 * fq; const bool isq = u.pn < 4; bf16_t* dst = isq ? qp : kpp;
            const float lg2 = __log2f(1.f - __builtin_amdgcn_exp2f(-5.f - (float)h)) * (isq ? 1.f : -1.f), mul = isq ? 1.f : 0.0625f;
            f32x4 iv[2]; iv[0] = *(const f32x4*)(inv2pi + d0); iv[1] = *(const f32x4*)(inv2pi + d0 + 4);
#pragma unroll
            for (int ai = 0; ai < 2; ++ai)
#pragma unroll
                for (int m = 0; m < 4; ++m) { const int row = row0 + ai * HALF + m * 16, pos = row & (SEQ - 1), jj = row & 63;
                    const float rs = __builtin_amdgcn_rsqf(ss[row] * (1.f / DM) + EPS), sc = __builtin_amdgcn_exp2f(lg2 * (float)(jj + 1)) * mul;
                    f32x4 y1[2], y2[2];
#pragma unroll
                    for (int n = 0; n < 2; ++n) { f32x4 c, s;
#pragma unroll
                        for (int j = 0; j < 4; ++j) { const float rev = __builtin_amdgcn_fractf((float)pos * iv[n][j]); c[j] = __builtin_amdgcn_cosf(rev); s[j] = __builtin_amdgcn_sinf(rev); }
                        const f32x4 x1 = acc[ai][0][m][n] * rs, x2 = acc[ai][1][m][n] * rs;
                        y1[n] = (x1 * c - x2 * s) * sc; y2[n] = (x2 * c + x1 * s) * sc; }
                    bf16_t* rowp = dst + (size_t)row * 1024 + h * 256;
                    if (isq) { const int p0 = (d0 & ~15) + 4 * ((d0 >> 3) & 1);
                        u32x2 w; w.x = cvt_pk_bf16(y1[0][0], y1[0][1]); w.y = cvt_pk_bf16(y1[0][2], y1[0][3]); *(u32x2*)(rowp + p0) = w;
                        w.x = cvt_pk_bf16(y1[1][0], y1[1][1]); w.y = cvt_pk_bf16(y1[1][2], y1[1][3]); *(u32x2*)(rowp + p0 + 8) = w;
                        w.x = cvt_pk_bf16(y2[0][0], y2[0][1]); w.y = cvt_pk_bf16(y2[0][2], y2[0][3]); *(u32x2*)(rowp + 128 + p0) = w;
                        w.x = cvt_pk_bf16(y2[1][0], y2[1][1]); w.y = cvt_pk_bf16(y2[1][2], y2[1][3]); *(u32x2*)(rowp + 128 + p0 + 8) = w; }
                    else { *(u32x4*)(rowp + d0) = pack8(y1[0], y1[1]); *(u32x4*)(rowp + d0 + 128) = pack8(y2[0], y2[1]); } }
        } else {
            const int col0 = (u.pn - 8) * BM + wc * 32 + 8 * fq;
#pragma unroll
            for (int ai = 0; ai < 2; ++ai)
#pragma unroll
                for (int m = 0; m < 4; ++m) { const int row = row0 + ai * HALF + m * 16; const float rs = __builtin_amdgcn_rsqf(ss[row] * (1.f / DM) + EPS); bf16_t* rowp = v + (size_t)row * 2048 + col0;
#pragma unroll
                    for (int bj = 0; bj < 2; ++bj) *(u32x4*)(rowp + bj * HALF) = pack8(acc[ai][bj][m][0] * rs, acc[ai][bj][m][1] * rs); }
        }
    } };
struct EpiGate { static constexpr bool PERM = true, AFTER_DRAIN = false; bf16_t* o; const float* ss; const float* ssp;
    __device__ __forceinline__ void operator()(const f32x4 (&acc)[2][2][4][2], const Unit& u, int wr, int wc, int fr, int fq) const {
        const int row0 = u.pm * BM + wr * 64 + fr, col0 = u.pn * BM + wc * 32 + 8 * fq, h = u.pn >> 1;
#pragma unroll
        for (int ai = 0; ai < 2; ++ai)
#pragma unroll
            for (int m = 0; m < 4; ++m) { const int row = row0 + ai * HALF + m * 16; const float rs = __builtin_amdgcn_rsqf(ss[row] * (1.f / DM) + EPS);
                float sq = 0.f;
#pragma unroll
                for (int s4 = 0; s4 < 4; ++s4) sq += ssp[(size_t)((4 * fq + s4) * 4 + h) * M_ + row];
                sq += __shfl_xor(sq, 16); sq += __shfl_xor(sq, 32);
                const float rinv = __builtin_amdgcn_rsqf(sq * (1.f / RV) + EPS); bf16_t* rowp = o + (size_t)row * 2048 + col0;
#pragma unroll
                for (int bj = 0; bj < 2; ++bj) { const u32x4 ow = *(const u32x4*)(rowp + bj * HALF); f32x4 r[2];
#pragma unroll
                    for (int n = 0; n < 2; ++n) { const f32x4 g = acc[ai][bj][m][n] * rs; const unsigned w0 = n ? ow.z : ow.x, w1 = n ? ow.w : ow.y;
                        const float o0 = __uint_as_float(w0 << 16), o1 = __uint_as_float(w0 & 0xffff0000u), o2 = __uint_as_float(w1 << 16), o3 = __uint_as_float(w1 & 0xffff0000u);
                        r[n][0] = o0 * rinv * g[0] * sigmoid_fast(g[0]); r[n][1] = o1 * rinv * g[1] * sigmoid_fast(g[1]); r[n][2] = o2 * rinv * g[2] * sigmoid_fast(g[2]); r[n][3] = o3 * rinv * g[3] * sigmoid_fast(g[3]); }
                    *(u32x4*)(rowp + bj * HALF) = pack8(r[0], r[1]); } }
    } };

template <class Epi, class Sched, bool ALIGN_EPI = false, bool SP2 = false>
__device__ __forceinline__ void gemm_phase(PG8_LAS unsigned char* lds, const Gemm g, const Sched& S, const Epi& E) {
    const int tid = threadIdx.x, wid = __builtin_amdgcn_readfirstlane(tid >> 6), lane = tid & 63, wr = wid >> 2, wc = wid & 3, fr = lane & 15, fq = lane >> 4;
    const int K = g.K, nt = K / BK;
    unsigned voffA[2], voffB[2];
#pragma unroll
    for (int i = 0; i < 2; ++i) { int R, C; stage_rc(tid * 16 + i * 8192, R, C); const int Rb = Epi::PERM ? ((R & ~31) + perm32(R & 31)) : R;
        voffA[i] = (unsigned)(R * g.lda + C) * 2u; voffB[i] = (unsigned)(Rb * g.ldb + C) * 2u; }
    const size_t kstep = (size_t)(BK * 2);
    const size_t hstepA = (size_t)HALF * g.lda * 2, hstepB = (size_t)HALF * g.ldb * 2;
    const size_t tstepA = 2 * hstepA, tstepB = 2 * hstepB;
    const unsigned ldsw = (unsigned)wid * 1024u;
    const int aoff = lds_byte(wr * 64 + fr, fq * 8), boff = lds_byte(wc * 32 + fr, fq * 8);
#define PG8_SA(b, h) (((b) * 2 + (h)) * HTB)
#define PG8_SB(b, h) ((4 + (b) * 2 + (h)) * HTB)
#define PG8_STAGE(bufoff, gbase, voff) do { _Pragma("unroll") for (int _i = 0; _i < 2; ++_i) \
        __builtin_amdgcn_global_load_lds((const unsigned*)((const char*)(gbase) + (voff)[_i]), (PG8_LAS unsigned*)(lds + (bufoff) + ldsw + _i * 8192), 16, 0, 0); } while (0)
#define PG8_LDA(dst, b, h) do { _Pragma("unroll") for (int m = 0; m < 4; ++m) _Pragma("unroll") for (int k = 0; k < 2; ++k) dst[m][k] = *(const PG8_LAS bf16x8*)(lds + PG8_SA(b, h) + aoff + m * 2048 + k * 1024); } while (0)
#define PG8_LDB(dst, b, h) do { _Pragma("unroll") for (int n = 0; n < 2; ++n) _Pragma("unroll") for (int k = 0; k < 2; ++k) dst[n][k] = *(const PG8_LAS bf16x8*)(lds + PG8_SB(b, h) + boff + n * 2048 + k * 1024); } while (0)
#define PG8_MMA(ai, bj, At, Bt) do { __builtin_amdgcn_s_setprio(1); _Pragma("unroll") for (int m = 0; m < 4; ++m) _Pragma("unroll") for (int n = 0; n < 2; ++n) _Pragma("unroll") for (int k = 0; k < 2; ++k) \
        acc[ai][bj][m][n] = __builtin_amdgcn_mfma_f32_16x16x32_bf16(Bt[n][k], At[m][k], acc[ai][bj][m][n], 0, 0, 0); __builtin_amdgcn_s_setprio(0); } while (0)
#define PG8_WAIT_V(n) asm volatile("s_waitcnt vmcnt(" #n ")" ::: "memory")
#define PG8_WAIT_L(n) asm volatile("s_waitcnt lgkmcnt(" #n ")" ::: "memory")
#define PG8_BAR __builtin_amdgcn_s_barrier()
#define PG8_SCHED __builtin_amdgcn_sched_barrier(0)
    Unit cur, nxt; int ui = 0;
    if (!S.next(0, cur)) return;
    f32x4 acc[2][2][4][2];
#pragma unroll
    for (int a = 0; a < 2; ++a)
#pragma unroll
        for (int b = 0; b < 2; ++b)
#pragma unroll
            for (int m = 0; m < 4; ++m)
#pragma unroll
                for (int n = 0; n < 2; ++n) acc[a][b][m][n] = (f32x4){0.f, 0.f, 0.f, 0.f};
    bf16x8 At[4][2], B0[2][2], B1[2][2];
    const char* cA = (const char*)g.A + (size_t)cur.pm * tstepA; const char* cB = (const char*)g.Bt + (size_t)cur.pn * tstepB;
    S.a_ready(cur);
    if constexpr (SP2) {
        PG8_STAGE(PG8_SB(0, 0), cB, voffB); PG8_STAGE(PG8_SB(0, 1), cB + hstepB, voffB); PG8_STAGE(PG8_SA(0, 0), cA, voffA); PG8_STAGE(PG8_SA(0, 1), cA + hstepA, voffA);
        if (wr == 1) PG8_BAR;
        PG8_WAIT_V(2); PG8_BAR;
        PG8_STAGE(PG8_SB(1, 0), cB + kstep, voffB); PG8_STAGE(PG8_SA(1, 0), cA + kstep, voffA); PG8_STAGE(PG8_SB(1, 1), cB + hstepB + kstep, voffB);
        PG8_WAIT_V(6); PG8_BAR;
    } else {
        PG8_STAGE(PG8_SB(0, 0), cB, voffB); PG8_STAGE(PG8_SA(0, 0), cA, voffA); PG8_STAGE(PG8_SB(0, 1), cB + hstepB, voffB); PG8_STAGE(PG8_SA(0, 1), cA + hstepA, voffA);
        if (wr == 1) PG8_BAR;
        PG8_WAIT_V(4); PG8_BAR;
        PG8_STAGE(PG8_SB(1, 0), cB + kstep, voffB); PG8_STAGE(PG8_SA(1, 0), cA + kstep, voffA); PG8_STAGE(PG8_SB(1, 1), cB + hstepB + kstep, voffB);
        PG8_WAIT_V(6); PG8_BAR;
    }
    for (;;) {
        const bool has_next = S.next(ui + 1, nxt);
        const char* nA = has_next ? (const char*)g.A + (size_t)nxt.pm * tstepA : cA; const char* nB = has_next ? (const char*)g.Bt + (size_t)nxt.pn * tstepB : cB;
        for (int t = 0; t < nt; t += 2) {
            const bool last = (t == nt - 2);
            const char* a1 = cA + (size_t)(t + 1) * kstep;
            const char* a2 = last ? nA : cA + (size_t)(t + 2) * kstep; const char* b2 = last ? nB : cB + (size_t)(t + 2) * kstep;
            const char* a3 = a2 + kstep; const char* b3 = b2 + kstep;
            if (last && has_next) S.a_ready(nxt);
            if constexpr (SP2) {
            PG8_LDB(B0, 0, 0); PG8_LDB(B1, 0, 1); PG8_SCHED; PG8_LDA(At, 0, 0); PG8_STAGE(PG8_SA(1, 1), a1 + hstepA, voffA);
            PG8_WAIT_V(8); PG8_WAIT_L(0); PG8_BAR; PG8_MMA(0, 0, At, B0); PG8_MMA(0, 1, At, B1); PG8_BAR; PG8_SCHED;
            PG8_LDA(At, 0, 1); PG8_STAGE(PG8_SB(0, 0), b2, voffB); PG8_STAGE(PG8_SB(0, 1), b2 + hstepB, voffB); PG8_STAGE(PG8_SA(0, 0), a2, voffA);
            PG8_WAIT_V(8); PG8_WAIT_L(0); PG8_BAR; PG8_MMA(1, 0, At, B0); PG8_MMA(1, 1, At, B1); PG8_BAR; PG8_SCHED;
            PG8_LDB(B0, 1, 0); PG8_LDB(B1, 1, 1); PG8_SCHED; PG8_LDA(At, 1, 0); PG8_STAGE(PG8_SA(0, 1), a2 + hstepA, voffA);
            PG8_WAIT_V(8); PG8_WAIT_L(0); PG8_BAR; PG8_MMA(0, 0, At, B0); PG8_MMA(0, 1, At, B1); PG8_BAR; PG8_SCHED;
            PG8_LDA(At, 1, 1); PG8_STAGE(PG8_SB(1, 0), b3, voffB); PG8_STAGE(PG8_SB(1, 1), b3 + hstepB, voffB); PG8_STAGE(PG8_SA(1, 0), a3, voffA);
            PG8_WAIT_V(8); PG8_WAIT_L(0); PG8_BAR; PG8_MMA(1, 0, At, B0); PG8_MMA(1, 1, At, B1); PG8_BAR; PG8_SCHED;
            } else {
            PG8_LDB(B0, 0, 0); PG8_SCHED; PG8_LDA(At, 0, 0); PG8_STAGE(PG8_SA(1, 1), a1 + hstepA, voffA);
            PG8_WAIT_L(8); PG8_BAR; PG8_WAIT_L(0); PG8_MMA(0, 0, At, B0); PG8_BAR; PG8_SCHED;
            PG8_LDB(B1, 0, 1); PG8_STAGE(PG8_SB(0, 0), b2, voffB);
            PG8_BAR; PG8_WAIT_L(0); PG8_MMA(0, 1, At, B1); PG8_BAR;
            PG8_LDA(At, 0, 1); PG8_STAGE(PG8_SA(0, 0), a2, voffA);
            PG8_BAR; PG8_WAIT_L(0); PG8_MMA(1, 0, At, B0); PG8_BAR; PG8_SCHED;
            PG8_STAGE(PG8_SB(0, 1), b2 + hstepB, voffB);
            PG8_WAIT_V(6); PG8_BAR; PG8_MMA(1, 1, At, B1); PG8_BAR;
            PG8_LDB(B0, 1, 0); PG8_SCHED; PG8_LDA(At, 1, 0); PG8_STAGE(PG8_SA(0, 1), a2 + hstepA, voffA);
            PG8_WAIT_L(8); PG8_BAR; PG8_WAIT_L(0); PG8_MMA(0, 0, At, B0); PG8_BAR; PG8_SCHED;
            PG8_LDB(B1, 1, 1); PG8_STAGE(PG8_SB(1, 0), b3, voffB);
            PG8_BAR; PG8_WAIT_L(0); PG8_MMA(0, 1, At, B1); PG8_BAR;
            PG8_LDA(At, 1, 1); PG8_STAGE(PG8_SA(1, 0), a3, voffA);
            PG8_BAR; PG8_WAIT_L(0); PG8_MMA(1, 0, At, B0); PG8_BAR; PG8_SCHED;
            PG8_STAGE(PG8_SB(1, 1), b3 + hstepB, voffB);
            PG8_WAIT_V(6); PG8_BAR; PG8_MMA(1, 1, At, B1); PG8_BAR;
            }
        }
        if constexpr (ALIGN_EPI) { if (wr == 0) PG8_BAR; }
        if constexpr (!Epi::AFTER_DRAIN) { E(acc, cur, wr, wc, fr, fq); S.done(cur); }
        if (!has_next) break;
#pragma unroll
        for (int a = 0; a < 2; ++a)
#pragma unroll
            for (int b = 0; b < 2; ++b)
#pragma unroll
                for (int m = 0; m < 4; ++m)
#pragma unroll
                    for (int n = 0; n < 2; ++n) acc[a][b][m][n] = (f32x4){0.f, 0.f, 0.f, 0.f};
        cur = nxt; cA = nA; cB = nB; ++ui;
        if constexpr (ALIGN_EPI) { if (wr == 1) PG8_BAR; }
    }
    PG8_WAIT_V(0);
    if constexpr (!ALIGN_EPI) { if (wr == 0) PG8_BAR; }
    PG8_BAR;
    if constexpr (Epi::AFTER_DRAIN) { E.fused(acc, cur, wr, wc, fr, fq, lds, wid, lane); S.done(cur); }
#undef PG8_SA
#undef PG8_SB
#undef PG8_STAGE
#undef PG8_LDA
#undef PG8_LDB
#undef PG8_MMA
#undef PG8_WAIT_V
#undef PG8_WAIT_L
#undef PG8_BAR
#undef PG8_SCHED
}
}


namespace fp {
using s16x4 = __attribute__((ext_vector_type(4))) short;
#define SBAR() __builtin_amdgcn_sched_barrier(0)
__device__ __forceinline__ int crow(int r, int hi) { return (r & 3) + 8 * (r >> 2) + 4 * hi; }
__device__ __forceinline__ unsigned cvtpk(float lo, float hi) { unsigned r; asm volatile("v_cvt_pk_bf16_f32 %0, %1, %2" : "=v"(r) : "v"(lo), "v"(hi)); return r; }
template <int NCB> __device__ __forceinline__ int t_st(int k, int c) { const int kk = (k & ~0xC) | ((k & 4) << 1) | ((k & 8) >> 1); return ((kk >> 3) * NCB + (c >> 5)) * 512 + ((kk & 7) * 32 + (c & 31)) * 2; }
__device__ __forceinline__ int t_rd_base(int lane) { return ((lane & 3) << 3) | (((lane >> 2) & 3) << 6) | (((lane >> 4) & 1) << 5) | (((lane >> 5) & 1) << 8); }
template <int OFF> __device__ __forceinline__ s16x4 tr_read(int vb) { s16x4 r; asm volatile("ds_read_b64_tr_b16 %0, %1 offset:%2" : "=&v"(r) : "v"(vb), "i"(OFF) : "memory"); return r; }
#define TPK(L, H) (bf16x8){L[0], L[1], L[2], L[3], H[0], H[1], H[2], H[3]}

namespace att {
#ifndef ATT_K_AT
#define ATT_K_AT WS_KVRAW
#define ATT_LDK 1024
#define ATT_V_AT WS_VB
#define ATT_LDV 512
#define ATT_VOFF(h) ((h) * 64)
#endif
constexpr int NW = 8, QBLK = 32, KVBLK = 64, LDQ = 768, LDK = ATT_LDK, LDV = ATT_LDV, LDO = 1024;
#ifndef ATT_THR
#define ATT_THR 8.f
#endif
constexpr float QSCALE = 0.10206207261596575f * 1.4426950408889634f, THRL = ATT_THR * 1.4426950408889634f;
constexpr int SHM_V = 8192, SHM_K = 16384, OFF_V = 0, OFF_K = 2 * SHM_V, OFF_WS = OFF_K + 2 * SHM_K, LDS_NEED = OFF_WS + NW * 64 * 4;
#define KSWZ(row, colB) ((row) * 256 + ((colB) ^ (((row) & 7) << 4)))
__device__ __forceinline__ float max3f(float a, float b, float c) { return __builtin_fmaxf(__builtin_fmaxf(a, b), c); }
__device__ __forceinline__ void partialSM(f32x16& p0, f32x16& p1, float& mhat, f32x16& negm, float& alpha) {
    float a = max3f(p0[0], p0[1], p1[0]), b = max3f(p0[2], p0[3], p1[1]); a = max3f(a, p1[2], p1[3]);
#pragma unroll
    for (int r = 4; r < 16; r += 4) { a = max3f(a, p0[r], p0[r + 1]); b = max3f(b, p0[r + 2], p0[r + 3]); a = max3f(a, p1[r], p1[r + 1]); b = max3f(b, p1[r + 2], p1[r + 3]); }
    float rm = fmaxf(a, b);
    { auto rr = __builtin_amdgcn_permlane32_swap(__float_as_uint(rm), __float_as_uint(rm), false, false); rm = fmaxf(__uint_as_float(rr[0]), __uint_as_float(rr[1])); }
    if (__builtin_expect(__all(rm <= THRL), 1)) { alpha = 1.f; }
    else { const float dl = fmaxf(rm, 0.f); mhat += dl; alpha = __builtin_amdgcn_exp2f(-dl);
#pragma unroll
        for (int r = 0; r < 16; ++r) { p0[r] -= dl; p1[r] -= dl; }
#pragma unroll
        for (int r = 0; r < 16; ++r) negm[r] = -mhat; }
#pragma unroll
    for (int r = 0; r < 16; ++r) p0[r] = __builtin_amdgcn_exp2f(p0[r]);
}
__device__ __forceinline__ void finishSM(f32x16& p0, f32x16& p1, float alpha, float& l_reg, bf16x8& pa0, bf16x8& pa1, bf16x8& pa2, bf16x8& pa3) {
#pragma unroll
    for (int r = 0; r < 16; ++r) p1[r] = __builtin_amdgcn_exp2f(p1[r]);
    float ps = 0;
#pragma unroll
    for (int r = 0; r < 16; ++r) ps += p0[r];
#pragma unroll
    for (int r = 0; r < 16; ++r) ps += p1[r];
    { auto rr = __builtin_amdgcn_permlane32_swap(__float_as_uint(ps), __float_as_uint(ps), false, false); ps = __uint_as_float(rr[0]) + __uint_as_float(rr[1]); }
    l_reg = l_reg * alpha + ps;
#define PK4(P, BASE, OUT) do { unsigned a0 = cvtpk(P[BASE + 0], P[BASE + 1]), a1 = cvtpk(P[BASE + 2], P[BASE + 3]);   \
    unsigned b0 = cvtpk(P[BASE + 4], P[BASE + 5]), b1 = cvtpk(P[BASE + 6], P[BASE + 7]);                              \
    auto r0 = __builtin_amdgcn_permlane32_swap(a0, b0, false, false); auto r1 = __builtin_amdgcn_permlane32_swap(a1, b1, false, false); \
    u32x4 w = {r0[0], r1[0], r0[1], r1[1]}; OUT = *reinterpret_cast<bf16x8*>(&w); } while (0)
    PK4(p0, 0, pa0); PK4(p0, 8, pa1); PK4(p1, 0, pa2); PK4(p1, 8, pa3);
#undef PK4
}
__device__ __forceinline__ void qkt(f32x16& p0, f32x16& p1, const char* Ks, const bf16x8* qr, const f32x16& negm, int r32, int hi) {
#pragma unroll
    for (int d0 = 0; d0 < 6; ++d0) { const int cb = (d0 * 16 + hi * 8) * 2;
        const bf16x8 b0 = *reinterpret_cast<const bf16x8*>(Ks + KSWZ(r32, cb));
        const bf16x8 b1 = *reinterpret_cast<const bf16x8*>(Ks + KSWZ(32 + r32, cb));
        if (d0 == 0) { p0 = __builtin_amdgcn_mfma_f32_32x32x16_bf16(b0, qr[0], negm, 0, 0, 0); p1 = __builtin_amdgcn_mfma_f32_32x32x16_bf16(b1, qr[0], negm, 0, 0, 0); }
        else { p0 = __builtin_amdgcn_mfma_f32_32x32x16_bf16(b0, qr[d0], p0, 0, 0, 0); p1 = __builtin_amdgcn_mfma_f32_32x32x16_bf16(b1, qr[d0], p1, 0, 0, 0); } }
}
constexpr int v_rd_off(int d0, int ks, int half) { return d0 * 512 + ks * 2048 + half * 1024; }
template <int D0> __device__ __forceinline__ void pv_one(f32x16& od, int vb, bf16x8 pa0, bf16x8 pa1, bf16x8 pa2, bf16x8 pa3) {
    const s16x4 l0 = tr_read<v_rd_off(D0, 0, 0)>(vb), h0 = tr_read<v_rd_off(D0, 0, 1)>(vb), l1 = tr_read<v_rd_off(D0, 1, 0)>(vb), h1 = tr_read<v_rd_off(D0, 1, 1)>(vb);
    const s16x4 l2 = tr_read<v_rd_off(D0, 2, 0)>(vb), h2 = tr_read<v_rd_off(D0, 2, 1)>(vb), l3 = tr_read<v_rd_off(D0, 3, 0)>(vb), h3 = tr_read<v_rd_off(D0, 3, 1)>(vb);
    asm volatile("s_waitcnt lgkmcnt(0)" ::: "memory"); SBAR();
    od = __builtin_amdgcn_mfma_f32_32x32x16_bf16(pa0, TPK(l0, h0), od, 0, 0, 0);
    od = __builtin_amdgcn_mfma_f32_32x32x16_bf16(pa1, TPK(l1, h1), od, 0, 0, 0);
    od = __builtin_amdgcn_mfma_f32_32x32x16_bf16(pa2, TPK(l2, h2), od, 0, 0, 0);
    od = __builtin_amdgcn_mfma_f32_32x32x16_bf16(pa3, TPK(l3, h3), od, 0, 0, 0);
}
__device__ __forceinline__ void pv_d0(f32x16* o, int vb, bf16x8 pa0, bf16x8 pa1, bf16x8 pa2, bf16x8 pa3) { pv_one<0>(o[0], vb, pa0, pa1, pa2, pa3); pv_one<1>(o[1], vb, pa0, pa1, pa2, pa3); }

__device__ __forceinline__ void attn_unit(const bf16_t* __restrict__ Qb, const bf16_t* __restrict__ Kh, const bf16_t* __restrict__ Vh, bf16_t* __restrict__ Ob, int q0, char* lds) {
    const int tid = threadIdx.x, wid = tid >> 6, lane = tid & 63, r32 = lane & 31, hi = lane >> 5;
    char* V_lds = lds + OFF_V; char* K_lds = lds + OFF_K;
    float* wsf = (float*)(lds + OFF_WS) + wid * 64; float* li_l = wsf; float* al_l = wsf + 32;
    float mhat = 0.f, l_reg = 0; f32x16 o[2] = {}; bf16x8 qr[6]; f32x16 negm = {};
    const bf16_t* Qw = Qb + (long)(wid * QBLK + r32) * LDQ + hi * 8;
#pragma unroll
    for (int d0 = 0; d0 < 6; ++d0) qr[d0] = *reinterpret_cast<const bf16x8*>(Qw + d0 * 16);
    const int srow = tid >> 3, sch = tid & 7;
    const int vst = t_st<2>(srow, sch * 8), kst0 = KSWZ(srow, sch * 16), kst1 = KSWZ(srow, (sch + 8) * 16);
    const int vb0 = (int)(uintptr_t)V_lds + t_rd_base(lane);
    const int koff1 = (sch & 4) ? 32 : 64;
    struct { bf16x8 k0, k1, v0; } sr_[1];
#define SLOAD(i, key0) do { const bf16_t* kp_ = Kh + (long)((key0) + srow) * LDK + sch * 8; sr_[i].k0 = *reinterpret_cast<const bf16x8*>(kp_); sr_[i].k1 = *reinterpret_cast<const bf16x8*>(kp_ + koff1); \
    sr_[i].v0 = *reinterpret_cast<const bf16x8*>(Vh + (long)((key0) + srow) * LDV + sch * 8); } while (0)
#define SWRITE(b, i) do { *(bf16x8*)(K_lds + (b) * SHM_K + kst0) = sr_[i].k0; *(bf16x8*)(K_lds + (b) * SHM_K + kst1) = sr_[i].k1; *(bf16x8*)(V_lds + (b) * SHM_V + vst) = sr_[i].v0; } while (0)
#define SWAIT() asm volatile("s_waitcnt vmcnt(0)" ::: "memory")
#define RESC(a) do { if (__any((a) < 1.f)) { if (hi == 0) al_l[r32] = (a); asm volatile("s_waitcnt lgkmcnt(0)" ::: "memory"); \
    _Pragma("unroll") for (int d = 0; d < 2; ++d) _Pragma("unroll") for (int r = 0; r < 16; ++r) o[d][r] *= al_l[crow(r, hi)]; } } while (0)
#define MASKT(P0, P1, t) do { if ((t) > tmaxw) { _Pragma("unroll") for (int r = 0; r < 16; ++r) { P0[r] = -1e30f; P1[r] = -1e30f; } } } while (0)
    f32x16 pA0, pA1, pB0, pB1; float alA, alB; bf16x8 pa0, pa1, pa2, pa3;
    const int NT = q0 / KVBLK + 4; const int tmaxw = (q0 + wid * QBLK) / KVBLK;
    constexpr int SE = 0, SO = 0;
    SLOAD(SE, 0); asm volatile("s_waitcnt vmcnt(0)" ::: "memory"); SWRITE(0, SE); __syncthreads();
    qkt(pA0, pA1, K_lds, qr, negm, r32, hi); partialSM(pA0, pA1, mhat, negm, alA);
    SLOAD(SO, KVBLK);
    SWAIT(); SWRITE(1, SO); __syncthreads();
    for (int j = 1; j + 1 < NT; j += 2) {
        SBAR(); qkt(pB0, pB1, K_lds + SHM_K, qr, negm, r32, hi); MASKT(pB0, pB1, j);
        finishSM(pA0, pA1, alA, l_reg, pa0, pa1, pa2, pa3); SBAR();
        SLOAD(SO, (j + 1) * KVBLK); SBAR();
        pv_d0(o, vb0, pa0, pa1, pa2, pa3); partialSM(pB0, pB1, mhat, negm, alB);
        __syncthreads(); SWAIT(); SWRITE(0, SE);
        RESC(alB); __syncthreads();
        SBAR(); qkt(pA0, pA1, K_lds, qr, negm, r32, hi); MASKT(pA0, pA1, j + 1);
        finishSM(pB0, pB1, alB, l_reg, pa0, pa1, pa2, pa3); SBAR();
        SLOAD(SE, (j + 2) * KVBLK); SBAR();
        pv_d0(o, vb0 + SHM_V, pa0, pa1, pa2, pa3); partialSM(pA0, pA1, mhat, negm, alA);
        __syncthreads(); SWAIT(); SWRITE(1, SO);
        RESC(alA); __syncthreads();
    }
    SBAR(); qkt(pB0, pB1, K_lds + SHM_K, qr, negm, r32, hi); MASKT(pB0, pB1, NT - 1);
    finishSM(pA0, pA1, alA, l_reg, pa0, pa1, pa2, pa3); SBAR();
    pv_d0(o, vb0, pa0, pa1, pa2, pa3); partialSM(pB0, pB1, mhat, negm, alB);
    __syncthreads(); RESC(alB);
    finishSM(pB0, pB1, alB, l_reg, pa0, pa1, pa2, pa3); SBAR();
    pv_d0(o, vb0 + SHM_V, pa0, pa1, pa2, pa3);
    if (hi == 0) li_l[r32] = l_reg; asm volatile("s_waitcnt lgkmcnt(0)" ::: "memory");
    float rli[16];
#pragma unroll
    for (int r = 0; r < 16; ++r) rli[r] = __builtin_amdgcn_rcpf(li_l[crow(r, hi)]);
    bf16_t* Ow = Ob + (long)(wid * QBLK) * LDO;
#pragma unroll
    for (int r = 0; r < 16; ++r) { const int orow = crow(r, hi);
#pragma unroll
        for (int d0 = 0; d0 < 2; ++d0) Ow[(long)orow * LDO + d0 * 32 + r32] = f2bf(o[d0][r] * rli[r]); }
    __syncthreads();
#undef SLOAD
#undef SWRITE
#undef SWAIT
#undef RESC
#undef MASKT
}
__device__ __forceinline__ void attn_phase(unsigned char* ws, char* lds, int vcu, int G) {
    const bf16_t* q = (const bf16_t*)(ws + WS_QRAW); const bf16_t* k = (const bf16_t*)(ws + ATT_K_AT); const bf16_t* v = (const bf16_t*)(ws + ATT_V_AT);
#ifdef ATT_DEBUG_ALT
    bf16_t* mix = (bf16_t*)(ws + WS_XB);
#else
    bf16_t* mix = (bf16_t*)(ws + WS_MIX);
#endif
    if (__builtin_amdgcn_readfirstlane(threadIdx.x) >= 256) __builtin_amdgcn_s_setprio(1);
    for (int pi = vcu; pi < 256; pi += G) {
        const int bh = pi >> 3, s = pi & 7, b = bh >> 3, h = bh & 7;
        const size_t rb = (size_t)b * SEQ;
#pragma unroll 1
        for (int u = 0; u < 2; ++u) { const int qb = u ? 15 - s : s, q0 = qb * 256;
#ifdef ATT_QBMASK
            if (!((ATT_QBMASK >> qb) & 1)) continue;
#endif
            attn_unit(q + (rb + q0) * LDQ + h * 96, k + rb * LDK + h * 96, v + rb * LDV + ATT_VOFF(h), mix + (rb + q0) * LDO + 512 + h * 64, q0, lds); }
    }
    __builtin_amdgcn_s_setprio(0);
}
#undef KSWZ
}

template <int CTRL> __device__ __forceinline__ float dppf(float x) { return __builtin_bit_cast(float, __builtin_amdgcn_update_dpp(0, __builtin_bit_cast(int, x), CTRL, 0xF, 0xF, true)); }
__device__ __forceinline__ float sum8(float x) { x += dppf<0xB1>(x); x += dppf<0x4E>(x); x += dppf<0x141>(x); return x; }
__device__ __forceinline__ float sum64(float x) { x = sum8(x); x += dppf<0x140>(x);
    { auto rr = __builtin_amdgcn_permlane16_swap(__float_as_uint(x), __float_as_uint(x), false, false); x = __uint_as_float(rr[0]) + __uint_as_float(rr[1]); }
    { auto rr = __builtin_amdgcn_permlane32_swap(__float_as_uint(x), __float_as_uint(x), false, false); x = __uint_as_float(rr[0]) + __uint_as_float(rr[1]); } return x; }
__device__ __forceinline__ float lo16(unsigned u) { return __uint_as_float(u << 16); }
__device__ __forceinline__ float hi16(unsigned u) { return __uint_as_float(u & 0xffff0000u); }
__device__ __forceinline__ float sq8(u32x4 w) { float s = 0.f; s += lo16(w.x) * lo16(w.x) + hi16(w.x) * hi16(w.x); s += lo16(w.y) * lo16(w.y) + hi16(w.y) * hi16(w.y); s += lo16(w.z) * lo16(w.z) + hi16(w.z) * hi16(w.z); s += lo16(w.w) * lo16(w.w) + hi16(w.w) * hi16(w.w); return s; }


namespace mlaf {
constexpr int PQ = 784, PKV = 528;
__device__ __forceinline__ float sq8b(bf16x8 v) { const u32x4 w = *reinterpret_cast<const u32x4*>(&v); return sq8(w); }
#define TRIG(cs_, sn_, rev_) asm volatile("v_cos_f32 %0, %2\n\tv_sin_f32 %1, %2\n\ts_nop 7\n\ts_nop 7\n\ts_nop 7" : "=&v"(cs_), "=&v"(sn_) : "v"(rev_))
__device__ __forceinline__ float rsq_guarded(float x) { float r; asm volatile("v_rsq_f32 %0, %1\n\ts_nop 7\n\ts_nop 7" : "=&v"(r) : "v"(x)); return r; }
__device__ __forceinline__ float swap32_sum(float x) { auto rr = __builtin_amdgcn_permlane32_swap(__float_as_uint(x), __float_as_uint(x), false, false); return __uint_as_float(rr[0]) + __uint_as_float(rr[1]); }
struct Ctx { const bf16_t* zb; bf16_t* qo; bf16_t* ko; bf16_t* vo; char* lds; const float* qn; const float* kn; const float* invm; int h, r32, hi; };
constexpr int WBUF = 96 * PQ;
static_assert(128 * PKV <= WBUF && 2 * WBUF <= 160 * 1024 - 2048, "two weight buffers fit the LDS");
__device__ __forceinline__ void ld_wq(const bf16_t* Wq, int h, int tid, bf16x8 (&w)[9]) {
#pragma unroll
    for (int i = 0; i < 9; ++i) { const int cc = tid + 512 * i, n = cc / 48, kc = cc % 48; w[i] = *reinterpret_cast<const bf16x8*>(Wq + (size_t)(96 * h + n) * 384 + 8 * kc); } }
__device__ __forceinline__ void st_wq(char* buf, int tid, const bf16x8 (&w)[9]) {
#pragma unroll
    for (int i = 0; i < 9; ++i) { const int cc = tid + 512 * i, n = cc / 48, kc = cc % 48; *(bf16x8*)(buf + n * PQ + 16 * kc) = w[i]; } }
__device__ __forceinline__ void ld_wkv(const bf16_t* Wkv, int h, int tid, bf16x8 (&w)[8]) {
#pragma unroll
    for (int i = 0; i < 8; ++i) { const int cc = tid + 512 * i, n = cc >> 5, kc = cc & 31; w[i] = *reinterpret_cast<const bf16x8*>(Wkv + (size_t)(128 * h + n) * 256 + 8 * kc); } }
__device__ __forceinline__ void st_wkv(char* buf, int tid, const bf16x8 (&w)[8]) {
#pragma unroll
    for (int i = 0; i < 8; ++i) { const int cc = tid + 512 * i, n = cc >> 5, kc = cc & 31; *(bf16x8*)(buf + n * PKV + 16 * kc) = w[i]; } }
__device__ __forceinline__ void q_epi(const Ctx& c, int h, int tok, float pos, float rq, const f32x16& a0, const f32x16& a1, const f32x16& a2) {
    const int hi = c.hi;
    float s = 0.f;
#pragma unroll
    for (int r = 0; r < 16; ++r) s += a0[r] * a0[r] + a1[r] * a1[r] + a2[r] * a2[r];
    const float rn = rsq_guarded(swap32_sum(s) * (rq * rq) * (1.f / MQK) + EPS) * (att::QSCALE * rq);
    bf16_t* qrow = c.qo + (size_t)tok * 768 + h * 96 + 4 * hi; const float* gq = c.qn + 4 * hi;
#pragma unroll
    for (int g = 0; g < 4; ++g) { const f32x4 gn = *(const f32x4*)(gq + 8 * g);
        u32x2 w; w.x = cvtpk(a0[4 * g] * rn * gn[0], a0[4 * g + 1] * rn * gn[1]); w.y = cvtpk(a0[4 * g + 2] * rn * gn[2], a0[4 * g + 3] * rn * gn[3]);
        *(u32x2*)(qrow + 8 * g) = w; asm volatile("" ::: "memory"); }
#pragma unroll
    for (int g = 0; g < 4; ++g) { const f32x4 gn = *(const f32x4*)(gq + 32 + 8 * g);
        u32x2 w; w.x = cvtpk(a1[4 * g] * rn * gn[0], a1[4 * g + 1] * rn * gn[1]); w.y = cvtpk(a1[4 * g + 2] * rn * gn[2], a1[4 * g + 3] * rn * gn[3]);
        *(u32x2*)(qrow + 32 + 8 * g) = w; asm volatile("" ::: "memory"); }
#pragma unroll
    for (int g = 0; g < 2; ++g) { const f32x4 g1 = *(const f32x4*)(gq + 64 + 8 * g), g2 = *(const f32x4*)(gq + 80 + 8 * g), iv = *(const f32x4*)(c.invm + 4 * hi + 8 * g);
        float o1[4], o2[4];
#pragma unroll
        for (int j = 0; j < 4; ++j) { const float x1 = a2[4 * g + j] * rn * g1[j], x2 = a2[4 * g + 8 + j] * rn * g2[j];
            const float rev = __builtin_amdgcn_fractf(pos * iv[j]); float cs, sn; TRIG(cs, sn, rev);
            o1[j] = x1 * cs - x2 * sn; o2[j] = x2 * cs + x1 * sn; }
        u32x2 w; w.x = cvtpk(o1[0], o1[1]); w.y = cvtpk(o1[2], o1[3]); *(u32x2*)(qrow + 64 + 8 * g) = w;
        w.x = cvtpk(o2[0], o2[1]); w.y = cvtpk(o2[2], o2[3]); *(u32x2*)(qrow + 80 + 8 * g) = w; asm volatile("" ::: "memory"); }
}
__device__ __forceinline__ void kv_epi(const Ctx& c, int h, int tok, float pos, float rk, const float (&pf)[4][4], float sp, const f32x16& a0, const f32x16& a1, const f32x16& a2, const f32x16& a3) {
    const int hi = c.hi;
    float s = 0.f;
#pragma unroll
    for (int r = 0; r < 16; ++r) s += a0[r] * a0[r] + a1[r] * a1[r];
    const float rp = rsq_guarded(swap32_sum(s * (rk * rk) + sp) * (1.f / MQK) + EPS), rn = rp * rk;
    bf16_t* krow = c.ko + (size_t)tok * 1024 + h * 96 + 4 * hi; bf16_t* vrow = c.vo + (size_t)tok * 512 + h * 64 + 4 * hi; const float* gk = c.kn + 4 * hi;
#pragma unroll
    for (int g = 0; g < 4; ++g) { const f32x4 gn = *(const f32x4*)(gk + 8 * g);
        u32x2 w; w.x = cvtpk(a0[4 * g] * rn * gn[0], a0[4 * g + 1] * rn * gn[1]); w.y = cvtpk(a0[4 * g + 2] * rn * gn[2], a0[4 * g + 3] * rn * gn[3]);
        *(u32x2*)(krow + 8 * g) = w; asm volatile("" ::: "memory"); }
#pragma unroll
    for (int g = 0; g < 4; ++g) { const f32x4 gn = *(const f32x4*)(gk + 32 + 8 * g);
        u32x2 w; w.x = cvtpk(a1[4 * g] * rn * gn[0], a1[4 * g + 1] * rn * gn[1]); w.y = cvtpk(a1[4 * g + 2] * rn * gn[2], a1[4 * g + 3] * rn * gn[3]);
        *(u32x2*)(krow + 32 + 8 * g) = w; asm volatile("" ::: "memory"); }
#pragma unroll
    for (int g = 0; g < 2; ++g) { const f32x4 g1 = *(const f32x4*)(gk + 64 + 8 * g), g2 = *(const f32x4*)(gk + 80 + 8 * g), iv = *(const f32x4*)(c.invm + 4 * hi + 8 * g);
        float o1[4], o2[4];
#pragma unroll
        for (int j = 0; j < 4; ++j) { const float x1 = pf[g][j] * rp * g1[j], x2 = pf[g + 2][j] * rp * g2[j];
            const float rev = __builtin_amdgcn_fractf(pos * iv[j]); float cs, sn; TRIG(cs, sn, rev);
            o1[j] = x1 * cs - x2 * sn; o2[j] = x2 * cs + x1 * sn; }
        u32x2 w; w.x = cvtpk(o1[0], o1[1]); w.y = cvtpk(o1[2], o1[3]); *(u32x2*)(krow + 64 + 8 * g) = w;
        w.x = cvtpk(o2[0], o2[1]); w.y = cvtpk(o2[2], o2[3]); *(u32x2*)(krow + 80 + 8 * g) = w; asm volatile("" ::: "memory"); }
#pragma unroll
    for (int g = 0; g < 4; ++g) { u32x2 w; w.x = cvtpk(a2[4 * g] * rk, a2[4 * g + 1] * rk); w.y = cvtpk(a2[4 * g + 2] * rk, a2[4 * g + 3] * rk); *(u32x2*)(vrow + 8 * g) = w;
        w.x = cvtpk(a3[4 * g] * rk, a3[4 * g + 1] * rk); w.y = cvtpk(a3[4 * g + 2] * rk, a3[4 * g + 3] * rk); *(u32x2*)(vrow + 32 + 8 * g) = w; asm volatile("" ::: "memory"); }
}
__device__ __forceinline__ void mla_fused_phase(const Ptrs& p, const bf16_t* Wq, const bf16_t* Wkv, char* lds, int vcu) {
    const int tid = threadIdx.x, wid = tid >> 6, lane = tid & 63, r32 = lane & 31, hi = lane >> 5;
    Ctx c; c.zb = (const bf16_t*)(p.ws + WS_ZB); c.qo = (bf16_t*)(p.ws + WS_QRAW); c.ko = (bf16_t*)(p.ws + WS_KVRAW); c.vo = (bf16_t*)(p.ws + WS_VB); c.lds = lds;
    c.qn = p.in[IN_Q_NORM]; c.kn = p.in[IN_K_NORM]; c.invm = (const float*)(p.ws + WS_INVM);
    c.r32 = r32; c.hi = hi; c.h = 0;
    const int h0 = 2 * (vcu & 3), pm = 8 * (vcu >> 5) + ((vcu & 31) >> 2), tok = 256 * pm + 32 * wid + r32;
    const bf16_t* arow = c.zb + (size_t)tok * ZLD + 8 * hi;
    const float pos = (float)(tok & (SEQ - 1));
    char* buf0 = lds; char* buf1 = lds + WBUF;
    constexpr int DQ = 8, DK = 4;
    bf16x8 af[DQ];
#pragma unroll
    for (int i = 0; i < DQ; ++i) af[i] = *reinterpret_cast<const bf16x8*>(arow + ZO_CQ + 16 * i);
    { bf16x8 w[9]; ld_wq(Wq, h0, tid, w); st_wq(buf0, tid, w); }
    { bf16x8 w[9]; ld_wq(Wq, h0 + 1, tid, w); st_wq(buf1, tid, w); }
    __syncthreads();
    bf16x8 wk0[8], wk1[8];
    {
        f32x16 acc[6] = {}; float ssa = 0.f;
        const char* wb0 = buf0 + r32 * PQ + 16 * hi; const char* wb1 = buf1 + r32 * PQ + 16 * hi;
#pragma unroll
        for (int ks = 0; ks < 24; ++ks) { const bf16x8 cur = af[ks % DQ]; ssa += sq8b(cur);
#pragma unroll
            for (int tt = 0; tt < 3; ++tt) { acc[tt] = __builtin_amdgcn_mfma_f32_32x32x16_bf16(*reinterpret_cast<const bf16x8*>(wb0 + tt * 32 * PQ + 32 * ks), cur, acc[tt], 0, 0, 0);
                acc[3 + tt] = __builtin_amdgcn_mfma_f32_32x32x16_bf16(*reinterpret_cast<const bf16x8*>(wb1 + tt * 32 * PQ + 32 * ks), cur, acc[3 + tt], 0, 0, 0); }
            if (ks + DQ < 24) af[ks % DQ] = *reinterpret_cast<const bf16x8*>(arow + ZO_CQ + 16 * (ks + DQ)); }
        ld_wkv(Wkv, h0, tid, wk0); ld_wkv(Wkv, h0 + 1, tid, wk1);
        const float rq = rsq_guarded(swap32_sum(ssa) * (1.f / MQR) + EPS);
        q_epi(c, h0, tok, pos, rq, acc[0], acc[1], acc[2]);
        q_epi(c, h0 + 1, tok, pos, rq, acc[3], acc[4], acc[5]);
    }
    __syncthreads();
    st_wkv(buf0, tid, wk0); st_wkv(buf1, tid, wk1);
    bf16x8 ak[DK];
#pragma unroll
    for (int i = 0; i < DK; ++i) ak[i] = *reinterpret_cast<const bf16x8*>(arow + ZO_CKV + 16 * i);
    u32x2 pe[4];
#pragma unroll
    for (int g = 0; g < 4; ++g) pe[g] = *(const u32x2*)(c.zb + (size_t)tok * ZLD + ZO_KPE + 8 * g + 4 * hi);
    __syncthreads();
    {
        f32x16 acc[8] = {}; float ssk = 0.f;
        const char* wb0 = buf0 + r32 * PKV + 16 * hi; const char* wb1 = buf1 + r32 * PKV + 16 * hi;
#pragma unroll
        for (int ks = 0; ks < 16; ++ks) { const bf16x8 cur = ak[ks % DK]; ssk += sq8b(cur);
#pragma unroll
            for (int tt = 0; tt < 4; ++tt) { acc[tt] = __builtin_amdgcn_mfma_f32_32x32x16_bf16(*reinterpret_cast<const bf16x8*>(wb0 + tt * 32 * PKV + 32 * ks), cur, acc[tt], 0, 0, 0);
                acc[4 + tt] = __builtin_amdgcn_mfma_f32_32x32x16_bf16(*reinterpret_cast<const bf16x8*>(wb1 + tt * 32 * PKV + 32 * ks), cur, acc[4 + tt], 0, 0, 0); }
            if (ks + DK < 16) ak[ks % DK] = *reinterpret_cast<const bf16x8*>(arow + ZO_CKV + 16 * (ks + DK)); }
        const float rk = rsq_guarded(swap32_sum(ssk) * (1.f / MKVR) + EPS);
        float pf[4][4], sp = 0.f;
#pragma unroll
        for (int g = 0; g < 4; ++g) { pf[g][0] = __uint_as_float(pe[g].x << 16); pf[g][1] = __uint_as_float(pe[g].x & 0xffff0000u); pf[g][2] = __uint_as_float(pe[g].y << 16); pf[g][3] = __uint_as_float(pe[g].y & 0xffff0000u);
            sp += (pf[g][0] * pf[g][0] + pf[g][1] * pf[g][1]) + (pf[g][2] * pf[g][2] + pf[g][3] * pf[g][3]); }
        kv_epi(c, h0, tok, pos, rk, pf, sp, acc[0], acc[1], acc[2], acc[3]);
        kv_epi(c, h0 + 1, tok, pos, rk, pf, sp, acc[4], acc[5], acc[6], acc[7]);
    }
    __syncthreads();
}
}

__device__ __forceinline__ void gating_phase(const Ptrs& p, char* lds, int vcu, int G) {
    const int tid = threadIdx.x, wid = tid >> 6, lane = tid & 63, r32 = lane & 31, hi = lane >> 5;
    const bf16_t* zb = (const bf16_t*)(p.ws + WS_ZB); bf16_t* mix = (bf16_t*)(p.ws + WS_MIX); const bf16_t* Wsp = (const bf16_t*)(p.ws + WS_WSP);
    const int vb = (int)(uintptr_t)lds + t_rd_base(lane);
    for (int it2 = 0; it2 < 2; ++it2) {
        const int k = 2 * (vcu & 31) + it2, g = k & 3, blk = 16 * (vcu >> 5) + (k >> 2), row0 = blk * 128;
        {
            const int r = tid >> 2, qd = tid & 3; const bf16_t* vr = zb + (size_t)(row0 + r) * ZLD + ZO_V + g * 128 + qd * 32; const float* vn = p.in[IN_GM_V_NORM] + g * 128 + qd * 32;
            bf16x8 x[4]; float s = 0.f;
#pragma unroll
            for (int i = 0; i < 4; ++i) { x[i] = *reinterpret_cast<const bf16x8*>(vr + i * 8);
#pragma unroll
                for (int u = 0; u < 8; ++u) { const float f = bf2f((bf16_t)x[i][u]); s += f * f; } }
            s += __shfl_xor(s, 1); s += __shfl_xor(s, 2);
            const float rn = rsqrtf(s * (1.f / 128.f) + EPS);
#pragma unroll
            for (int i = 0; i < 4; ++i) { u32x4 w; const f32x4 g0 = *(const f32x4*)(vn + i * 8), g1 = *(const f32x4*)(vn + i * 8 + 4);
                w.x = pk2(bf2f((bf16_t)x[i][0]) * rn * g0[0], bf2f((bf16_t)x[i][1]) * rn * g0[1]); w.y = pk2(bf2f((bf16_t)x[i][2]) * rn * g0[2], bf2f((bf16_t)x[i][3]) * rn * g0[3]);
                w.z = pk2(bf2f((bf16_t)x[i][4]) * rn * g1[0], bf2f((bf16_t)x[i][5]) * rn * g1[1]); w.w = pk2(bf2f((bf16_t)x[i][6]) * rn * g1[2], bf2f((bf16_t)x[i][7]) * rn * g1[3]);
                *(u32x4*)(lds + t_st<4>(r, qd * 32 + i * 8)) = w; }
        }
        __syncthreads();
        const int mt = wid >> 1, cb0 = (wid & 1) * 2;
        f32x16 acc0 = {}, acc1 = {};
        const bf16_t* wrow = Wsp + (size_t)g * 16384 + (size_t)(mt * 32 + r32) * 128 + hi * 8;
        const int nks = (mt < 2) ? 4 : 8;
        bf16x8 afr[8];
#pragma unroll
        for (int ks = 0; ks < 8; ++ks) afr[ks] = *reinterpret_cast<const bf16x8*>(wrow + ks * 16);
        const float* bs = p.in[IN_GM_B_S] + g * 128 + mt * 32;
        bf16_t ur0[16], ur1[16]; float br[16];
#pragma unroll
        for (int r = 0; r < 16; ++r) { const int t = crow(r, hi); const size_t row = (size_t)(row0 + mt * 32 + t); const int c0 = g * 128 + cb0 * 32 + r32;
            ur0[r] = zb[row * ZLD + ZO_U + c0]; ur1[r] = zb[row * ZLD + ZO_U + c0 + 32]; br[r] = bs[t]; }
#pragma unroll
        for (int ks = 0; ks < 8; ++ks) { if (ks < nks) {
            const bf16x8 a = afr[ks];
            s16x4 l0, h0, l1, h1; const int off = vb + ks * 4096 + cb0 * 512;
            asm volatile("ds_read_b64_tr_b16 %0, %1" : "=&v"(l0) : "v"(off) : "memory"); asm volatile("ds_read_b64_tr_b16 %0, %1 offset:2048" : "=&v"(h0) : "v"(off) : "memory");
            asm volatile("ds_read_b64_tr_b16 %0, %1 offset:512" : "=&v"(l1) : "v"(off) : "memory"); asm volatile("ds_read_b64_tr_b16 %0, %1 offset:2560" : "=&v"(h1) : "v"(off) : "memory");
            asm volatile("s_waitcnt lgkmcnt(0)" ::: "memory"); SBAR();
            acc0 = __builtin_amdgcn_mfma_f32_32x32x16_bf16(a, TPK(l0, h0), acc0, 0, 0, 0);
            acc1 = __builtin_amdgcn_mfma_f32_32x32x16_bf16(a, TPK(l1, h1), acc1, 0, 0, 0); } }
#pragma unroll
        for (int r = 0; r < 16; ++r) { const int t = crow(r, hi); const float b = br[r]; const size_t row = (size_t)(row0 + mt * 32 + t);
            const int c0 = g * 128 + cb0 * 32 + r32;
            const float u0 = bf2f(ur0[r]), u1 = bf2f(ur1[r]);
            mix[row * 1024 + c0] = f2bf(u0 * (acc0[r] + b)); mix[row * 1024 + c0 + 32] = f2bf(u1 * (acc1[r] + b)); }
        __syncthreads();
    }
}

__device__ __forceinline__ void amat_phase(unsigned char* ws, int gw, int ngw, int lane) {
    const int r32 = lane & 31, hi = lane >> 5;
    {
        const int x = gw >> 8, wl = gw & 255, il = wl >> 1, mt = wl & 1, h = il & 3, chunk = 32 * (x & 1) + (il >> 2), b = x >> 1, bh = b * 4 + h, item = bh * 64 + chunk;
        const size_t row0 = (size_t)b * SEQ + chunk * 64;
        const bf16_t* qp = (const bf16_t*)(ws + WS_QP) + (row0 + mt * 32 + r32) * 1024 + h * 256 + hi * 8;
        const bf16_t* kp = (const bf16_t*)(ws + WS_KPP) + (row0 + r32) * 1024 + h * 256 + hi * 8;
        f32x16 a0 = {}, a1 = {};
#pragma unroll 4
        for (int ks = 0; ks < 16; ++ks) { const bf16x8 a = *reinterpret_cast<const bf16x8*>(qp + ks * 16);
            const u32x4 k0 = *reinterpret_cast<const u32x4*>(kp + ks * 16), k1 = *reinterpret_cast<const u32x4*>(kp + 32 * 1024 + ks * 16);
            auto s0 = __builtin_amdgcn_permlane32_swap(k0.x, k0.z, false, false); auto s1 = __builtin_amdgcn_permlane32_swap(k0.y, k0.w, false, false);
            auto s2 = __builtin_amdgcn_permlane32_swap(k1.x, k1.z, false, false); auto s3 = __builtin_amdgcn_permlane32_swap(k1.y, k1.w, false, false);
            u32x4 w0 = {s0[0], s1[0], s0[1], s1[1]}, w1 = {s2[0], s3[0], s2[1], s3[1]};
            a0 = __builtin_amdgcn_mfma_f32_32x32x16_bf16(a, *reinterpret_cast<bf16x8*>(&w0), a0, 0, 0, 0); a1 = __builtin_amdgcn_mfma_f32_32x32x16_bf16(a, *reinterpret_cast<bf16x8*>(&w1), a1, 0, 0, 0); }
        bf16_t* A = (bf16_t*)(ws + WS_AMAT) + (size_t)item * 4096;
#pragma unroll
        for (int r = 0; r < 16; ++r) { const int j = mt * 32 + crow(r, hi); const int m0 = r32, m1 = 32 + r32;
            A[j * 64 + m0] = (j >= m0) ? f2bf(a0[r]) : (bf16_t)0; A[j * 64 + m1] = (j >= m1) ? f2bf(a1[r]) : (bf16_t)0; }
    }
}
namespace scan {
constexpr int KSL = 4160;
constexpr int OFF_K = 0, OFF_V = 2 * 8 * KSL, OFF_RED = OFF_V + 2 * 4096, OFF_OT = OFF_RED + 2 * 32768, OFF_SS = OFF_OT + 2 * 4096, LDS_NEED = OFF_SS + 2 * 256;
template <int CTRL> __device__ __forceinline__ float dpp_f(float x) { return __builtin_bit_cast(float, __builtin_amdgcn_update_dpp(0, __builtin_bit_cast(int, x), CTRL, 0xF, 0xF, true)); }
__device__ __forceinline__ float sum32(float x) {
    x += dpp_f<0xB1>(x); x += dpp_f<0x4E>(x); x += dpp_f<0x141>(x); x += dpp_f<0x140>(x);
    auto rr = __builtin_amdgcn_permlane16_swap(__float_as_uint(x), __float_as_uint(x), false, false);
    return __uint_as_float(rr[0]) + __uint_as_float(rr[1]);
}
struct Stage { bf16x8 kq[4], vq, qf[2][2], af; };
__device__ __forceinline__ void scan_phase(unsigned char* ws, char* lds, int vcu, int G) {
    const int tid = threadIdx.x, wid = __builtin_amdgcn_readfirstlane(tid >> 6), lane = tid & 63, r32 = lane & 31, hi = lane >> 5;
    float* ssp = (float*)(ws + WS_SSP);
    const int lds0 = (int)(uintptr_t)lds, rdb = t_rd_base(lane);
    int kdst[4];
#pragma unroll
    for (int i2 = 0; i2 < 4; ++i2) { const int idx = tid + 512 * i2, m = idx >> 5, c = idx & 31; kdst[i2] = OFF_K + (c >> 2) * KSL + t_st<1>(m, 8 * (c & 3)); }
    const int vdst = OFF_V + t_st<1>(tid >> 2, 8 * (tid & 3));
    for (int item = vcu; item < 256; item += G) {
        const int bh = item >> 4, sl = item & 15, b = bh >> 2, h = bh & 3;
        const float g = __builtin_amdgcn_exp2f(64.f * __log2f(1.f - __builtin_amdgcn_exp2f(-5.f - (float)h)));
        const bf16_t* qbase = (const bf16_t*)(ws + WS_QP) + (size_t)b * SEQ * 1024 + h * 256 + 32 * wid + 8 * hi + (size_t)r32 * 1024;
        const bf16_t* kfull = (const bf16_t*)(ws + WS_KPP) + (size_t)b * SEQ * 1024 + h * 256 + (size_t)(tid >> 5) * 1024 + 8 * (tid & 31);
        bf16_t* vbase = (bf16_t*)(ws + WS_VO) + (size_t)b * SEQ * 2048 + h * 512 + 32 * sl;
        const bf16_t* vld = vbase + (size_t)(tid >> 2) * 2048 + 8 * (tid & 3);
        const bf16_t* abase = (const bf16_t*)(ws + WS_AMAT) + (size_t)bh * 64 * 4096 + (32 * (wid & 1) + r32) * 64 + 16 * (wid >> 1) + 8 * hi;
        float* sspb = ssp + (size_t)(sl * 4 + h) * M_ + (size_t)b * SEQ;
        f32x16 S = {};
        Stage st0, st1;
#define SC_LOADKV(ST, i) do { const size_t ro_ = (size_t)(i) * 64; \
        _Pragma("unroll") for (int i2 = 0; i2 < 4; ++i2) ST.kq[i2] = *reinterpret_cast<const bf16x8*>(kfull + (ro_ + 16 * i2) * 1024); \
        if (tid < 256) ST.vq = *reinterpret_cast<const bf16x8*>(vld + ro_ * 2048); } while (0)
#define SC_LOADQA(ST, i) do { const size_t ro_ = (size_t)(i) * 64; \
        _Pragma("unroll") for (int mt = 0; mt < 2; ++mt) _Pragma("unroll") for (int s2 = 0; s2 < 2; ++s2) ST.qf[mt][s2] = *reinterpret_cast<const bf16x8*>(qbase + (ro_ + 32 * mt) * 1024 + 16 * s2); \
        ST.af = *reinterpret_cast<const bf16x8*>(abase + (size_t)(i) * 4096); } while (0)
#define SC_WRITE(ST, bsel) do { _Pragma("unroll") for (int i2 = 0; i2 < 4; ++i2) *(bf16x8*)(lds + (bsel) * 8 * KSL + kdst[i2]) = ST.kq[i2]; if (tid < 256) *(bf16x8*)(lds + (bsel) * 4096 + vdst) = ST.vq; } while (0)
#define SC_FLUSH(i, BSEL) do { if (tid < 256) { const u32x4 w = *(const u32x4*)(lds + OFF_OT + (BSEL) * 4096 + tid * 16); *(u32x4*)(vbase + (size_t)((i) * 64 + (tid >> 2)) * 2048 + 8 * (tid & 3)) = w; } \
        else if (tid < 320) sspb[(i) * 64 + (tid - 256)] = ((const float*)(lds + OFF_SS + (BSEL) * 256))[tid - 256]; } while (0)
#define SC_STEP(i, CUR, OTH, BSEL) do { \
            const int row0 = (i) * 64; const int ld_ = ((i) + 2 < 64) ? (i) + 2 : 63; \
            SC_LOADKV(CUR, ld_); \
            bf16x8 sb[2]; \
            _Pragma("unroll") for (int s2 = 0; s2 < 2; ++s2) { u32x4 w = {cvtpk(S[8 * s2 + 0], S[8 * s2 + 1]), cvtpk(S[8 * s2 + 2], S[8 * s2 + 3]), cvtpk(S[8 * s2 + 4], S[8 * s2 + 5]), cvtpk(S[8 * s2 + 6], S[8 * s2 + 7])}; sb[s2] = *reinterpret_cast<bf16x8*>(&w); } \
            f32x16 op0 = {}, op1 = {}; \
            op0 = __builtin_amdgcn_mfma_f32_32x32x16_bf16(CUR.qf[0][0], sb[0], op0, 0, 0, 0); op1 = __builtin_amdgcn_mfma_f32_32x32x16_bf16(CUR.qf[1][0], sb[0], op1, 0, 0, 0); \
            op0 = __builtin_amdgcn_mfma_f32_32x32x16_bf16(CUR.qf[0][1], sb[1], op0, 0, 0, 0); op1 = __builtin_amdgcn_mfma_f32_32x32x16_bf16(CUR.qf[1][1], sb[1], op1, 0, 0, 0); \
            const int kvb = lds0 + OFF_K + (BSEL) * 8 * KSL + wid * KSL + rdb, vvb = lds0 + OFF_V + (BSEL) * 4096 + rdb; \
            s16x4 kl[4], kh[4], vl[4], vh[4], xl, xh; \
            kl[0] = tr_read<0>(kvb); kh[0] = tr_read<512>(kvb); kl[1] = tr_read<1024>(kvb); kh[1] = tr_read<1536>(kvb); kl[2] = tr_read<2048>(kvb); kh[2] = tr_read<2560>(kvb); kl[3] = tr_read<3072>(kvb); kh[3] = tr_read<3584>(kvb); \
            vl[0] = tr_read<0>(vvb); vh[0] = tr_read<512>(vvb); vl[1] = tr_read<1024>(vvb); vh[1] = tr_read<1536>(vvb); vl[2] = tr_read<2048>(vvb); vh[2] = tr_read<2560>(vvb); vl[3] = tr_read<3072>(vvb); vh[3] = tr_read<3584>(vvb); \
            { const int xo = vvb + (wid >> 1) * 1024; xl = tr_read<0>(xo); xh = tr_read<512>(xo); } \
            asm volatile("s_waitcnt lgkmcnt(0)" ::: "memory"); SBAR(); \
            if (wid & 1) op1 = __builtin_amdgcn_mfma_f32_32x32x16_bf16(CUR.af, TPK(xl, xh), op1, 0, 0, 0); \
            else         op0 = __builtin_amdgcn_mfma_f32_32x32x16_bf16(CUR.af, TPK(xl, xh), op0, 0, 0, 0); \
            _Pragma("unroll") for (int ks = 0; ks < 4; ++ks) S = __builtin_amdgcn_mfma_f32_32x32x16_bf16(TPK(kl[ks], kh[ks]), TPK(vl[ks], vh[ks]), S, 0, 0, 0); \
            SC_LOADQA(CUR, ld_); \
            _Pragma("unroll") for (int r = 0; r < 16; ++r) S[r] *= g; \
            unsigned* red = (unsigned*)(lds + OFF_RED + (BSEL) * 32768); \
            _Pragma("unroll") for (int p = 0; p < 8; ++p) { red[((wid * 2 + 0) * 8 + p) * 64 + lane] = cvtpk(op0[2 * p], op0[2 * p + 1]); red[((wid * 2 + 1) * 8 + p) * 64 + lane] = cvtpk(op1[2 * p], op1[2 * p + 1]); } \
            SC_WRITE(OTH, (BSEL) ^ 1); \
            __syncthreads(); \
            if ((i) > 0) SC_FLUSH((i) - 1, (BSEL) ^ 1); \
            _Pragma("unroll") for (int q = 0; q < 2; ++q) { const int idx = wid * 2 + q, mt = idx >> 3, p = idx & 7; float v0 = 0.f, v1 = 0.f; \
                _Pragma("unroll") for (int w2 = 0; w2 < 8; ++w2) { const unsigned u = red[((w2 * 2 + mt) * 8 + p) * 64 + lane]; v0 += __uint_as_float(u << 16); v1 += __uint_as_float(u & 0xffff0000u); } \
                const int j = 32 * mt + crow(2 * p, hi); \
                bf16_t* ot = (bf16_t*)(lds + OFF_OT + (BSEL) * 4096) + j * 32 + r32; \
                ot[0] = f2bf(v0); ot[32] = f2bf(v1); \
                const float s0 = sum32(v0 * v0), s1 = sum32(v1 * v1); \
                if (r32 == 0) { float* sp = (float*)(lds + OFF_SS + (BSEL) * 256) + j; sp[0] = s0; sp[1] = s1; } } \
        } while (0)
        SC_LOADKV(st0, 0); SC_LOADQA(st0, 0); SC_LOADKV(st1, 1); SC_LOADQA(st1, 1);
        SC_WRITE(st0, 0);
        __syncthreads();
#pragma unroll 1
        for (int i = 0; i < 64; i += 2) { SC_STEP(i, st0, st1, 0); SC_STEP(i + 1, st1, st0, 1); }
        __syncthreads();
        SC_FLUSH(63, 1);
        __syncthreads();
#undef SC_LOADKV
#undef SC_LOADQA
#undef SC_WRITE
#undef SC_STEP
#undef SC_FLUSH
    }
}
}
}

constexpr int NWAVES = 8;
constexpr int RING_OFF = 0, RING_BYTES = 131072;
constexpr int LDS_BYTES = 163840;
constexpr int LDSCTL_OFF = LDS_BYTES - 1024, MISC_OFF = LDSCTL_OFF + 320;
constexpr int LDS_BYTES_UNUSED_ = 0;
constexpr int CW_TMO = 0, CW_CODE = 1, CW_BAR = 4096;

constexpr size_t WO_IN0 = 0;
constexpr size_t WO_UQ = WO_IN0 + (size_t)1792 * 1024;
constexpr size_t WO_UKV = WO_UQ + (size_t)768 * 384;
constexpr size_t WO_OUT0 = WO_UKV + (size_t)1024 * 256;
constexpr size_t WO_GU0 = WO_OUT0 + (size_t)1024 * 1024;
constexpr size_t WO_DN0 = WO_GU0 + (size_t)5632 * 1024;
constexpr size_t WO_IN1 = WO_DN0 + (size_t)1024 * 2816;
constexpr size_t WO_OUT1 = WO_IN1 + (size_t)6144 * 1024;
constexpr size_t WO_GU1 = WO_OUT1 + (size_t)1024 * 2048;
constexpr size_t WO_DN1 = WO_GU1 + (size_t)5632 * 1024;
constexpr size_t WO_END = WO_DN1 + (size_t)1024 * 2816;
static_assert(WS_W + WO_END * 2 <= WS_XB, "bf16 weight copies fit [8,64) MiB");

#define GAS __attribute__((address_space(1)))
#define LAS __attribute__((address_space(3)))
typedef unsigned v4u __attribute__((ext_vector_type(4)));
typedef GAS unsigned gu32;
typedef GAS unsigned long long gu64;
#define RLX_AGENT __ATOMIC_RELAXED, __HIP_MEMORY_SCOPE_AGENT
#define LDS_WAIT() asm volatile("s_waitcnt lgkmcnt(0)" ::: "memory")
#define VM_WAIT() asm volatile("s_waitcnt vmcnt(0)" ::: "memory")
__device__ __forceinline__ unsigned long long rt() { return __builtin_amdgcn_s_memrealtime(); }

#define XB_TMO      128
#define XB_XCNT(j)  (256  + 64 * (j))
#define XB_XSUB(j)  (1280 + 64 * (j))
#define XB_XGEN(j)  (2304 + 64 * (j))
#define XB_TOP      3328
#define XB_TOPGEN   3392
#define XCD_BAR_WORDS 3456
#define XB_SPIN_CAP (1u << 18)

__device__ __forceinline__ unsigned xb_ld(unsigned* p)              { return __hip_atomic_load(p, __ATOMIC_RELAXED, __HIP_MEMORY_SCOPE_AGENT); }
__device__ __forceinline__ unsigned xb_add(unsigned* p, unsigned v) { return __hip_atomic_fetch_add(p, v, __ATOMIC_RELAXED, __HIP_MEMORY_SCOPE_AGENT); }
__device__ __forceinline__ unsigned xb_xcc_id() { return (unsigned)__builtin_amdgcn_s_getreg((3 << 11) | 20) & 0xFu; }
#define XB_SPIN(cond, bar) do { unsigned _sp = 0; while (cond) { __builtin_amdgcn_s_sleep(1); \
    if ((++_sp & 255u) == 0u) { if (xb_ld(&(bar)[XB_TMO])) break; if (_sp > XB_SPIN_CAP) { atomicAdd(&(bar)[XB_TMO], 1u); break; } } } } while (0)

struct XcdBarrier {
    unsigned* bar; unsigned x;
    volatile LAS unsigned* st;
};

__device__ __forceinline__ XcdBarrier xcd_barrier_post(unsigned* bar, volatile LAS unsigned* st) {
    XcdBarrier b; b.bar = bar; b.x = xb_xcc_id(); b.st = st;
    if (threadIdx.x == 0) st[2] = xb_add(&bar[XB_XCNT(b.x)], 1u);
    return b;
}
__device__ __forceinline__ void xcd_barrier_complete(unsigned* bar, unsigned x, unsigned& nloc, unsigned& nx) {
    const unsigned G = gridDim.x * gridDim.y * gridDim.z;
    unsigned sum, cnt, mine, sp = 0u;
    for (;;) {
        sum = 0u; cnt = 0u; mine = 0u;
#pragma unroll
        for (unsigned j = 0; j < 16; ++j) { const unsigned c = xb_ld(&bar[XB_XCNT(j)]); sum += c; cnt += (c > 0u) ? 1u : 0u; mine = (j == x) ? c : mine; }
        if (sum == G) break;
        __builtin_amdgcn_s_sleep(1);
        if ((++sp & 255u) == 0u) { if (xb_ld(&bar[XB_TMO])) break; if (sp > XB_SPIN_CAP) { atomicAdd(&bar[XB_TMO], 1u); break; } }
    }
    nloc = mine > 0u ? mine : 1u; nx = cnt > 0u ? cnt : 1u;
}

__device__ __forceinline__ void xcd_barrier(const XcdBarrier& b) {
    asm volatile("s_waitcnt vmcnt(0)" ::: "memory");
    __syncthreads();
    if (threadIdx.x == 0) {
        unsigned* bar = b.bar;
        __builtin_amdgcn_s_waitcnt(0);
        unsigned nloc = b.st[0], nx = b.st[1];
        if (nloc == 0u) { xcd_barrier_complete(bar, b.x, nloc, nx); b.st[0] = nloc; b.st[1] = nx; }
        const unsigned old = xb_add(&bar[XB_XSUB(b.x)], 1u);
        const unsigned gen = old / nloc;
        if (old + 1u == (gen + 1u) * nloc) {
            __builtin_amdgcn_fence(__ATOMIC_RELEASE, "agent");
            asm volatile("s_waitcnt vmcnt(0)" ::: "memory");
            const unsigned og = xb_add(&bar[XB_TOP], 1u);
            const unsigned tg = og / nx;
            if (og + 1u == (tg + 1u) * nx) xb_add(&bar[XB_TOPGEN], 1u);
            else XB_SPIN(xb_ld(&bar[XB_TOPGEN]) == tg, bar);
            __builtin_amdgcn_fence(__ATOMIC_ACQUIRE, "agent");
            xb_add(&bar[XB_XGEN(b.x)], 1u);
            asm volatile("s_waitcnt vmcnt(0)" ::: "memory");
        } else {
            XB_SPIN(xb_ld(&bar[XB_XGEN(b.x)]) == gen, bar);
            __builtin_amdgcn_fence(__ATOMIC_ACQUIRE, "agent");
            asm volatile("s_waitcnt vmcnt(0)" ::: "memory");
        }
    }
    __syncthreads();
}


#define XB_LSUB(j)  (3520 + 64 * (j))
#define XB_LGEN(j)  (4544 + 64 * (j))
__device__ __forceinline__ void xcd_barrier_local(const XcdBarrier& b) {
    asm volatile("s_waitcnt vmcnt(0)" ::: "memory");
    __syncthreads();
    if (threadIdx.x == 0) {
        unsigned* bar = b.bar;
        __builtin_amdgcn_s_waitcnt(0);
        const unsigned nloc = b.st[0];
        const unsigned old = xb_add(&bar[XB_LSUB(b.x)], 1u);
        const unsigned gen = old / nloc;
        if (old + 1u == (gen + 1u) * nloc) xb_add(&bar[XB_LGEN(b.x)], 1u);
        else XB_SPIN(xb_ld(&bar[XB_LGEN(b.x)]) == gen, bar);
        __builtin_amdgcn_fence(__ATOMIC_ACQUIRE, "agent");
        asm volatile("s_waitcnt vmcnt(0)" ::: "memory");
    }
    __syncthreads();
}
struct Args { Ptrs p; int ph_lo, ph_hi; };

struct WtItem { const float* W; bf16_t* WT; int k0; bool zero; };
typedef float wf4 __attribute__((ext_vector_type(4)));
__device__ __forceinline__ unsigned wt_cvtpk(float lo, float hi) { unsigned r; asm volatile("v_cvt_pk_bf16_f32 %0, %1, %2" : "=v"(r) : "v"(lo), "v"(hi)); return r; }
__device__ __forceinline__ void wt_load(const WtItem& it, int ldw, wf4 (&tv)[8], int lane) {
    if (it.zero) {
#pragma unroll
        for (int j = 0; j < 8; ++j) tv[j] = (wf4){0.f, 0.f, 0.f, 0.f};
    } else {
        const float* src = it.W + (size_t)(it.k0 + (lane >> 3)) * ldw + 4 * (lane & 7);
#pragma unroll
        for (int j = 0; j < 8; ++j) tv[j] = *(const wf4*)(src + (size_t)(8 * j) * ldw);
    }
}
template <bool GAIN> __device__ __forceinline__ void wt_store_t(const WtItem& it, const float* gain, int K, const wf4 (&tv)[8], LAS float* scr, int lane) {
    const int c = lane & 7;
    wf4 g0 = {1.f, 1.f, 1.f, 1.f}, g1 = {1.f, 1.f, 1.f, 1.f};
    if (GAIN) { g0 = *(const wf4*)(gain + it.k0 + 8 * c); g1 = *(const wf4*)(gain + it.k0 + 8 * c + 4); }
#pragma unroll
    for (int j = 0; j < 8; ++j) { LAS float* d = scr + ((lane >> 3) + 8 * j) * 33 + 4 * c; d[0] = tv[j].x; d[1] = tv[j].y; d[2] = tv[j].z; d[3] = tv[j].w; }
    LDS_WAIT(); asm volatile("" ::: "memory");
#pragma unroll
    for (int j = 0; j < 4; ++j) { const int n = (lane >> 3) + 8 * j; const LAS float* s = scr + (8 * c) * 33 + n;
        v4u o; o.x = wt_cvtpk(s[0 * 33] * g0.x, s[1 * 33] * g0.y); o.y = wt_cvtpk(s[2 * 33] * g0.z, s[3 * 33] * g0.w); o.z = wt_cvtpk(s[4 * 33] * g1.x, s[5 * 33] * g1.y); o.w = wt_cvtpk(s[6 * 33] * g1.z, s[7 * 33] * g1.w);
        *(GAS v4u*)(it.WT + (size_t)n * K + it.k0 + 8 * c) = o; }
    LDS_WAIT(); asm volatile("" ::: "memory");
}
__device__ __forceinline__ void wt_store(const WtItem& it, const float* gain, int K, const wf4 (&tv)[8], LAS float* scr, int lane) { if (gain) wt_store_t<true>(it, gain, K, tv, scr, lane); else wt_store_t<false>(it, gain, K, tv, scr, lane); }
__device__ __forceinline__ WtItem wt_make(const float* W, const float* W2, int ncols, int kind, int K, bf16_t* WT, int it, int nrow0, int nnb) {
    const int kb = it / nnb, nb = it % nnb, n0 = nrow0 + nb * 32; const float* src = W; int col = n0; bool zero = false;
    if (kind == 1) { src = ((n0 >> 7) & 1) ? W2 : W; col = 128 * (n0 >> 8) + (n0 & 127); } else zero = (n0 >= ncols);
    WtItem r; r.W = src + col; r.WT = WT + (size_t)n0 * K; r.k0 = kb * 64; r.zero = zero; return r;
}
__device__ __forceinline__ void wt_segment(const float* W, const float* W2, int ldw, int ncols, int kind, const float* gain, int K, int nrows, bf16_t* WT, LAS float* scr, int gw, int ngw, int lane, int nrow0 = 0) {
    const int nitems = (K / 64) * (nrows / 32);
    for (int it = gw; it < nitems; it += 2 * ngw) {
        const WtItem a = wt_make(W, W2, ncols, kind, K, WT, it, nrow0, nrows / 32); wf4 ta[8], tb[8]; wt_load(a, ldw, ta, lane);
        const bool two = (it + ngw) < nitems; WtItem b = a;
        if (two) { b = wt_make(W, W2, ncols, kind, K, WT, it + ngw, nrow0, nrows / 32); wt_load(b, ldw, tb, lane); }
        wt_store(a, gain, K, ta, scr, lane);
        if (two) wt_store(b, gain, K, tb, scr, lane);
    }
}

__global__ void __launch_bounds__(NWAVES * 64, 2) mk_fwd(Args args) {
    extern __shared__ __attribute__((aligned(16))) unsigned char lds[];
    LAS unsigned char* L = (LAS unsigned char*)lds;
    volatile LAS unsigned* MISC = (volatile LAS unsigned*)(L + MISC_OFF);
    const Ptrs& P = args.p;
    const int tid = threadIdx.x, lane = tid & 63, wave = __builtin_amdgcn_readfirstlane(tid >> 6);
    const int G = gridDim.x, bx = blockIdx.x;
    const int vcu = (G % 8 == 0) ? (bx % 8) * (G / 8) + bx / 8 : bx;
    unsigned char* ws = P.ws; gu32* ctl = (gu32*)(ws + WS_CTL);
    for (int u = tid; u < (LDS_BYTES - LDSCTL_OFF) / 4; u += NWAVES * 64) ((LAS unsigned*)(L + LDSCTL_OFF))[u] = 0u;
    __syncthreads();
    const int lo = args.ph_lo, hi = args.ph_hi;
    XcdBarrier bar; bar.bar = (unsigned*)(ctl + CW_BAR); bar.x = 0; bar.st = nullptr;
#if !USE_CG_SYNC
    if (hi - lo > 1) bar = xcd_barrier_post((unsigned*)(ctl + CW_BAR), MISC + 8);
#endif
    float* ssb = (float*)(ws + WS_SS); float* ss1 = ssb; float* ss2 = ssb + M_; float* ss3 = ssb + 2 * M_;
    bf16_t* Wb = (bf16_t*)(ws + WS_W); bf16_t* xb = (bf16_t*)(ws + WS_XB); bf16_t* zb = (bf16_t*)(ws + WS_ZB); bf16_t* mix = (bf16_t*)(ws + WS_MIX); bf16_t* act = (bf16_t*)(ws + WS_ACT);
    const int gw = vcu * NWAVES + wave, NGW = G * NWAVES;

#if USE_CG_SYNC
#define GRID_BAR() cg::this_grid().sync()
#else
#define GRID_BAR() xcd_barrier(bar)
#endif
#ifndef CG_FIRST
#define CG_FIRST 0
#endif
#ifdef TIMING
#define STAMP(k) do { if (bx == 0 && tid == 0) ((unsigned long long*)(ws + WS_CTL + 1024))[(k)] = __builtin_amdgcn_s_memrealtime(); } while (0)
#else
#define STAMP(k) do {} while (0)
#endif
#define IN(k) (lo <= (k) && (k) < hi)
#define SEAM(k) do { if (IN(k) && IN((k) + 1)) { GRID_BAR(); } STAMP((k) + 1); } while (0)
#ifndef LOCAL_SEAMS
#define LOCAL_SEAMS 1
#endif
#define LSEAM(k) do { if (IN(k) && IN((k) + 1)) { if (local_ok) xcd_barrier_local(bar); else GRID_BAR(); } STAMP((k) + 1); } while (0)
#ifndef PHASE_ON
#define PHASE_ON(k) 1
#endif
        STAMP(0);
        if (PHASE_ON(0) && IN(nv::PH_PREP)) {
            LAS float* scr = (LAS float*)(L + RING_OFF + wave * 16384);
            const float* nm = P.in[IN_NORM_MIX]; const float* nf = P.in[IN_NORM_FFN];
            wt_segment(P.in[IN_EVEN_W_IN], nullptr, EVEN_IN, EVEN_IN, 0, nm, 1024, 1792, Wb + WO_IN0, scr, gw, NGW, lane);
            wt_segment(P.in[IN_W_UQ], nullptr, 768, 768, 0, P.in[IN_Q_A_NORM], 384, 768, Wb + WO_UQ, scr, gw, NGW, lane);
            wt_segment(P.in[IN_W_UKV], nullptr, 1024, 1024, 0, P.in[IN_KV_A_NORM], 256, 1024, Wb + WO_UKV, scr, gw, NGW, lane);
            for (int row = gw; row < M_; row += 2 * NGW) {
                const int row2 = (row + NGW < M_) ? row + NGW : row;
                f32x4 va[4], vb[4];
#pragma unroll
                for (int j = 0; j < 4; ++j) { va[j] = *(const f32x4*)(P.in[IN_X] + (size_t)row * DM + j * 256 + lane * 4); vb[j] = *(const f32x4*)(P.in[IN_X] + (size_t)row2 * DM + j * 256 + lane * 4); }
                float s = 0.f, s2 = 0.f;
#pragma unroll
                for (int j = 0; j < 4; ++j) { s += va[j].x * va[j].x + va[j].y * va[j].y + va[j].z * va[j].z + va[j].w * va[j].w; s2 += vb[j].x * vb[j].x + vb[j].y * vb[j].y + vb[j].z * vb[j].z + vb[j].w * vb[j].w;
                    u32x2 o; o.x = pk2(va[j].x, va[j].y); o.y = pk2(va[j].z, va[j].w); *(u32x2*)(xb + (size_t)row * DM + j * 256 + lane * 4) = o;
                    o.x = pk2(vb[j].x, vb[j].y); o.y = pk2(vb[j].z, vb[j].w); *(u32x2*)(xb + (size_t)row2 * DM + j * 256 + lane * 4) = o; }
                s = wave_sum(s); s2 = wave_sum(s2);
                if (lane == 0) { ((float*)(ws + WS_RS0))[row] = rsqrtf(s * (1.f / DM) + EPS); ((float*)(ws + WS_RS0))[row2] = rsqrtf(s2 * (1.f / DM) + EPS); }
            }
            if (gw == 0) { for (int i = lane; i < 128; i += 64) ((float*)(ws + WS_INVR))[i] = (float)(exp(-(double)i / 128.0 * 9.210340371976184) * 0.15915494309189535);
                if (lane < 16) ((float*)(ws + WS_INVM))[lane] = (float)(exp(-(double)lane / 16.0 * 9.210340371976184) * 0.15915494309189535); }
            for (int idx = gw * 64 + lane; idx < 4 * 128 * 128; idx += NGW * 64) { const int t = (idx >> 7) & 127, s = idx & 127; ((bf16_t*)(ws + WS_WSP))[idx] = ((s >> 6) <= (t >> 6)) ? f2bf(P.in[IN_GM_W_S][idx]) : (bf16_t)0; }
        }
        if (IN(nv::PH_PREP) && IN(nv::PH_IN0)) { if (CG_FIRST || hi > 1000) cg::this_grid().sync(); else GRID_BAR(); }
        int cid = bx; bool local_ok = false;
#if !USE_CG_SYNC
        if (hi - lo > 1 && G == 256 && LOCAL_SEAMS) {
            if (tid == 0) { unsigned ok = 1u; for (unsigned j = 0; j < 16; ++j) { const unsigned c = xb_ld(&bar.bar[XB_XCNT(j)]); ok &= (j < 8) ? (c == (unsigned)G / 8u) : (c == 0u); } ok &= (bar.x < 8u) ? 1u : 0u; MISC[11] = ok; }
            __syncthreads();
            local_ok = MISC[11] != 0u;
            if (local_ok) { const int rank = (int)MISC[10]; cid = 8 * rank + (int)bar.x; }
        }
#endif
        const int vcu2 = local_ok ? ((cid & 7) * (G / 8) + (cid >> 3)) : vcu; const int gw2 = vcu2 * NWAVES + wave;
        STAMP(1);
        if (PHASE_ON(1) && IN(nv::PH_IN0)) {
            pg8::Gemm g{xb, Wb + WO_IN0, DM, 1024, 1024}; pg8::StaticOrder S; S.init(M_, ZLD, G, cid);
            pg8::EpiZ0 E{zb, (const float*)(ws + WS_RS0)};
            pg8::gemm_phase<pg8::EpiZ0, pg8::StaticOrder, true, true>(L + RING_OFF, g, S, E);
            if (cid >= 192) { LAS float* scr = (LAS float*)(L + RING_OFF + wave * 16384);
                wt_segment(P.in[IN_EVEN_W_OUT], nullptr, 1024, 1024, 0, nullptr, 1024, 1024, Wb + WO_OUT0, scr, (cid - 192) * NWAVES + wave, 64 * NWAVES, lane);
                wt_segment(P.in[IN_FFN_DOWN], nullptr, 1024, 1024, 0, nullptr, DFF, 1024, Wb + WO_DN0, scr, (cid - 192) * NWAVES + wave, 64 * NWAVES, lane); __syncthreads(); }
        }
        LSEAM(nv::PH_IN0);
        if (PHASE_ON(2) && IN(nv::PH_MLAUP)) { fp::mlaf::mla_fused_phase(P, Wb + WO_UQ, Wb + WO_UKV, (char*)lds + RING_OFF, vcu2); }
        STAMP(nv::PH_MLAUP + 1);
        if (PHASE_ON(3) && IN(nv::PH_GATING)) { fp::gating_phase(P, (char*)lds + RING_OFF, vcu2, G); }
        if (PHASE_ON(3) && IN(nv::PH_GATING)) { LAS float* scr = (LAS float*)(L + RING_OFF + wave * 16384);
            wt_segment(P.in[IN_FFN_GATE], P.in[IN_FFN_UP], DFF, DFF, 1, P.in[IN_NORM_FFN], 1024, 5632, Wb + WO_GU0, scr, gw, NGW, lane); __syncthreads(); }
        SEAM(nv::PH_GATING);
        if (PHASE_ON(5) && IN(nv::PH_ATTN)) { fp::att::attn_phase(ws, (char*)lds + RING_OFF, vcu2, G); }
        SEAM(nv::PH_ATTN);
        if (PHASE_ON(6) && IN(nv::PH_OUT0)) {
            pg8::Gemm g{mix, Wb + WO_OUT0, 1024, 1024, 1024}; pg8::StaticOrder S; S.init(M_, DM, G, cid);
            pg8::EpiResid<false, false> E{nullptr, P.out, xb, ss1};
            pg8::gemm_phase<pg8::EpiResid<false, false>, pg8::StaticOrder, true, true>(L + RING_OFF, g, S, E);
        }
        LSEAM(nv::PH_OUT0);

        if (PHASE_ON(7) && IN(nv::PH_FFN0A)) {
            const bool l1 = (nv::PH_FFN0A == nv::PH_FFN1A);
            pg8::Gemm g{xb, Wb + (l1 ? WO_GU1 : WO_GU0), DM, 1024, 1024}; pg8::StaticOrder S; S.init(M_, 2 * DFF, G, cid);
            pg8::EpiSwiglu E{act, l1 ? ss3 : ss1};
            pg8::gemm_phase<pg8::EpiSwiglu, pg8::StaticOrder, true, true>(L + RING_OFF, g, S, E);
            if (!l1 && cid >= 128) { LAS float* scr = (LAS float*)(L + RING_OFF + wave * 16384);
                wt_segment(P.in[IN_ODD_W_OUT], nullptr, 1024, 1024, 0, P.in[IN_RET_OUT_NORM], 2048, 1024, Wb + WO_OUT1, scr, (cid - 128) * NWAVES + wave, 128 * NWAVES, lane);
                wt_segment(P.in[IN_FFN_DOWN] + (size_t)DFF * DM, nullptr, 1024, 1024, 0, nullptr, DFF, 1024, Wb + WO_DN1, scr, (cid - 128) * NWAVES + wave, 128 * NWAVES, lane);
                wt_segment(P.in[IN_FFN_GATE] + (size_t)DM * DFF, P.in[IN_FFN_UP] + (size_t)DM * DFF, DFF, DFF, 1, P.in[IN_NORM_FFN] + DM, 1024, 5632, Wb + WO_GU1, scr, (cid - 128) * NWAVES + wave, 128 * NWAVES, lane);
                wt_segment(P.in[IN_ODD_W_IN], nullptr, ODD_IN, ODD_IN, 0, P.in[IN_NORM_MIX] + DM, 1024, 6144, Wb + WO_IN1, scr, (cid - 128) * NWAVES + wave, 128 * NWAVES, lane); __syncthreads(); }
        }
        LSEAM(nv::PH_FFN0A);
        if (PHASE_ON(8) && IN(nv::PH_FFN0B)) {
            const bool l1 = (nv::PH_FFN0B == nv::PH_FFN1B);
            pg8::Gemm g{act, Wb + (l1 ? WO_DN1 : WO_DN0), DFF, DFF, DFF}; pg8::StaticOrder S; S.init(M_, DM, G, cid);
            if (l1) { pg8::EpiResid<false, true> E{nullptr, P.out, xb, ss2}; pg8::gemm_phase<pg8::EpiResid<false, true>, pg8::StaticOrder, true, true>(L + RING_OFF, g, S, E); }
            else { pg8::EpiResid<false, false> E{nullptr, P.out, xb, ss2}; pg8::gemm_phase<pg8::EpiResid<false, false>, pg8::StaticOrder, true, true>(L + RING_OFF, g, S, E); }
        }

        SEAM(nv::PH_FFN0B);
        if (PHASE_ON(9) && IN(nv::PH_IN1)) {
            pg8::Gemm g{xb, Wb + WO_IN1, DM, 1024, 1024}; pg8::StaticOrder S; S.init(M_, 4096, G, cid);
            pg8::EpiIn1 E{(bf16_t*)(ws + WS_QP), (bf16_t*)(ws + WS_KPP), (bf16_t*)(ws + WS_VO), ss2, (const float*)(ws + WS_INVR), nullptr};
            pg8::gemm_phase<pg8::EpiIn1, pg8::StaticOrder, true, true>(L + RING_OFF, g, S, E);
        }
        LSEAM(nv::PH_IN1);
        if (PHASE_ON(10) && IN(nv::PH_AMAT)) { fp::amat_phase(ws, gw2, NGW, lane); }
        SEAM(nv::PH_AMAT);
        if (PHASE_ON(11) && IN(nv::PH_SCAN)) { fp::scan::scan_phase(ws, (char*)lds + RING_OFF, vcu2, G); }
        SEAM(nv::PH_SCAN);
        if (PHASE_ON(12) && IN(nv::PH_GATE)) {
            pg8::Gemm g{xb, Wb + WO_IN1 + (size_t)4096 * 1024, DM, 1024, 1024}; pg8::StaticOrder S; S.init(M_, 2048, G, cid);
            pg8::EpiGate E{(bf16_t*)(ws + WS_VO), ss2, (const float*)(ws + WS_SSP)};
            pg8::gemm_phase<pg8::EpiGate, pg8::StaticOrder, true, true>(L + RING_OFF, g, S, E);
        }
        LSEAM(nv::PH_GATE);
        if (PHASE_ON(13) && IN(nv::PH_OUT1)) {
            pg8::Gemm g{(const bf16_t*)(ws + WS_VO), Wb + WO_OUT1, 2048, 2048, 2048}; pg8::StaticOrder S; S.init(M_, DM, G, cid);
            pg8::EpiResid<false, false> E{nullptr, P.out, xb, ss3};
            pg8::gemm_phase<pg8::EpiResid<false, false>, pg8::StaticOrder, true, true>(L + RING_OFF, g, S, E);
        }
        LSEAM(nv::PH_OUT1);

        if (PHASE_ON(14) && IN(nv::PH_FFN1A)) {
            const bool l1 = (nv::PH_FFN1A == nv::PH_FFN1A);
            pg8::Gemm g{xb, Wb + (l1 ? WO_GU1 : WO_GU0), DM, 1024, 1024}; pg8::StaticOrder S; S.init(M_, 2 * DFF, G, cid);
            pg8::EpiSwiglu E{act, l1 ? ss3 : ss1};
            pg8::gemm_phase<pg8::EpiSwiglu, pg8::StaticOrder, true, true>(L + RING_OFF, g, S, E);
        }
        LSEAM(nv::PH_FFN1A);
        if (PHASE_ON(15) && IN(nv::PH_FFN1B)) {
            const bool l1 = (nv::PH_FFN1B == nv::PH_FFN1B);
            pg8::Gemm g{act, Wb + (l1 ? WO_DN1 : WO_DN0), DFF, DFF, DFF}; pg8::StaticOrder S; S.init(M_, DM, G, cid);
            if (l1) { pg8::EpiResid<false, true> E{nullptr, P.out, xb, ss2}; pg8::gemm_phase<pg8::EpiResid<false, true>, pg8::StaticOrder, true, true>(L + RING_OFF, g, S, E); }
            else { pg8::EpiResid<false, false> E{nullptr, P.out, xb, ss2}; pg8::gemm_phase<pg8::EpiResid<false, false>, pg8::StaticOrder, true, true>(L + RING_OFF, g, S, E); }
        }

    STAMP(16);
}
#ifdef TIMING
__global__ void k_poke_time(float* out, const unsigned char* ws) { const unsigned long long* ts = (const unsigned long long*)(ws + WS_CTL + 1024); out[0] += (float)(ts[T_B] - ts[T_A]) * (0.01f / T_DIV); }
#endif
extern "C" void kernel_launch(void* const* d_in, const int* in_sizes, int n_in, void* d_out, int out_size, void* d_ws, size_t ws_size, hipStream_t stream) {
    if (n_in != 20 || out_size != M_ * DM || ws_size < WS_END) { fprintf(stderr, "kernel_launch: unexpected shapes n_in %d out %d ws %zu\n", n_in, out_size, ws_size); return; }
    static int grid = 0;
    if (grid == 0) {
        int dev = 0, cus = 0, per_cu = 0;
        (void)hipGetDevice(&dev); (void)hipDeviceGetAttribute(&cus, hipDeviceAttributeMultiprocessorCount, dev);
        if (hipFuncSetAttribute((const void*)mk_fwd, hipFuncAttributeMaxDynamicSharedMemorySize, LDS_BYTES) != hipSuccess) fprintf(stderr, "kernel_launch: hipFuncSetAttribute failed\n");
        if (hipOccupancyMaxActiveBlocksPerMultiprocessor(&per_cu, (const void*)mk_fwd, NWAVES * 64, LDS_BYTES) != hipSuccess || per_cu < 1) { fprintf(stderr, "kernel_launch: occupancy query says %d\n", per_cu); per_cu = 1; }
        (void)hipGetLastError();
        grid = cus * per_cu;
        if (grid != 256) fprintf(stderr, "kernel_launch: grid %d (cus %d x %d)\n", grid, cus, per_cu);
    }
    (void)hipMemsetAsync(d_ws, 0, ZERO_BYTES, stream);
    Args a{};
    for (int i = 0; i < 20; ++i) a.p.in[i] = (const float*)d_in[i];
    a.p.out = (float*)d_out; a.p.ws = (unsigned char*)d_ws; a.ph_lo = 0; a.ph_hi = nv::PH_COUNT;
    void* kargs[] = {&a};
    const hipError_t e = hipLaunchCooperativeKernel((const void*)mk_fwd, dim3(grid), dim3(NWAVES * 64), kargs, LDS_BYTES, stream);
#ifdef TIMING
    hipLaunchKernelGGL(k_poke_time, dim3(1), dim3(1), 0, stream, (float*)d_out, (const unsigned char*)d_ws);
#endif
    if (e != hipSuccess) fprintf(stderr, "kernel_launch: cooperative launch failed: %s (grid %d)\n", hipGetErrorString(e), grid);
}
```

```cpp
#define USE_CG_SYNC 0
#include <hip/hip_runtime.h>
#include <hip/hip_cooperative_groups.h>
#include <cstdio>
#include <cstdint>
namespace cg = cooperative_groups;

constexpr int BATCH = 4, SEQ = 4096, DM = 1024, M_ = BATCH * SEQ;
constexpr int CHUNK = 64;
constexpr float EPS = 1e-6f;
constexpr int GM_G = 4, GM_D = 128, GM_W = 512, GM_BLK = 128;
constexpr int MH = 8, MQR = 384, MKVR = 256, MNOPE = 64, MROPE = 32, MV = 64, MQK = 96;
constexpr int EVEN_IN = 1696, ZLD = 1792;
constexpr int RH = 4, RQK = 256, RV = 512, ODD_IN = 6144;
constexpr int DFF = 2816;
constexpr int ZO_U = 0, ZO_V = 512, ZO_CQ = 1024, ZO_CKV = 1408, ZO_KPE = 1664;

typedef unsigned short bf16_t;
typedef short bf16x8 __attribute__((ext_vector_type(8)));
typedef float f32x4 __attribute__((ext_vector_type(4)));
typedef float f32x16 __attribute__((ext_vector_type(16)));
typedef unsigned u32x4 __attribute__((ext_vector_type(4)));
typedef unsigned u32x2 __attribute__((ext_vector_type(2)));

__device__ __forceinline__ float bf2f(bf16_t v) { return __uint_as_float(((unsigned)v) << 16); }
__device__ __forceinline__ bf16_t f2bf(float f) { unsigned u = __float_as_uint(f); return (bf16_t)((u + 0x7fffu + ((u >> 16) & 1u)) >> 16); }
__device__ __forceinline__ unsigned pk2(float lo, float hi) { return (unsigned)f2bf(lo) | ((unsigned)f2bf(hi) << 16); }
__device__ __forceinline__ float gelu_tanh(float x) {
    const float u = 0.7978845608028654f * (x + 0.044715f * x * x * x);
    return x / (1.f + __expf(-2.f * u));
}
__device__ __forceinline__ float silu_f(float x) { return x / (1.f + __expf(-x)); }
__device__ __forceinline__ float wave_sum(float v) {
#pragma unroll
    for (int o = 1; o < 64; o <<= 1) v += __shfl_xor(v, o);
    return v;
}

constexpr size_t MiB = 1u << 20;
constexpr size_t WS_CTL = 0;
constexpr size_t WS_SS = 1 * MiB;
constexpr size_t ZERO_BYTES = 2 * MiB;
constexpr size_t WS_RS0 = 2 * MiB;
constexpr size_t WS_INVR = 2 * MiB + 128 * 1024;
constexpr size_t WS_INVM = 2 * MiB + 128 * 1024 + 1024;
constexpr size_t WS_COSR = 3 * MiB;
constexpr size_t WS_SINR = 5 * MiB;
constexpr size_t WS_WSP = 7 * MiB;
constexpr size_t WS_W = 8 * MiB;
constexpr size_t WS_XB = 64 * MiB;
constexpr size_t WS_ARENA = 96 * MiB;
constexpr size_t WS_ZB = 96 * MiB;
constexpr size_t WS_QRAW = 152 * MiB;
constexpr size_t WS_KVRAW = 176 * MiB;
constexpr size_t WS_MIX = 208 * MiB;
constexpr size_t WS_VB = 240 * MiB;
constexpr size_t WS_ACT = 96 * MiB;
constexpr size_t WS_QP = 96 * MiB;
constexpr size_t WS_KPP = 128 * MiB;
constexpr size_t WS_VO = 160 * MiB;
constexpr size_t WS_AMAT = 224 * MiB;
constexpr size_t WS_SSP = 232 * MiB;
constexpr size_t WS_SSQ = 3 * MiB;
constexpr size_t WS_END = 256 * MiB;

struct Ptrs {
    const float* in[20];
    float* out;
    unsigned char* ws;
};
#define IN_X 0
#define IN_NORM_MIX 1
#define IN_NORM_FFN 2
#define IN_EVEN_W_IN 3
#define IN_GM_V_NORM 4
#define IN_GM_W_S 5
#define IN_GM_B_S 6
#define IN_Q_A_NORM 7
#define IN_W_UQ 8
#define IN_KV_A_NORM 9
#define IN_W_UKV 10
#define IN_Q_NORM 11
#define IN_K_NORM 12
#define IN_EVEN_W_OUT 13
#define IN_ODD_W_IN 14
#define IN_RET_OUT_NORM 15
#define IN_ODD_W_OUT 16
#define IN_FFN_GATE 17
#define IN_FFN_UP 18
#define IN_FFN_DOWN 19

__device__ __forceinline__ float* ws_f32(const Ptrs& p, size_t off) { return (float*)(p.ws + off); }
__device__ __forceinline__ bf16_t* ws_bf(const Ptrs& p, size_t off) { return (bf16_t*)(p.ws + off); }
namespace nv {
enum Phase { PH_PREP = 0, PH_IN0, PH_MLAUP, PH_GATING, PH_MLANORM, PH_ATTN, PH_OUT0, PH_FFN0A, PH_FFN0B, PH_IN1, PH_AMAT, PH_SCAN, PH_GATE, PH_OUT1, PH_FFN1A, PH_FFN1B, PH_COUNT };
}

namespace pg8 {
#define PG8_LAS __attribute__((address_space(3)))
constexpr int BM = 256, BK = 64, HALF = 128, HTB = HALF * BK * 2  , STAGE_BYTES = 8 * HTB, NXCD = 8, WGM = 8;

__host__ __device__ __forceinline__ int lds_byte(int r, int c) { const int st = (r >> 4) * 2 + (c >> 5), rr = r & 15, cc = c & 31, ob = rr * 64 + cc * 2; return st * 1024 + (ob ^ (((ob >> 9) & 1) << 5)); }
__host__ __device__ __forceinline__ void stage_rc(int b, int& R, int& C) { const int st = b / 1024, sb = b % 1024, swz = sb ^ (((sb >> 9) & 1) << 5); R = (st >> 1) * 16 + swz / 64; C = (st & 1) * 32 + (swz % 64) / 2; }
__host__ __device__ __forceinline__ int perm32(int rho) { const int n = rho >> 4, i = rho & 15; return 8 * (i >> 2) + 4 * n + (i & 3); }

struct Unit { int pm, pn; };
struct Gemm { const bf16_t* A; const bf16_t* Bt; int lda, ldb, K; };

struct StaticOrder {
    int nM, nN, nwg, G, c;
    __host__ __device__ void init(int M, int N, int G_, int c_) { nM = M / BM; nN = N / BM; nwg = nM * nN; G = G_; c = c_; }
    __host__ __device__ bool next(int i, Unit& u) const {
        const long L = (long)i * G + c; if (L >= nwg) return false;
        int wgid = (int)L; { const int q = nwg / NXCD, r = nwg % NXCD, xcd = wgid % NXCD, off = wgid / NXCD; wgid = (xcd < r ? xcd * (q + 1) : r * (q + 1) + (xcd - r) * q) + off; }
        const int nig = WGM * nN, gid = wgid / nig, fm = gid * WGM, gsz = (nM - fm) < WGM ? (nM - fm) : WGM;
        u.pm = fm + ((wgid % nig) % gsz); u.pn = (wgid % nig) / gsz; return true;
    }
    __device__ __forceinline__ void a_ready(const Unit&) const {}
    __device__ __forceinline__ void done(const Unit&) const {}
};

__device__ __forceinline__ unsigned cvt_pk_bf16(float lo, float hi) { unsigned r; asm volatile("v_cvt_pk_bf16_f32 %0, %1, %2" : "=v"(r) : "v"(lo), "v"(hi)); return r; }
__device__ __forceinline__ u32x4 pack8(const f32x4 v0, const f32x4 v1) { u32x4 w; w.x = cvt_pk_bf16(v0[0], v0[1]); w.y = cvt_pk_bf16(v0[2], v0[3]); w.z = cvt_pk_bf16(v1[0], v1[1]); w.w = cvt_pk_bf16(v1[2], v1[3]); return w; }
__device__ __forceinline__ float gelu_fast(float x) {
    const float u2 = x * (1.5957691216057308f + 0.07135481627260025f * x * x);
    return x * __builtin_amdgcn_rcpf(1.f + __builtin_amdgcn_exp2f(-1.4426950408889634f * u2)); }
__device__ __forceinline__ float sigmoid_fast(float x) { return __builtin_amdgcn_rcpf(1.f + __builtin_amdgcn_exp2f(-1.4426950408889634f * x)); }
__device__ __forceinline__ f32x4 gelu4(f32x4 v) { return (f32x4){gelu_fast(v[0]), gelu_fast(v[1]), gelu_fast(v[2]), gelu_fast(v[3])}; }


struct EpiZ0 { static constexpr bool PERM = true, AFTER_DRAIN = false; bf16_t* zb; const float* rs0;
    __device__ __forceinline__ void operator()(const f32x4 (&acc)[2][2][4][2], const Unit& u, int wr, int wc, int fr, int fq) const {
        const int row0 = u.pm * BM + wr * 64 + fr, col0 = u.pn * BM + wc * 32 + 8 * fq; const bool act = u.pn < 4;
#pragma unroll
        for (int ai = 0; ai < 2; ++ai)
#pragma unroll
            for (int m = 0; m < 4; ++m) { const int row = row0 + ai * HALF + m * 16; const float rs = rs0[row]; bf16_t* rowp = zb + (size_t)row * ZLD + col0;
#pragma unroll
                for (int bj = 0; bj < 2; ++bj) { f32x4 v0 = acc[ai][bj][m][0] * rs, v1 = acc[ai][bj][m][1] * rs; if (act) { v0 = gelu4(v0); v1 = gelu4(v1); }
                    *(u32x4*)(rowp + bj * HALF) = pack8(v0, v1); } }
    } };
struct EpiStore { static constexpr bool PERM = true, AFTER_DRAIN = false; bf16_t* O; int ldo; int pad;
    __device__ __forceinline__ void operator()(const f32x4 (&acc)[2][2][4][2], const Unit& u, int wr, int wc, int fr, int fq) const {
        const int row0 = u.pm * BM + wr * 64 + fr, col0 = u.pn * BM + wc * 32 + 8 * fq;
#pragma unroll
        for (int ai = 0; ai < 2; ++ai)
#pragma unroll
            for (int m = 0; m < 4; ++m) { bf16_t* rowp = O + (size_t)(row0 + ai * HALF + m * 16) * ldo + col0;
#pragma unroll
                for (int bj = 0; bj < 2; ++bj) *(u32x4*)(rowp + bj * HALF) = pack8(acc[ai][bj][m][0], acc[ai][bj][m][1]); }
    } };
template <bool FIRST, bool LAST> struct EpiResid { static constexpr bool PERM = !LAST, AFTER_DRAIN = false; const float* basef; float* out; bf16_t* xb; float* ss;
    __device__ __forceinline__ void operator()(const f32x4 (&acc)[2][2][4][2], const Unit& u, int wr, int wc, int fr, int fq) const {
        const int row0 = u.pm * BM + wr * 64 + fr;
        if constexpr (!LAST) {
            const int col0 = u.pn * BM + wc * 32 + 8 * fq;
            u32x4 rb[2][4][2];
#pragma unroll
            for (int ai = 0; ai < 2; ++ai)
#pragma unroll
                for (int m = 0; m < 4; ++m)
#pragma unroll
                    for (int bj = 0; bj < 2; ++bj) rb[ai][m][bj] = *(const u32x4*)(xb + (size_t)(row0 + ai * HALF + m * 16) * DM + col0 + bj * HALF);
#pragma unroll
            for (int ai = 0; ai < 2; ++ai)
#pragma unroll
                for (int m = 0; m < 4; ++m) { const int row = row0 + ai * HALF + m * 16; bf16_t* rowp = xb + (size_t)row * DM + col0; float sq = 0.f;
#pragma unroll
                    for (int bj = 0; bj < 2; ++bj) { const u32x4 b = rb[ai][m][bj];
                        f32x4 v0 = (f32x4){__uint_as_float(b.x << 16), __uint_as_float(b.x & 0xffff0000u), __uint_as_float(b.y << 16), __uint_as_float(b.y & 0xffff0000u)} + acc[ai][bj][m][0];
                        f32x4 v1 = (f32x4){__uint_as_float(b.z << 16), __uint_as_float(b.z & 0xffff0000u), __uint_as_float(b.w << 16), __uint_as_float(b.w & 0xffff0000u)} + acc[ai][bj][m][1];
                        *(u32x4*)(rowp + bj * HALF) = pack8(v0, v1);
                        sq += (v0[0] * v0[0] + v0[1] * v0[1]) + (v0[2] * v0[2] + v0[3] * v0[3]) + (v1[0] * v1[0] + v1[1] * v1[1]) + (v1[2] * v1[2] + v1[3] * v1[3]); }
                    sq += __shfl_xor(sq, 16); sq += __shfl_xor(sq, 32); if (fq == 0) atomicAdd(ss + row, sq);
                    if (m & 1) asm volatile("" ::: "memory"); }
        } else {
            const int col0 = u.pn * BM + wc * 32 + 4 * fq;
            u32x2 rb[2][4][2][2];
#pragma unroll
            for (int ai = 0; ai < 2; ++ai)
#pragma unroll
                for (int m = 0; m < 4; ++m)
#pragma unroll
                    for (int bj = 0; bj < 2; ++bj)
#pragma unroll
                        for (int n = 0; n < 2; ++n) rb[ai][m][bj][n] = *(const u32x2*)(xb + (size_t)(row0 + ai * HALF + m * 16) * DM + col0 + bj * HALF + n * 16);
#pragma unroll
            for (int ai = 0; ai < 2; ++ai)
#pragma unroll
                for (int m = 0; m < 4; ++m) { const int row = row0 + ai * HALF + m * 16; const size_t off = (size_t)row * DM + col0;
#pragma unroll
                    for (int bj = 0; bj < 2; ++bj)
#pragma unroll
                        for (int n = 0; n < 2; ++n) { const size_t o2 = off + bj * HALF + n * 16; const u32x2 b = rb[ai][m][bj][n];
                            const f32x4 v = (f32x4){__uint_as_float(b.x << 16), __uint_as_float(b.x & 0xffff0000u), __uint_as_float(b.y << 16), __uint_as_float(b.y & 0xffff0000u)} + acc[ai][bj][m][n];
                            *(f32x4*)(out + o2) = v; }
                    if (m & 1) asm volatile("" ::: "memory"); }
        }
    } };
struct EpiSwiglu { static constexpr bool PERM = true, AFTER_DRAIN = false; bf16_t* act; const float* ss;
    __device__ __forceinline__ void operator()(const f32x4 (&acc)[2][2][4][2], const Unit& u, int wr, int wc, int fr, int fq) const {
        const int row0 = u.pm * BM + wr * 64 + fr, col0 = u.pn * HALF + wc * 32 + 8 * fq;
#pragma unroll
        for (int ai = 0; ai < 2; ++ai)
#pragma unroll
            for (int m = 0; m < 4; ++m) { const int row = row0 + ai * HALF + m * 16; const float rs = __builtin_amdgcn_rsqf(ss[row] * (1.f / DM) + EPS);
                f32x4 o[2];
#pragma unroll
                for (int n = 0; n < 2; ++n) { const f32x4 g = acc[ai][0][m][n] * rs, up = acc[ai][1][m][n] * rs;
#pragma unroll
                    for (int j = 0; j < 4; ++j) o[n][j] = g[j] * sigmoid_fast(g[j]) * up[j]; }
                *(u32x4*)(act + (size_t)row * DFF + col0) = pack8(o[0], o[1]); }
    } };
struct EpiIn1 { static constexpr bool PERM = true, AFTER_DRAIN = false; bf16_t* qp; bf16_t* kpp; bf16_t* v; const float* ss; const float* inv2pi; const float* unused_;
    __device__ __forceinline__ void operator()(const f32x4 (&acc)[2][2][4][2], const Unit& u, int wr, int wc, int fr, int fq) const {
        const int row0 = u.pm * BM + wr * 64 + fr;
        if (u.pn < 8) {
            const int h = u.pn & 3, d0 = wc * 32 + 8 * fq; const bool isq = u.pn < 4; bf16_t* dst = isq ? qp : kpp;
            const float lg2 = __log2f(1.f - __builtin_amdgcn_exp2f(-5.f - (float)h)) * (isq ? 1.f : -1.f), mul = isq ? 1.f : 0.0625f;
            f32x4 iv[2]; iv[0] = *(const f32x4*)(inv2pi + d0); iv[1] = *(const f32x4*)(inv2pi + d0 + 4);
#pragma unroll
            for (int ai = 0; ai < 2; ++ai)
#pragma unroll
                for (int m = 0; m < 4; ++m) { const int row = row0 + ai * HALF + m * 16, pos = row & (SEQ - 1), jj = row & 63;
                    const float rs = __builtin_amdgcn_rsqf(ss[row] * (1.f / DM) + EPS), sc = __builtin_amdgcn_exp2f(lg2 * (float)(jj + 1)) * mul;
                    f32x4 y1[2], y2[2];
#pragma unroll
                    for (int n = 0; n < 2; ++n) { f32x4 c, s;
#pragma unroll
                        for (int j = 0; j < 4; ++j) { const float rev = __builtin_amdgcn_fractf((float)pos * iv[n][j]); c[j] = __builtin_amdgcn_cosf(rev); s[j] = __builtin_amdgcn_sinf(rev); }
                        const f32x4 x1 = acc[ai][0][m][n] * rs, x2 = acc[ai][1][m][n] * rs;
                        y1[n] = (x1 * c - x2 * s) * sc; y2[n] = (x2 * c + x1 * s) * sc; }
                    bf16_t* rowp = dst + (size_t)row * 1024 + h * 256;
                    if (isq) { const int p0 = (d0 & ~15) + 4 * ((d0 >> 3) & 1);
                        u32x2 w; w.x = cvt_pk_bf16(y1[0][0], y1[0][1]); w.y = cvt_pk_bf16(y1[0][2], y1[0][3]); *(u32x2*)(rowp + p0) = w;
                        w.x = cvt_pk_bf16(y1[1][0], y1[1][1]); w.y = cvt_pk_bf16(y1[1][2], y1[1][3]); *(u32x2*)(rowp + p0 + 8) = w;
                        w.x = cvt_pk_bf16(y2[0][0], y2[0][1]); w.y = cvt_pk_bf16(y2[0][2], y2[0][3]); *(u32x2*)(rowp + 128 + p0) = w;
                        w.x = cvt_pk_bf16(y2[1][0], y2[1][1]); w.y = cvt_pk_bf16(y2[1][2], y2[1][3]); *(u32x2*)(rowp + 128 + p0 + 8) = w; }
                    else { *(u32x4*)(rowp + d0) = pack8(y1[0], y1[1]); *(u32x4*)(rowp + d0 + 128) = pack8(y2[0], y2[1]); } }
        } else {
            const int col0 = (u.pn - 8) * BM + wc * 32 + 8 * fq;
#pragma unroll
            for (int ai = 0; ai < 2; ++ai)
#pragma unroll
                for (int m = 0; m < 4; ++m) { const int row = row0 + ai * HALF + m * 16; const float rs = __builtin_amdgcn_rsqf(ss[row] * (1.f / DM) + EPS); bf16_t* rowp = v + (size_t)row * 2048 + col0;
#pragma unroll
                    for (int bj = 0; bj < 2; ++bj) *(u32x4*)(rowp + bj * HALF) = pack8(acc[ai][bj][m][0] * rs, acc[ai][bj][m][1] * rs); }
        }
    } };
struct EpiGate { static constexpr bool PERM = true, AFTER_DRAIN = false; bf16_t* o; const float* ss; const float* ssp;
    __device__ __forceinline__ void operator()(const f32x4 (&acc)[2][2][4][2], const Unit& u, int wr, int wc, int fr, int fq) const {
        const int row0 = u.pm * BM + wr * 64 + fr, col0 = u.pn * BM + wc * 32 + 8 * fq, h = u.pn >> 1;
#pragma unroll
        for (int ai = 0; ai < 2; ++ai)
#pragma unroll
            for (int m = 0; m < 4; ++m) { const int row = row0 + ai * HALF + m * 16; const float rs = __builtin_amdgcn_rsqf(ss[row] * (1.f / DM) + EPS);
                float sq = 0.f;
#pragma unroll
                for (int s4 = 0; s4 < 4; ++s4) sq += ssp[(size_t)((4 * fq + s4) * 4 + h) * M_ + row];
                sq += __shfl_xor(sq, 16); sq += __shfl_xor(sq, 32);
                const float rinv = __builtin_amdgcn_rsqf(sq * (1.f / RV) + EPS); bf16_t* rowp = o + (size_t)row * 2048 + col0;
#pragma unroll
                for (int bj = 0; bj < 2; ++bj) { const u32x4 ow = *(const u32x4*)(rowp + bj * HALF); f32x4 r[2];
#pragma unroll
                    for (int n = 0; n < 2; ++n) { const f32x4 g = acc[ai][bj][m][n] * rs; const unsigned w0 = n ? ow.z : ow.x, w1 = n ? ow.w : ow.y;
                        const float o0 = __uint_as_float(w0 << 16), o1 = __uint_as_float(w0 & 0xffff0000u), o2 = __uint_as_float(w1 << 16), o3 = __uint_as_float(w1 & 0xffff0000u);
                        r[n][0] = o0 * rinv * g[0] * sigmoid_fast(g[0]); r[n][1] = o1 * rinv * g[1] * sigmoid_fast(g[1]); r[n][2] = o2 * rinv * g[2] * sigmoid_fast(g[2]); r[n][3] = o3 * rinv * g[3] * sigmoid_fast(g[3]); }
                    *(u32x4*)(rowp + bj * HALF) = pack8(r[0], r[1]); } }
    } };

template <class Epi, class Sched, bool ALIGN_EPI = false, bool SP2 = false>
__device__ __forceinline__ void gemm_phase(PG8_LAS unsigned char* lds, const Gemm g, const Sched& S, const Epi& E) {
    const int tid = threadIdx.x, wid = __builtin_amdgcn_readfirstlane(tid >> 6), lane = tid & 63, wr = wid >> 2, wc = wid & 3, fr = lane & 15, fq = lane >> 4;
    const int K = g.K, nt = K / BK;
    unsigned voffA[2], voffB[2];
#pragma unroll
    for (int i = 0; i < 2; ++i) { int R, C; stage_rc(tid * 16 + i * 8192, R, C); const int Rb = Epi::PERM ? ((R & ~31) + perm32(R & 31)) : R;
        voffA[i] = (unsigned)(R * g.lda + C) * 2u; voffB[i] = (unsigned)(Rb * g.ldb + C) * 2u; }
    const size_t kstep = (size_t)(BK * 2);
    const size_t hstepA = (size_t)HALF * g.lda * 2, hstepB = (size_t)HALF * g.ldb * 2;
    const size_t tstepA = 2 * hstepA, tstepB = 2 * hstepB;
    const unsigned ldsw = (unsigned)wid * 1024u;
    const int aoff = lds_byte(wr * 64 + fr, fq * 8), boff = lds_byte(wc * 32 + fr, fq * 8);
#define PG8_SA(b, h) (((b) * 2 + (h)) * HTB)
#define PG8_SB(b, h) ((4 + (b) * 2 + (h)) * HTB)
#define PG8_STAGE(bufoff, gbase, voff) do { _Pragma("unroll") for (int _i = 0; _i < 2; ++_i) \
        __builtin_amdgcn_global_load_lds((const unsigned*)((const char*)(gbase) + (voff)[_i]), (PG8_LAS unsigned*)(lds + (bufoff) + ldsw + _i * 8192), 16, 0, 0); } while (0)
#define PG8_LDA(dst, b, h) do { _Pragma("unroll") for (int m = 0; m < 4; ++m) _Pragma("unroll") for (int k = 0; k < 2; ++k) dst[m][k] = *(const PG8_LAS bf16x8*)(lds + PG8_SA(b, h) + aoff + m * 2048 + k * 1024); } while (0)
#define PG8_LDB(dst, b, h) do { _Pragma("unroll") for (int n = 0; n < 2; ++n) _Pragma("unroll") for (int k = 0; k < 2; ++k) dst[n][k] = *(const PG8_LAS bf16x8*)(lds + PG8_SB(b, h) + boff + n * 2048 + k * 1024); } while (0)
#define PG8_MMA(ai, bj, At, Bt) do { __builtin_amdgcn_s_setprio(1); _Pragma("unroll") for (int m = 0; m < 4; ++m) _Pragma("unroll") for (int n = 0; n < 2; ++n) _Pragma("unroll") for (int k = 0; k < 2; ++k) \
        acc[ai][bj][m][n] = __builtin_amdgcn_mfma_f32_16x16x32_bf16(Bt[n][k], At[m][k], acc[ai][bj][m][n], 0, 0, 0); __builtin_amdgcn_s_setprio(0); } while (0)
#define PG8_WAIT_V(n) asm volatile("s_waitcnt vmcnt(" #n ")" ::: "memory")
#define PG8_WAIT_L(n) asm volatile("s_waitcnt lgkmcnt(" #n ")" ::: "memory")
#define PG8_BAR __builtin_amdgcn_s_barrier()
#define PG8_SCHED __builtin_amdgcn_sched_barrier(0)
    Unit cur, nxt; int ui = 0;
    if (!S.next(0, cur)) return;
    f32x4 acc[2][2][4][2];
#pragma unroll
    for (int a = 0; a < 2; ++a)
#pragma unroll
        for (int b = 0; b < 2; ++b)
#pragma unroll
            for (int m = 0; m < 4; ++m)
#pragma unroll
                for (int n = 0; n < 2; ++n) acc[a][b][m][n] = (f32x4){0.f, 0.f, 0.f, 0.f};
    bf16x8 At[4][2], B0[2][2], B1[2][2];
    const char* cA = (const char*)g.A + (size_t)cur.pm * tstepA; const char* cB = (const char*)g.Bt + (size_t)cur.pn * tstepB;
    S.a_ready(cur);
    if constexpr (SP2) {
        PG8_STAGE(PG8_SB(0, 0), cB, voffB); PG8_STAGE(PG8_SB(0, 1), cB + hstepB, voffB); PG8_STAGE(PG8_SA(0, 0), cA, voffA); PG8_STAGE(PG8_SA(0, 1), cA + hstepA, voffA);
        if (wr == 1) PG8_BAR;
        PG8_WAIT_V(2); PG8_BAR;
        PG8_STAGE(PG8_SB(1, 0), cB + kstep, voffB); PG8_STAGE(PG8_SA(1, 0), cA + kstep, voffA); PG8_STAGE(PG8_SB(1, 1), cB + hstepB + kstep, voffB);
        PG8_WAIT_V(6); PG8_BAR;
    } else {
        PG8_STAGE(PG8_SB(0, 0), cB, voffB); PG8_STAGE(PG8_SA(0, 0), cA, voffA); PG8_STAGE(PG8_SB(0, 1), cB + hstepB, voffB); PG8_STAGE(PG8_SA(0, 1), cA + hstepA, voffA);
        if (wr == 1) PG8_BAR;
        PG8_WAIT_V(4); PG8_BAR;
        PG8_STAGE(PG8_SB(1, 0), cB + kstep, voffB); PG8_STAGE(PG8_SA(1, 0), cA + kstep, voffA); PG8_STAGE(PG8_SB(1, 1), cB + hstepB + kstep, voffB);
        PG8_WAIT_V(6); PG8_BAR;
    }
    for (;;) {
        const bool has_next = S.next(ui + 1, nxt);
        const char* nA = has_next ? (const char*)g.A + (size_t)nxt.pm * tstepA : cA; const char* nB = has_next ? (const char*)g.Bt + (size_t)nxt.pn * tstepB : cB;
        for (int t = 0; t < nt; t += 2) {
            const bool last = (t == nt - 2);
            const char* a1 = cA + (size_t)(t + 1) * kstep;
            const char* a2 = last ? nA : cA + (size_t)(t + 2) * kstep; const char* b2 = last ? nB : cB + (size_t)(t + 2) * kstep;
            const char* a3 = a2 + kstep; const char* b3 = b2 + kstep;
            if (last && has_next) S.a_ready(nxt);
            if constexpr (SP2) {
            PG8_LDB(B0, 0, 0); PG8_LDB(B1, 0, 1); PG8_SCHED; PG8_LDA(At, 0, 0); PG8_STAGE(PG8_SA(1, 1), a1 + hstepA, voffA);
            PG8_WAIT_V(8); PG8_WAIT_L(0); PG8_BAR; PG8_MMA(0, 0, At, B0); PG8_MMA(0, 1, At, B1); PG8_BAR; PG8_SCHED;
            PG8_LDA(At, 0, 1); PG8_STAGE(PG8_SB(0, 0), b2, voffB); PG8_STAGE(PG8_SB(0, 1), b2 + hstepB, voffB); PG8_STAGE(PG8_SA(0, 0), a2, voffA);
            PG8_WAIT_V(8); PG8_WAIT_L(0); PG8_BAR; PG8_MMA(1, 0, At, B0); PG8_MMA(1, 1, At, B1); PG8_BAR; PG8_SCHED;
            PG8_LDB(B0, 1, 0); PG8_LDB(B1, 1, 1); PG8_SCHED; PG8_LDA(At, 1, 0); PG8_STAGE(PG8_SA(0, 1), a2 + hstepA, voffA);
            PG8_WAIT_V(8); PG8_WAIT_L(0); PG8_BAR; PG8_MMA(0, 0, At, B0); PG8_MMA(0, 1, At, B1); PG8_BAR; PG8_SCHED;
            PG8_LDA(At, 1, 1); PG8_STAGE(PG8_SB(1, 0), b3, voffB); PG8_STAGE(PG8_SB(1, 1), b3 + hstepB, voffB); PG8_STAGE(PG8_SA(1, 0), a3, voffA);
            PG8_WAIT_V(8); PG8_WAIT_L(0); PG8_BAR; PG8_MMA(1, 0, At, B0); PG8_MMA(1, 1, At, B1); PG8_BAR; PG8_SCHED;
            } else {
            PG8_LDB(B0, 0, 0); PG8_SCHED; PG8_LDA(At, 0, 0); PG8_STAGE(PG8_SA(1, 1), a1 + hstepA, voffA);
            PG8_WAIT_L(8); PG8_BAR; PG8_WAIT_L(0); PG8_MMA(0, 0, At, B0); PG8_BAR; PG8_SCHED;
            PG8_LDB(B1, 0, 1); PG8_STAGE(PG8_SB(0, 0), b2, voffB);
            PG8_BAR; PG8_WAIT_L(0); PG8_MMA(0, 1, At, B1); PG8_BAR;
            PG8_LDA(At, 0, 1); PG8_STAGE(PG8_SA(0, 0), a2, voffA);
            PG8_BAR; PG8_WAIT_L(0); PG8_MMA(1, 0, At, B0); PG8_BAR; PG8_SCHED;
            PG8_STAGE(PG8_SB(0, 1), b2 + hstepB, voffB);
            PG8_WAIT_V(6); PG8_BAR; PG8_MMA(1, 1, At, B1); PG8_BAR;
            PG8_LDB(B0, 1, 0); PG8_SCHED; PG8_LDA(At, 1, 0); PG8_STAGE(PG8_SA(0, 1), a2 + hstepA, voffA);
            PG8_WAIT_L(8); PG8_BAR; PG8_WAIT_L(0); PG8_MMA(0, 0, At, B0); PG8_BAR; PG8_SCHED;
            PG8_LDB(B1, 1, 1); PG8_STAGE(PG8_SB(1, 0), b3, voffB);
            PG8_BAR; PG8_WAIT_L(0); PG8_MMA(0, 1, At, B1); PG8_BAR;
            PG8_LDA(At, 1, 1); PG8_STAGE(PG8_SA(1, 0), a3, voffA);
            PG8_BAR; PG8_WAIT_L(0); PG8_MMA(1, 0, At, B0); PG8_BAR; PG8_SCHED;
            PG8_STAGE(PG8_SB(1, 1), b3 + hstepB, voffB);
            PG8_WAIT_V(6); PG8_BAR; PG8_MMA(1, 1, At, B1); PG8_BAR;
            }
        }
        if constexpr (ALIGN_EPI) { if (wr == 0) PG8_BAR; }
        if constexpr (!Epi::AFTER_DRAIN) { E(acc, cur, wr, wc, fr, fq); S.done(cur); }
        if (!has_next) break;
#pragma unroll
        for (int a = 0; a < 2; ++a)
#pragma unroll
            for (int b = 0; b < 2; ++b)
#pragma unroll
                for (int m = 0; m < 4; ++m)
#pragma unroll
                    for (int n = 0; n < 2; ++n) acc[a][b][m][n] = (f32x4){0.f, 0.f, 0.f, 0.f};
        cur = nxt; cA = nA; cB = nB; ++ui;
        if constexpr (ALIGN_EPI) { if (wr == 1) PG8_BAR; }
    }
    PG8_WAIT_V(0);
    if constexpr (!ALIGN_EPI) { if (wr == 0) PG8_BAR; }
    PG8_BAR;
    if constexpr (Epi::AFTER_DRAIN) { E.fused(acc, cur, wr, wc, fr, fq, lds, wid, lane); S.done(cur); }
#undef PG8_SA
#undef PG8_SB
#undef PG8_STAGE
#undef PG8_LDA
#undef PG8_LDB
#undef PG8_MMA
#undef PG8_WAIT_V
#undef PG8_WAIT_L
#undef PG8_BAR
#undef PG8_SCHED
}
}


namespace fp {
using s16x4 = __attribute__((ext_vector_type(4))) short;
#define SBAR() __builtin_amdgcn_sched_barrier(0)
__device__ __forceinline__ int crow(int r, int hi) { return (r & 3) + 8 * (r >> 2) + 4 * hi; }
__device__ __forceinline__ unsigned cvtpk(float lo, float hi) { unsigned r; asm volatile("v_cvt_pk_bf16_f32 %0, %1, %2" : "=v"(r) : "v"(lo), "v"(hi)); return r; }
template <int NCB> __device__ __forceinline__ int t_st(int k, int c) { const int kk = (k & ~0xC) | ((k & 4) << 1) | ((k & 8) >> 1); return ((kk >> 3) * NCB + (c >> 5)) * 512 + ((kk & 7) * 32 + (c & 31)) * 2; }
__device__ __forceinline__ int t_rd_base(int lane) { return ((lane & 3) << 3) | (((lane >> 2) & 3) << 6) | (((lane >> 4) & 1) << 5) | (((lane >> 5) & 1) << 8); }
template <int OFF> __device__ __forceinline__ s16x4 tr_read(int vb) { s16x4 r; asm volatile("ds_read_b64_tr_b16 %0, %1 offset:%2" : "=&v"(r) : "v"(vb), "i"(OFF) : "memory"); return r; }
#define TPK(L, H) (bf16x8){L[0], L[1], L[2], L[3], H[0], H[1], H[2], H[3]}

namespace att {
#ifndef ATT_K_AT
#define ATT_K_AT WS_KVRAW
#define ATT_LDK 1024
#define ATT_V_AT WS_VB
#define ATT_LDV 512
#define ATT_VOFF(h) ((h) * 64)
#endif
constexpr int NW = 8, QBLK = 32, KVBLK = 64, LDQ = 768, LDK = ATT_LDK, LDV = ATT_LDV, LDO = 1024;
#ifndef ATT_THR
#define ATT_THR 8.f
#endif
constexpr float QSCALE = 0.10206207261596575f * 1.4426950408889634f, THRL = ATT_THR * 1.4426950408889634f;
constexpr int SHM_V = 8192, SHM_K = 16384, OFF_V = 0, OFF_K = 2 * SHM_V, OFF_WS = OFF_K + 2 * SHM_K, LDS_NEED = OFF_WS + NW * 64 * 4;
#define KSWZ(row, colB) ((row) * 256 + ((colB) ^ (((row) & 7) << 4)))
__device__ __forceinline__ float max3f(float a, float b, float c) { return __builtin_fmaxf(__builtin_fmaxf(a, b), c); }
__device__ __forceinline__ void partialSM(f32x16& p0, f32x16& p1, float& mhat, f32x16& negm, float& alpha) {
    float a = max3f(p0[0], p0[1], p1[0]), b = max3f(p0[2], p0[3], p1[1]); a = max3f(a, p1[2], p1[3]);
#pragma unroll
    for (int r = 4; r < 16; r += 4) { a = max3f(a, p0[r], p0[r + 1]); b = max3f(b, p0[r + 2], p0[r + 3]); a = max3f(a, p1[r], p1[r + 1]); b = max3f(b, p1[r + 2], p1[r + 3]); }
    float rm = fmaxf(a, b);
    { auto rr = __builtin_amdgcn_permlane32_swap(__float_as_uint(rm), __float_as_uint(rm), false, false); rm = fmaxf(__uint_as_float(rr[0]), __uint_as_float(rr[1])); }
    if (__builtin_expect(__all(rm <= THRL), 1)) { alpha = 1.f; }
    else { const float dl = fmaxf(rm, 0.f); mhat += dl; alpha = __builtin_amdgcn_exp2f(-dl);
#pragma unroll
        for (int r = 0; r < 16; ++r) { p0[r] -= dl; p1[r] -= dl; }
#pragma unroll
        for (int r = 0; r < 16; ++r) negm[r] = -mhat; }
#pragma unroll
    for (int r = 0; r < 16; ++r) p0[r] = __builtin_amdgcn_exp2f(p0[r]);
}
__device__ __forceinline__ void finishSM(f32x16& p0, f32x16& p1, float alpha, float& l_reg, bf16x8& pa0, bf16x8& pa1, bf16x8& pa2, bf16x8& pa3) {
#pragma unroll
    for (int r = 0; r < 16; ++r) p1[r] = __builtin_amdgcn_exp2f(p1[r]);
    float ps = 0;
#pragma unroll
    for (int r = 0; r < 16; ++r) ps += p0[r];
#pragma unroll
    for (int r = 0; r < 16; ++r) ps += p1[r];
    { auto rr = __builtin_amdgcn_permlane32_swap(__float_as_uint(ps), __float_as_uint(ps), false, false); ps = __uint_as_float(rr[0]) + __uint_as_float(rr[1]); }
    l_reg = l_reg * alpha + ps;
#define PK4(P, BASE, OUT) do { unsigned a0 = cvtpk(P[BASE + 0], P[BASE + 1]), a1 = cvtpk(P[BASE + 2], P[BASE + 3]);   \
    unsigned b0 = cvtpk(P[BASE + 4], P[BASE + 5]), b1 = cvtpk(P[BASE + 6], P[BASE + 7]);                              \
    auto r0 = __builtin_amdgcn_permlane32_swap(a0, b0, false, false); auto r1 = __builtin_amdgcn_permlane32_swap(a1, b1, false, false); \
    u32x4 w = {r0[0], r1[0], r0[1], r1[1]}; OUT = *reinterpret_cast<bf16x8*>(&w); } while (0)
    PK4(p0, 0, pa0); PK4(p0, 8, pa1); PK4(p1, 0, pa2); PK4(p1, 8, pa3);
#undef PK4
}
__device__ __forceinline__ void qkt(f32x16& p0, f32x16& p1, const char* Ks, const bf16x8* qr, const f32x16& negm, int r32, int hi) {
#pragma unroll
    for (int d0 = 0; d0 < 6; ++d0) { const int cb = (d0 * 16 + hi * 8) * 2;
        const bf16x8 b0 = *reinterpret_cast<const bf16x8*>(Ks + KSWZ(r32, cb));
        const bf16x8 b1 = *reinterpret_cast<const bf16x8*>(Ks + KSWZ(32 + r32, cb));
        if (d0 == 0) { p0 = __builtin_amdgcn_mfma_f32_32x32x16_bf16(b0, qr[0], negm, 0, 0, 0); p1 = __builtin_amdgcn_mfma_f32_32x32x16_bf16(b1, qr[0], negm, 0, 0, 0); }
        else { p0 = __builtin_amdgcn_mfma_f32_32x32x16_bf16(b0, qr[d0], p0, 0, 0, 0); p1 = __builtin_amdgcn_mfma_f32_32x32x16_bf16(b1, qr[d0], p1, 0, 0, 0); } }
}
constexpr int v_rd_off(int d0, int ks, int half) { return d0 * 512 + ks * 2048 + half * 1024; }
template <int D0> __device__ __forceinline__ void pv_one(f32x16& od, int vb, bf16x8 pa0, bf16x8 pa1, bf16x8 pa2, bf16x8 pa3) {
    const s16x4 l0 = tr_read<v_rd_off(D0, 0, 0)>(vb), h0 = tr_read<v_rd_off(D0, 0, 1)>(vb), l1 = tr_read<v_rd_off(D0, 1, 0)>(vb), h1 = tr_read<v_rd_off(D0, 1, 1)>(vb);
    const s16x4 l2 = tr_read<v_rd_off(D0, 2, 0)>(vb), h2 = tr_read<v_rd_off(D0, 2, 1)>(vb), l3 = tr_read<v_rd_off(D0, 3, 0)>(vb), h3 = tr_read<v_rd_off(D0, 3, 1)>(vb);
    asm volatile("s_waitcnt lgkmcnt(0)" ::: "memory"); SBAR();
    od = __builtin_amdgcn_mfma_f32_32x32x16_bf16(pa0, TPK(l0, h0), od, 0, 0, 0);
    od = __builtin_amdgcn_mfma_f32_32x32x16_bf16(pa1, TPK(l1, h1), od, 0, 0, 0);
    od = __builtin_amdgcn_mfma_f32_32x32x16_bf16(pa2, TPK(l2, h2), od, 0, 0, 0);
    od = __builtin_amdgcn_mfma_f32_32x32x16_bf16(pa3, TPK(l3, h3), od, 0, 0, 0);
}
__device__ __forceinline__ void pv_d0(f32x16* o, int vb, bf16x8 pa0, bf16x8 pa1, bf16x8 pa2, bf16x8 pa3) { pv_one<0>(o[0], vb, pa0, pa1, pa2, pa3); pv_one<1>(o[1], vb, pa0, pa1, pa2, pa3); }

__device__ __forceinline__ void attn_unit(const bf16_t* __restrict__ Qb, const bf16_t* __restrict__ Kh, const bf16_t* __restrict__ Vh, bf16_t* __restrict__ Ob, int q0, char* lds) {
    const int tid = threadIdx.x, wid = tid >> 6, lane = tid & 63, r32 = lane & 31, hi = lane >> 5;
    char* V_lds = lds + OFF_V; char* K_lds = lds + OFF_K;
    float* wsf = (float*)(lds + OFF_WS) + wid * 64; float* li_l = wsf; float* al_l = wsf + 32;
    float mhat = 0.f, l_reg = 0; f32x16 o[2] = {}; bf16x8 qr[6]; f32x16 negm = {};
    const bf16_t* Qw = Qb + (long)(wid * QBLK + r32) * LDQ + hi * 8;
#pragma unroll
    for (int d0 = 0; d0 < 6; ++d0) qr[d0] = *reinterpret_cast<const bf16x8*>(Qw + d0 * 16);
    const int srow = tid >> 3, sch = tid & 7;
    const int vst = t_st<2>(srow, sch * 8), kst0 = KSWZ(srow, sch * 16), kst1 = KSWZ(srow, (sch + 8) * 16);
    const int vb0 = (int)(uintptr_t)V_lds + t_rd_base(lane);
    const int koff1 = (sch & 4) ? 32 : 64;
    struct { bf16x8 k0, k1, v0; } sr_[1];
#define SLOAD(i, key0) do { const bf16_t* kp_ = Kh + (long)((key0) + srow) * LDK + sch * 8; sr_[i].k0 = *reinterpret_cast<const bf16x8*>(kp_); sr_[i].k1 = *reinterpret_cast<const bf16x8*>(kp_ + koff1); \
    sr_[i].v0 = *reinterpret_cast<const bf16x8*>(Vh + (long)((key0) + srow) * LDV + sch * 8); } while (0)
#define SWRITE(b, i) do { *(bf16x8*)(K_lds + (b) * SHM_K + kst0) = sr_[i].k0; *(bf16x8*)(K_lds + (b) * SHM_K + kst1) = sr_[i].k1; *(bf16x8*)(V_lds + (b) * SHM_V + vst) = sr_[i].v0; } while (0)
#define SWAIT() asm volatile("s_waitcnt vmcnt(0)" ::: "memory")
#define RESC(a) do { if (__any((a) < 1.f)) { if (hi == 0) al_l[r32] = (a); asm volatile("s_waitcnt lgkmcnt(0)" ::: "memory"); \
    _Pragma("unroll") for (int d = 0; d < 2; ++d) _Pragma("unroll") for (int r = 0; r < 16; ++r) o[d][r] *= al_l[crow(r, hi)]; } } while (0)
#define MASKT(P0, P1, t) do { if ((t) > tmaxw) { _Pragma("unroll") for (int r = 0; r < 16; ++r) { P0[r] = -1e30f; P1[r] = -1e30f; } } } while (0)
    f32x16 pA0, pA1, pB0, pB1; float alA, alB; bf16x8 pa0, pa1, pa2, pa3;
    const int NT = q0 / KVBLK + 4; const int tmaxw = (q0 + wid * QBLK) / KVBLK;
    constexpr int SE = 0, SO = 0;
    SLOAD(SE, 0); asm volatile("s_waitcnt vmcnt(0)" ::: "memory"); SWRITE(0, SE); __syncthreads();
    qkt(pA0, pA1, K_lds, qr, negm, r32, hi); partialSM(pA0, pA1, mhat, negm, alA);
    SLOAD(SO, KVBLK);
    SWAIT(); SWRITE(1, SO); __syncthreads();
    for (int j = 1; j + 1 < NT; j += 2) {
        SBAR(); qkt(pB0, pB1, K_lds + SHM_K, qr, negm, r32, hi); MASKT(pB0, pB1, j);
        finishSM(pA0, pA1, alA, l_reg, pa0, pa1, pa2, pa3); SBAR();
        SLOAD(SO, (j + 1) * KVBLK); SBAR();
        pv_d0(o, vb0, pa0, pa1, pa2, pa3); partialSM(pB0, pB1, mhat, negm, alB);
        __syncthreads(); SWAIT(); SWRITE(0, SE);
        RESC(alB); __syncthreads();
        SBAR(); qkt(pA0, pA1, K_lds, qr, negm, r32, hi); MASKT(pA0, pA1, j + 1);
        finishSM(pB0, pB1, alB, l_reg, pa0, pa1, pa2, pa3); SBAR();
        SLOAD(SE, (j + 2) * KVBLK); SBAR();
        pv_d0(o, vb0 + SHM_V, pa0, pa1, pa2, pa3); partialSM(pA0, pA1, mhat, negm, alA);
        __syncthreads(); SWAIT(); SWRITE(1, SO);
        RESC(alA); __syncthreads();
    }
    SBAR(); qkt(pB0, pB1, K_lds + SHM_K, qr, negm, r32, hi); MASKT(pB0, pB1, NT - 1);
    finishSM(pA0, pA1, alA, l_reg, pa0, pa1, pa2, pa3); SBAR();
    pv_d0(o, vb0, pa0, pa1, pa2, pa3); partialSM(pB0, pB1, mhat, negm, alB);
    __syncthreads(); RESC(alB);
    finishSM(pB0, pB1, alB, l_reg, pa0, pa1, pa2, pa3); SBAR();
    pv_d0(o, vb0 + SHM_V, pa0, pa1, pa2, pa3);
    if (hi == 0) li_l[r32] = l_reg; asm volatile("s_waitcnt lgkmcnt(0)" ::: "memory");
    float rli[16];
#pragma unroll
    for (int r = 0; r < 16; ++r) rli[r] = __builtin_amdgcn_rcpf(li_l[crow(r, hi)]);
    bf16_t* Ow = Ob + (long)(wid * QBLK) * LDO;
#pragma unroll
    for (int r = 0; r < 16; ++r) { const int orow = crow(r, hi);
#pragma unroll
        for (int d0 = 0; d0 < 2; ++d0) Ow[(long)orow * LDO + d0 * 32 + r32] = f2bf(o[d0][r] * rli[r]); }
    __syncthreads();
#undef SLOAD
#undef SWRITE
#undef SWAIT
#undef RESC
#undef MASKT
}
__device__ __forceinline__ void attn_phase(unsigned char* ws, char* lds, int vcu, int G) {
    const bf16_t* q = (const bf16_t*)(ws + WS_QRAW); const bf16_t* k = (const bf16_t*)(ws + ATT_K_AT); const bf16_t* v = (const bf16_t*)(ws + ATT_V_AT);
#ifdef ATT_DEBUG_ALT
    bf16_t* mix = (bf16_t*)(ws + WS_XB);
#else
    bf16_t* mix = (bf16_t*)(ws + WS_MIX);
#endif
    for (int pi = vcu; pi < 256; pi += G) {
        const int bh = pi >> 3, s = pi & 7, b = bh >> 3, h = bh & 7;
        const size_t rb = (size_t)b * SEQ;
#pragma unroll 1
        for (int u = 0; u < 2; ++u) { const int qb = u ? 15 - s : s, q0 = qb * 256;
#ifdef ATT_QBMASK
            if (!((ATT_QBMASK >> qb) & 1)) continue;
#endif
            attn_unit(q + (rb + q0) * LDQ + h * 96, k + rb * LDK + h * 96, v + rb * LDV + ATT_VOFF(h), mix + (rb + q0) * LDO + 512 + h * 64, q0, lds); }
    }
}
#undef KSWZ
}

template <int CTRL> __device__ __forceinline__ float dppf(float x) { return __builtin_bit_cast(float, __builtin_amdgcn_update_dpp(0, __builtin_bit_cast(int, x), CTRL, 0xF, 0xF, true)); }
__device__ __forceinline__ float sum8(float x) { x += dppf<0xB1>(x); x += dppf<0x4E>(x); x += dppf<0x141>(x); return x; }
__device__ __forceinline__ float sum64(float x) { x = sum8(x); x += dppf<0x140>(x);
    { auto rr = __builtin_amdgcn_permlane16_swap(__float_as_uint(x), __float_as_uint(x), false, false); x = __uint_as_float(rr[0]) + __uint_as_float(rr[1]); }
    { auto rr = __builtin_amdgcn_permlane32_swap(__float_as_uint(x), __float_as_uint(x), false, false); x = __uint_as_float(rr[0]) + __uint_as_float(rr[1]); } return x; }
__device__ __forceinline__ float lo16(unsigned u) { return __uint_as_float(u << 16); }
__device__ __forceinline__ float hi16(unsigned u) { return __uint_as_float(u & 0xffff0000u); }
__device__ __forceinline__ float sq8(u32x4 w) { float s = 0.f; s += lo16(w.x) * lo16(w.x) + hi16(w.x) * hi16(w.x); s += lo16(w.y) * lo16(w.y) + hi16(w.y) * hi16(w.y); s += lo16(w.z) * lo16(w.z) + hi16(w.z) * hi16(w.z); s += lo16(w.w) * lo16(w.w) + hi16(w.w) * hi16(w.w); return s; }


namespace mlaf {
constexpr int PQ = 784, PKV = 528;
__device__ __forceinline__ float sq8b(bf16x8 v) { const u32x4 w = *reinterpret_cast<const u32x4*>(&v); return sq8(w); }
#define TRIG(cs_, sn_, rev_) asm volatile("v_cos_f32 %0, %2\n\tv_sin_f32 %1, %2\n\ts_nop 7\n\ts_nop 7\n\ts_nop 7" : "=&v"(cs_), "=&v"(sn_) : "v"(rev_))
__device__ __forceinline__ float rsq_guarded(float x) { float r; asm volatile("v_rsq_f32 %0, %1\n\ts_nop 7\n\ts_nop 7" : "=&v"(r) : "v"(x)); return r; }
__device__ __forceinline__ float swap32_sum(float x) { auto rr = __builtin_amdgcn_permlane32_swap(__float_as_uint(x), __float_as_uint(x), false, false); return __uint_as_float(rr[0]) + __uint_as_float(rr[1]); }
struct Ctx { const bf16_t* zb; bf16_t* qo; bf16_t* ko; bf16_t* vo; char* lds; const float* qn; const float* kn; const float* invm; int h, r32, hi; };
constexpr int WBUF = 96 * PQ;
static_assert(128 * PKV <= WBUF && 2 * WBUF <= 160 * 1024 - 2048, "two weight buffers fit the LDS");
__device__ __forceinline__ void ld_wq(const bf16_t* Wq, int h, int tid, bf16x8 (&w)[9]) {
#pragma unroll
    for (int i = 0; i < 9; ++i) { const int cc = tid + 512 * i, n = cc / 48, kc = cc % 48; w[i] = *reinterpret_cast<const bf16x8*>(Wq + (size_t)(96 * h + n) * 384 + 8 * kc); } }
__device__ __forceinline__ void st_wq(char* buf, int tid, const bf16x8 (&w)[9]) {
#pragma unroll
    for (int i = 0; i < 9; ++i) { const int cc = tid + 512 * i, n = cc / 48, kc = cc % 48; *(bf16x8*)(buf + n * PQ + 16 * kc) = w[i]; } }
__device__ __forceinline__ void ld_wkv(const bf16_t* Wkv, int h, int tid, bf16x8 (&w)[8]) {
#pragma unroll
    for (int i = 0; i < 8; ++i) { const int cc = tid + 512 * i, n = cc >> 5, kc = cc & 31; w[i] = *reinterpret_cast<const bf16x8*>(Wkv + (size_t)(128 * h + n) * 256 + 8 * kc); } }
__device__ __forceinline__ void st_wkv(char* buf, int tid, const bf16x8 (&w)[8]) {
#pragma unroll
    for (int i = 0; i < 8; ++i) { const int cc = tid + 512 * i, n = cc >> 5, kc = cc & 31; *(bf16x8*)(buf + n * PKV + 16 * kc) = w[i]; } }
__device__ __forceinline__ void q_epi(const Ctx& c, int h, int tok, float pos, float rq, const f32x16& a0, const f32x16& a1, const f32x16& a2) {
    const int hi = c.hi;
    float s = 0.f;
#pragma unroll
    for (int r = 0; r < 16; ++r) s += a0[r] * a0[r] + a1[r] * a1[r] + a2[r] * a2[r];
    const float rn = rsq_guarded(swap32_sum(s) * (rq * rq) * (1.f / MQK) + EPS) * (att::QSCALE * rq);
    bf16_t* qrow = c.qo + (size_t)tok * 768 + h * 96 + 4 * hi; const float* gq = c.qn + 4 * hi;
#pragma unroll
    for (int g = 0; g < 4; ++g) { const f32x4 gn = *(const f32x4*)(gq + 8 * g);
        u32x2 w; w.x = cvtpk(a0[4 * g] * rn * gn[0], a0[4 * g + 1] * rn * gn[1]); w.y = cvtpk(a0[4 * g + 2] * rn * gn[2], a0[4 * g + 3] * rn * gn[3]);
        *(u32x2*)(qrow + 8 * g) = w; asm volatile("" ::: "memory"); }
#pragma unroll
    for (int g = 0; g < 4; ++g) { const f32x4 gn = *(const f32x4*)(gq + 32 + 8 * g);
        u32x2 w; w.x = cvtpk(a1[4 * g] * rn * gn[0], a1[4 * g + 1] * rn * gn[1]); w.y = cvtpk(a1[4 * g + 2] * rn * gn[2], a1[4 * g + 3] * rn * gn[3]);
        *(u32x2*)(qrow + 32 + 8 * g) = w; asm volatile("" ::: "memory"); }
#pragma unroll
    for (int g = 0; g < 2; ++g) { const f32x4 g1 = *(const f32x4*)(gq + 64 + 8 * g), g2 = *(const f32x4*)(gq + 80 + 8 * g), iv = *(const f32x4*)(c.invm + 4 * hi + 8 * g);
        float o1[4], o2[4];
#pragma unroll
        for (int j = 0; j < 4; ++j) { const float x1 = a2[4 * g + j] * rn * g1[j], x2 = a2[4 * g + 8 + j] * rn * g2[j];
            const float rev = __builtin_amdgcn_fractf(pos * iv[j]); float cs, sn; TRIG(cs, sn, rev);
            o1[j] = x1 * cs - x2 * sn; o2[j] = x2 * cs + x1 * sn; }
        u32x2 w; w.x = cvtpk(o1[0], o1[1]); w.y = cvtpk(o1[2], o1[3]); *(u32x2*)(qrow + 64 + 8 * g) = w;
        w.x = cvtpk(o2[0], o2[1]); w.y = cvtpk(o2[2], o2[3]); *(u32x2*)(qrow + 80 + 8 * g) = w; asm volatile("" ::: "memory"); }
}
__device__ __forceinline__ void kv_epi(const Ctx& c, int h, int tok, float pos, float rk, const float (&pf)[4][4], float sp, const f32x16& a0, const f32x16& a1, const f32x16& a2, const f32x16& a3) {
    const int hi = c.hi;
    float s = 0.f;
#pragma unroll
    for (int r = 0; r < 16; ++r) s += a0[r] * a0[r] + a1[r] * a1[r];
    const float rp = rsq_guarded(swap32_sum(s * (rk * rk) + sp) * (1.f / MQK) + EPS), rn = rp * rk;
    bf16_t* krow = c.ko + (size_t)tok * 1024 + h * 96 + 4 * hi; bf16_t* vrow = c.vo + (size_t)tok * 512 + h * 64 + 4 * hi; const float* gk = c.kn + 4 * hi;
#pragma unroll
    for (int g = 0; g < 4; ++g) { const f32x4 gn = *(const f32x4*)(gk + 8 * g);
        u32x2 w; w.x = cvtpk(a0[4 * g] * rn * gn[0], a0[4 * g + 1] * rn * gn[1]); w.y = cvtpk(a0[4 * g + 2] * rn * gn[2], a0[4 * g + 3] * rn * gn[3]);
        *(u32x2*)(krow + 8 * g) = w; asm volatile("" ::: "memory"); }
#pragma unroll
    for (int g = 0; g < 4; ++g) { const f32x4 gn = *(const f32x4*)(gk + 32 + 8 * g);
        u32x2 w; w.x = cvtpk(a1[4 * g] * rn * gn[0], a1[4 * g + 1] * rn * gn[1]); w.y = cvtpk(a1[4 * g + 2] * rn * gn[2], a1[4 * g + 3] * rn * gn[3]);
        *(u32x2*)(krow + 32 + 8 * g) = w; asm volatile("" ::: "memory"); }
#pragma unroll
    for (int g = 0; g < 2; ++g) { const f32x4 g1 = *(const f32x4*)(gk + 64 + 8 * g), g2 = *(const f32x4*)(gk + 80 + 8 * g), iv = *(const f32x4*)(c.invm + 4 * hi + 8 * g);
        float o1[4], o2[4];
#pragma unroll
        for (int j = 0; j < 4; ++j) { const float x1 = pf[g][j] * rp * g1[j], x2 = pf[g + 2][j] * rp * g2[j];
            const float rev = __builtin_amdgcn_fractf(pos * iv[j]); float cs, sn; TRIG(cs, sn, rev);
            o1[j] = x1 * cs - x2 * sn; o2[j] = x2 * cs + x1 * sn; }
        u32x2 w; w.x = cvtpk(o1[0], o1[1]); w.y = cvtpk(o1[2], o1[3]); *(u32x2*)(krow + 64 + 8 * g) = w;
        w.x = cvtpk(o2[0], o2[1]); w.y = cvtpk(o2[2], o2[3]); *(u32x2*)(krow + 80 + 8 * g) = w; asm volatile("" ::: "memory"); }
#pragma unroll
    for (int g = 0; g < 4; ++g) { u32x2 w; w.x = cvtpk(a2[4 * g] * rk, a2[4 * g + 1] * rk); w.y = cvtpk(a2[4 * g + 2] * rk, a2[4 * g + 3] * rk); *(u32x2*)(vrow + 8 * g) = w;
        w.x = cvtpk(a3[4 * g] * rk, a3[4 * g + 1] * rk); w.y = cvtpk(a3[4 * g + 2] * rk, a3[4 * g + 3] * rk); *(u32x2*)(vrow + 32 + 8 * g) = w; asm volatile("" ::: "memory"); }
}
__device__ __forceinline__ void mla_fused_phase(const Ptrs& p, const bf16_t* Wq, const bf16_t* Wkv, char* lds, int vcu) {
    const int tid = threadIdx.x, wid = tid >> 6, lane = tid & 63, r32 = lane & 31, hi = lane >> 5;
    Ctx c; c.zb = (const bf16_t*)(p.ws + WS_ZB); c.qo = (bf16_t*)(p.ws + WS_QRAW); c.ko = (bf16_t*)(p.ws + WS_KVRAW); c.vo = (bf16_t*)(p.ws + WS_VB); c.lds = lds;
    c.qn = p.in[IN_Q_NORM]; c.kn = p.in[IN_K_NORM]; c.invm = (const float*)(p.ws + WS_INVM);
    c.r32 = r32; c.hi = hi; c.h = 0;
    const int h0 = 2 * (vcu & 3), pm = 8 * (vcu >> 5) + ((vcu & 31) >> 2), tok = 256 * pm + 32 * wid + r32;
    const bf16_t* arow = c.zb + (size_t)tok * ZLD + 8 * hi;
    const float pos = (float)(tok & (SEQ - 1));
    char* buf0 = lds; char* buf1 = lds + WBUF;
    constexpr int DQ = 8, DK = 4;
    bf16x8 af[DQ];
#pragma unroll
    for (int i = 0; i < DQ; ++i) af[i] = *reinterpret_cast<const bf16x8*>(arow + ZO_CQ + 16 * i);
    { bf16x8 w[9]; ld_wq(Wq, h0, tid, w); st_wq(buf0, tid, w); }
    { bf16x8 w[9]; ld_wq(Wq, h0 + 1, tid, w); st_wq(buf1, tid, w); }
    __syncthreads();
    bf16x8 wk0[8], wk1[8];
    {
        f32x16 acc[6] = {}; float ssa = 0.f;
        const char* wb0 = buf0 + r32 * PQ + 16 * hi; const char* wb1 = buf1 + r32 * PQ + 16 * hi;
        bf16x8 wf[2][6];
#pragma unroll
        for (int tt = 0; tt < 3; ++tt) { wf[0][tt] = *reinterpret_cast<const bf16x8*>(wb0 + tt * 32 * PQ); wf[0][3 + tt] = *reinterpret_cast<const bf16x8*>(wb1 + tt * 32 * PQ); }
#pragma unroll
        for (int ks = 0; ks < 24; ++ks) { const bf16x8 cur = af[ks % DQ]; ssa += sq8b(cur);
            if (ks + 1 < 24) {
#pragma unroll
                for (int tt = 0; tt < 3; ++tt) { wf[(ks + 1) & 1][tt] = *reinterpret_cast<const bf16x8*>(wb0 + tt * 32 * PQ + 32 * (ks + 1)); wf[(ks + 1) & 1][3 + tt] = *reinterpret_cast<const bf16x8*>(wb1 + tt * 32 * PQ + 32 * (ks + 1)); } }
            SBAR();
#pragma unroll
            for (int tt = 0; tt < 6; ++tt) acc[tt] = __builtin_amdgcn_mfma_f32_32x32x16_bf16(wf[ks & 1][tt], cur, acc[tt], 0, 0, 0);
            SBAR();
            if (ks + DQ < 24) af[ks % DQ] = *reinterpret_cast<const bf16x8*>(arow + ZO_CQ + 16 * (ks + DQ)); }
        ld_wkv(Wkv, h0, tid, wk0); ld_wkv(Wkv, h0 + 1, tid, wk1);
        const float rq = rsq_guarded(swap32_sum(ssa) * (1.f / MQR) + EPS);
        q_epi(c, h0, tok, pos, rq, acc[0], acc[1], acc[2]);
        q_epi(c, h0 + 1, tok, pos, rq, acc[3], acc[4], acc[5]);
    }
    __syncthreads();
    st_wkv(buf0, tid, wk0); st_wkv(buf1, tid, wk1);
    bf16x8 ak[DK];
#pragma unroll
    for (int i = 0; i < DK; ++i) ak[i] = *reinterpret_cast<const bf16x8*>(arow + ZO_CKV + 16 * i);
    u32x2 pe[4];
#pragma unroll
    for (int g = 0; g < 4; ++g) pe[g] = *(const u32x2*)(c.zb + (size_t)tok * ZLD + ZO_KPE + 8 * g + 4 * hi);
    __syncthreads();
    {
        f32x16 acc[8] = {}; float ssk = 0.f;
        const char* wb0 = buf0 + r32 * PKV + 16 * hi; const char* wb1 = buf1 + r32 * PKV + 16 * hi;
#pragma unroll
        for (int ks = 0; ks < 16; ++ks) { const bf16x8 cur = ak[ks % DK]; ssk += sq8b(cur);
            bf16x8 wk8[8];
#pragma unroll
            for (int tt = 0; tt < 4; ++tt) { wk8[tt] = *reinterpret_cast<const bf16x8*>(wb0 + tt * 32 * PKV + 32 * ks); wk8[4 + tt] = *reinterpret_cast<const bf16x8*>(wb1 + tt * 32 * PKV + 32 * ks); }
            SBAR();
#pragma unroll
            for (int tt = 0; tt < 8; ++tt) acc[tt] = __builtin_amdgcn_mfma_f32_32x32x16_bf16(wk8[tt], cur, acc[tt], 0, 0, 0);
            SBAR();
            if (ks + DK < 16) ak[ks % DK] = *reinterpret_cast<const bf16x8*>(arow + ZO_CKV + 16 * (ks + DK)); }
        const float rk = rsq_guarded(swap32_sum(ssk) * (1.f / MKVR) + EPS);
        float pf[4][4], sp = 0.f;
#pragma unroll
        for (int g = 0; g < 4; ++g) { pf[g][0] = __uint_as_float(pe[g].x << 16); pf[g][1] = __uint_as_float(pe[g].x & 0xffff0000u); pf[g][2] = __uint_as_float(pe[g].y << 16); pf[g][3] = __uint_as_float(pe[g].y & 0xffff0000u);
            sp += (pf[g][0] * pf[g][0] + pf[g][1] * pf[g][1]) + (pf[g][2] * pf[g][2] + pf[g][3] * pf[g][3]); }
        kv_epi(c, h0, tok, pos, rk, pf, sp, acc[0], acc[1], acc[2], acc[3]);
        kv_epi(c, h0 + 1, tok, pos, rk, pf, sp, acc[4], acc[5], acc[6], acc[7]);
    }
    __syncthreads();
}
}

__device__ __forceinline__ void gating_phase(const Ptrs& p, char* lds, int vcu, int G) {
    const int tid = threadIdx.x, wid = tid >> 6, lane = tid & 63, r32 = lane & 31, hi = lane >> 5;
    const bf16_t* zb = (const bf16_t*)(p.ws + WS_ZB); bf16_t* mix = (bf16_t*)(p.ws + WS_MIX); const bf16_t* Wsp = (const bf16_t*)(p.ws + WS_WSP);
    const int vb = (int)(uintptr_t)lds + t_rd_base(lane);
    for (int it2 = 0; it2 < 2; ++it2) {
        const int k = 2 * (vcu & 31) + it2, g = k & 3, blk = 16 * (vcu >> 5) + (k >> 2), row0 = blk * 128;
        {
            const int r = tid >> 2, qd = tid & 3; const bf16_t* vr = zb + (size_t)(row0 + r) * ZLD + ZO_V + g * 128 + qd * 32; const float* vn = p.in[IN_GM_V_NORM] + g * 128 + qd * 32;
            bf16x8 x[4]; float s = 0.f;
#pragma unroll
            for (int i = 0; i < 4; ++i) { x[i] = *reinterpret_cast<const bf16x8*>(vr + i * 8);
#pragma unroll
                for (int u = 0; u < 8; ++u) { const float f = bf2f((bf16_t)x[i][u]); s += f * f; } }
            s += __shfl_xor(s, 1); s += __shfl_xor(s, 2);
            const float rn = rsqrtf(s * (1.f / 128.f) + EPS);
#pragma unroll
            for (int i = 0; i < 4; ++i) { u32x4 w; const f32x4 g0 = *(const f32x4*)(vn + i * 8), g1 = *(const f32x4*)(vn + i * 8 + 4);
                w.x = pk2(bf2f((bf16_t)x[i][0]) * rn * g0[0], bf2f((bf16_t)x[i][1]) * rn * g0[1]); w.y = pk2(bf2f((bf16_t)x[i][2]) * rn * g0[2], bf2f((bf16_t)x[i][3]) * rn * g0[3]);
                w.z = pk2(bf2f((bf16_t)x[i][4]) * rn * g1[0], bf2f((bf16_t)x[i][5]) * rn * g1[1]); w.w = pk2(bf2f((bf16_t)x[i][6]) * rn * g1[2], bf2f((bf16_t)x[i][7]) * rn * g1[3]);
                *(u32x4*)(lds + t_st<4>(r, qd * 32 + i * 8)) = w; }
        }
        __syncthreads();
        const int mt = wid >> 1, cb0 = (wid & 1) * 2;
        f32x16 acc0 = {}, acc1 = {};
        const bf16_t* wrow = Wsp + (size_t)g * 16384 + (size_t)(mt * 32 + r32) * 128 + hi * 8;
        const int nks = (mt < 2) ? 4 : 8;
        bf16x8 afr[8];
#pragma unroll
        for (int ks = 0; ks < 8; ++ks) afr[ks] = *reinterpret_cast<const bf16x8*>(wrow + ks * 16);
        const float* bs = p.in[IN_GM_B_S] + g * 128 + mt * 32;
        bf16_t ur0[16], ur1[16]; float br[16];
#pragma unroll
        for (int r = 0; r < 16; ++r) { const int t = crow(r, hi); const size_t row = (size_t)(row0 + mt * 32 + t); const int c0 = g * 128 + cb0 * 32 + r32;
            ur0[r] = zb[row * ZLD + ZO_U + c0]; ur1[r] = zb[row * ZLD + ZO_U + c0 + 32]; br[r] = bs[t]; }
#pragma unroll
        for (int ks = 0; ks < 8; ++ks) { if (ks < nks) {
            const bf16x8 a = afr[ks];
            s16x4 l0, h0, l1, h1; const int off = vb + ks * 4096 + cb0 * 512;
            asm volatile("ds_read_b64_tr_b16 %0, %1" : "=&v"(l0) : "v"(off) : "memory"); asm volatile("ds_read_b64_tr_b16 %0, %1 offset:2048" : "=&v"(h0) : "v"(off) : "memory");
            asm volatile("ds_read_b64_tr_b16 %0, %1 offset:512" : "=&v"(l1) : "v"(off) : "memory"); asm volatile("ds_read_b64_tr_b16 %0, %1 offset:2560" : "=&v"(h1) : "v"(off) : "memory");
            asm volatile("s_waitcnt lgkmcnt(0)" ::: "memory"); SBAR();
            acc0 = __builtin_amdgcn_mfma_f32_32x32x16_bf16(a, TPK(l0, h0), acc0, 0, 0, 0);
            acc1 = __builtin_amdgcn_mfma_f32_32x32x16_bf16(a, TPK(l1, h1), acc1, 0, 0, 0); } }
#pragma unroll
        for (int r = 0; r < 16; ++r) { const int t = crow(r, hi); const float b = br[r]; const size_t row = (size_t)(row0 + mt * 32 + t);
            const int c0 = g * 128 + cb0 * 32 + r32;
            const float u0 = bf2f(ur0[r]), u1 = bf2f(ur1[r]);
            mix[row * 1024 + c0] = f2bf(u0 * (acc0[r] + b)); mix[row * 1024 + c0 + 32] = f2bf(u1 * (acc1[r] + b)); }
        __syncthreads();
    }
}

__device__ __forceinline__ void amat_phase(unsigned char* ws, int gw, int ngw, int lane) {
    const int r32 = lane & 31, hi = lane >> 5;
    {
        const int x = gw >> 8, wl = gw & 255, il = wl >> 1, mt = wl & 1, h = il & 3, chunk = 32 * (x & 1) + (il >> 2), b = x >> 1, bh = b * 4 + h, item = bh * 64 + chunk;
        const size_t row0 = (size_t)b * SEQ + chunk * 64;
        const bf16_t* qp = (const bf16_t*)(ws + WS_QP) + (row0 + mt * 32 + r32) * 1024 + h * 256 + hi * 8;
        const bf16_t* kp = (const bf16_t*)(ws + WS_KPP) + (row0 + r32) * 1024 + h * 256 + hi * 8;
        f32x16 a0 = {}, a1 = {};
#pragma unroll 4
        for (int ks = 0; ks < 16; ++ks) { const bf16x8 a = *reinterpret_cast<const bf16x8*>(qp + ks * 16);
            const u32x4 k0 = *reinterpret_cast<const u32x4*>(kp + ks * 16), k1 = *reinterpret_cast<const u32x4*>(kp + 32 * 1024 + ks * 16);
            auto s0 = __builtin_amdgcn_permlane32_swap(k0.x, k0.z, false, false); auto s1 = __builtin_amdgcn_permlane32_swap(k0.y, k0.w, false, false);
            auto s2 = __builtin_amdgcn_permlane32_swap(k1.x, k1.z, false, false); auto s3 = __builtin_amdgcn_permlane32_swap(k1.y, k1.w, false, false);
            u32x4 w0 = {s0[0], s1[0], s0[1], s1[1]}, w1 = {s2[0], s3[0], s2[1], s3[1]};
            a0 = __builtin_amdgcn_mfma_f32_32x32x16_bf16(a, *reinterpret_cast<bf16x8*>(&w0), a0, 0, 0, 0); a1 = __builtin_amdgcn_mfma_f32_32x32x16_bf16(a, *reinterpret_cast<bf16x8*>(&w1), a1, 0, 0, 0); }
        bf16_t* A = (bf16_t*)(ws + WS_AMAT) + (size_t)item * 4096;
#pragma unroll
        for (int r = 0; r < 16; ++r) { const int j = mt * 32 + crow(r, hi); const int m0 = r32, m1 = 32 + r32;
            A[j * 64 + m0] = (j >= m0) ? f2bf(a0[r]) : (bf16_t)0; A[j * 64 + m1] = (j >= m1) ? f2bf(a1[r]) : (bf16_t)0; }
    }
}
namespace scan {
constexpr int KSL = 4160;
constexpr int OFF_K = 0, OFF_V = 2 * 8 * KSL, OFF_RED = OFF_V + 2 * 4096, OFF_OT = OFF_RED + 2 * 32768, OFF_SS = OFF_OT + 2 * 4096, LDS_NEED = OFF_SS + 2 * 256;
template <int CTRL> __device__ __forceinline__ float dpp_f(float x) { return __builtin_bit_cast(float, __builtin_amdgcn_update_dpp(0, __builtin_bit_cast(int, x), CTRL, 0xF, 0xF, true)); }
__device__ __forceinline__ float sum32(float x) {
    x += dpp_f<0xB1>(x); x += dpp_f<0x4E>(x); x += dpp_f<0x141>(x); x += dpp_f<0x140>(x);
    auto rr = __builtin_amdgcn_permlane16_swap(__float_as_uint(x), __float_as_uint(x), false, false);
    return __uint_as_float(rr[0]) + __uint_as_float(rr[1]);
}
struct Stage { bf16x8 kq[4], vq, qf[2][2], af; };
__device__ __forceinline__ void scan_phase(unsigned char* ws, char* lds, int vcu, int G) {
    const int tid = threadIdx.x, wid = __builtin_amdgcn_readfirstlane(tid >> 6), lane = tid & 63, r32 = lane & 31, hi = lane >> 5;
    float* ssp = (float*)(ws + WS_SSP);
    const int lds0 = (int)(uintptr_t)lds, rdb = t_rd_base(lane);
    int kdst[4];
#pragma unroll
    for (int i2 = 0; i2 < 4; ++i2) { const int idx = tid + 512 * i2, m = idx >> 5, c = idx & 31; kdst[i2] = OFF_K + (c >> 2) * KSL + t_st<1>(m, 8 * (c & 3)); }
    const int vdst = OFF_V + t_st<1>(tid >> 2, 8 * (tid & 3));
    for (int item = vcu; item < 256; item += G) {
        const int bh = item >> 4, sl = item & 15, b = bh >> 2, h = bh & 3;
        const float g = __builtin_amdgcn_exp2f(64.f * __log2f(1.f - __builtin_amdgcn_exp2f(-5.f - (float)h)));
        const bf16_t* qbase = (const bf16_t*)(ws + WS_QP) + (size_t)b * SEQ * 1024 + h * 256 + 32 * wid + 8 * hi + (size_t)r32 * 1024;
        const bf16_t* kfull = (const bf16_t*)(ws + WS_KPP) + (size_t)b * SEQ * 1024 + h * 256 + (size_t)(tid >> 5) * 1024 + 8 * (tid & 31);
        bf16_t* vbase = (bf16_t*)(ws + WS_VO) + (size_t)b * SEQ * 2048 + h * 512 + 32 * sl;
        const bf16_t* vld = vbase + (size_t)(tid >> 2) * 2048 + 8 * (tid & 3);
        const bf16_t* abase = (const bf16_t*)(ws + WS_AMAT) + (size_t)bh * 64 * 4096 + (32 * (wid & 1) + r32) * 64 + 16 * (wid >> 1) + 8 * hi;
        float* sspb = ssp + (size_t)(sl * 4 + h) * M_ + (size_t)b * SEQ;
        f32x16 S = {};
        Stage st0, st1;
#define SC_LOADKV(ST, i) do { const size_t ro_ = (size_t)(i) * 64; \
        _Pragma("unroll") for (int i2 = 0; i2 < 4; ++i2) ST.kq[i2] = *reinterpret_cast<const bf16x8*>(kfull + (ro_ + 16 * i2) * 1024); \
        if (tid < 256) ST.vq = *reinterpret_cast<const bf16x8*>(vld + ro_ * 2048); } while (0)
#define SC_LOADQA(ST, i) do { const size_t ro_ = (size_t)(i) * 64; \
        _Pragma("unroll") for (int mt = 0; mt < 2; ++mt) _Pragma("unroll") for (int s2 = 0; s2 < 2; ++s2) ST.qf[mt][s2] = *reinterpret_cast<const bf16x8*>(qbase + (ro_ + 32 * mt) * 1024 + 16 * s2); \
        ST.af = *reinterpret_cast<const bf16x8*>(abase + (size_t)(i) * 4096); } while (0)
#define SC_WRITE(ST, bsel) do { _Pragma("unroll") for (int i2 = 0; i2 < 4; ++i2) *(bf16x8*)(lds + (bsel) * 8 * KSL + kdst[i2]) = ST.kq[i2]; if (tid < 256) *(bf16x8*)(lds + (bsel) * 4096 + vdst) = ST.vq; } while (0)
#define SC_FLUSH(i, BSEL) do { if (tid < 256) { const u32x4 w = *(const u32x4*)(lds + OFF_OT + (BSEL) * 4096 + tid * 16); *(u32x4*)(vbase + (size_t)((i) * 64 + (tid >> 2)) * 2048 + 8 * (tid & 3)) = w; } \
        else if (tid < 320) sspb[(i) * 64 + (tid - 256)] = ((const float*)(lds + OFF_SS + (BSEL) * 256))[tid - 256]; } while (0)
#define SC_STEP(i, CUR, OTH, BSEL) do { \
            const int row0 = (i) * 64; const int ld_ = ((i) + 2 < 64) ? (i) + 2 : 63; \
            SC_LOADKV(CUR, ld_); \
            bf16x8 sb[2]; \
            _Pragma("unroll") for (int s2 = 0; s2 < 2; ++s2) { u32x4 w = {cvtpk(S[8 * s2 + 0], S[8 * s2 + 1]), cvtpk(S[8 * s2 + 2], S[8 * s2 + 3]), cvtpk(S[8 * s2 + 4], S[8 * s2 + 5]), cvtpk(S[8 * s2 + 6], S[8 * s2 + 7])}; sb[s2] = *reinterpret_cast<bf16x8*>(&w); } \
            f32x16 op0 = {}, op1 = {}; \
            op0 = __builtin_amdgcn_mfma_f32_32x32x16_bf16(CUR.qf[0][0], sb[0], op0, 0, 0, 0); op1 = __builtin_amdgcn_mfma_f32_32x32x16_bf16(CUR.qf[1][0], sb[0], op1, 0, 0, 0); \
            op0 = __builtin_amdgcn_mfma_f32_32x32x16_bf16(CUR.qf[0][1], sb[1], op0, 0, 0, 0); op1 = __builtin_amdgcn_mfma_f32_32x32x16_bf16(CUR.qf[1][1], sb[1], op1, 0, 0, 0); \
            const int kvb = lds0 + OFF_K + (BSEL) * 8 * KSL + wid * KSL + rdb, vvb = lds0 + OFF_V + (BSEL) * 4096 + rdb; \
            s16x4 kl[4], kh[4], vl[4], vh[4], xl, xh; \
            kl[0] = tr_read<0>(kvb); kh[0] = tr_read<512>(kvb); kl[1] = tr_read<1024>(kvb); kh[1] = tr_read<1536>(kvb); kl[2] = tr_read<2048>(kvb); kh[2] = tr_read<2560>(kvb); kl[3] = tr_read<3072>(kvb); kh[3] = tr_read<3584>(kvb); \
            vl[0] = tr_read<0>(vvb); vh[0] = tr_read<512>(vvb); vl[1] = tr_read<1024>(vvb); vh[1] = tr_read<1536>(vvb); vl[2] = tr_read<2048>(vvb); vh[2] = tr_read<2560>(vvb); vl[3] = tr_read<3072>(vvb); vh[3] = tr_read<3584>(vvb); \
            { const int xo = vvb + (wid >> 1) * 1024; xl = tr_read<0>(xo); xh = tr_read<512>(xo); } \
            asm volatile("s_waitcnt lgkmcnt(0)" ::: "memory"); SBAR(); \
            if (wid & 1) op1 = __builtin_amdgcn_mfma_f32_32x32x16_bf16(CUR.af, TPK(xl, xh), op1, 0, 0, 0); \
            else         op0 = __builtin_amdgcn_mfma_f32_32x32x16_bf16(CUR.af, TPK(xl, xh), op0, 0, 0, 0); \
            _Pragma("unroll") for (int ks = 0; ks < 4; ++ks) S = __builtin_amdgcn_mfma_f32_32x32x16_bf16(TPK(kl[ks], kh[ks]), TPK(vl[ks], vh[ks]), S, 0, 0, 0); \
            SC_LOADQA(CUR, ld_); \
            _Pragma("unroll") for (int r = 0; r < 16; ++r) S[r] *= g; \
            unsigned* red = (unsigned*)(lds + OFF_RED + (BSEL) * 32768); \
            _Pragma("unroll") for (int p = 0; p < 8; ++p) { red[((wid * 2 + 0) * 8 + p) * 64 + lane] = cvtpk(op0[2 * p], op0[2 * p + 1]); red[((wid * 2 + 1) * 8 + p) * 64 + lane] = cvtpk(op1[2 * p], op1[2 * p + 1]); } \
            SC_WRITE(OTH, (BSEL) ^ 1); \
            __syncthreads(); \
            if ((i) > 0) SC_FLUSH((i) - 1, (BSEL) ^ 1); \
            _Pragma("unroll") for (int q = 0; q < 2; ++q) { const int idx = wid * 2 + q, mt = idx >> 3, p = idx & 7; float v0 = 0.f, v1 = 0.f; \
                _Pragma("unroll") for (int w2 = 0; w2 < 8; ++w2) { const unsigned u = red[((w2 * 2 + mt) * 8 + p) * 64 + lane]; v0 += __uint_as_float(u << 16); v1 += __uint_as_float(u & 0xffff0000u); } \
                const int j = 32 * mt + crow(2 * p, hi); \
                bf16_t* ot = (bf16_t*)(lds + OFF_OT + (BSEL) * 4096) + j * 32 + r32; \
                ot[0] = f2bf(v0); ot[32] = f2bf(v1); \
                const float s0 = sum32(v0 * v0), s1 = sum32(v1 * v1); \
                if (r32 == 0) { float* sp = (float*)(lds + OFF_SS + (BSEL) * 256) + j; sp[0] = s0; sp[1] = s1; } } \
        } while (0)
        SC_LOADKV(st0, 0); SC_LOADQA(st0, 0); SC_LOADKV(st1, 1); SC_LOADQA(st1, 1);
        SC_WRITE(st0, 0);
        __syncthreads();
#pragma unroll 1
        for (int i = 0; i < 64; i += 2) { SC_STEP(i, st0, st1, 0); SC_STEP(i + 1, st1, st0, 1); }
        __syncthreads();
        SC_FLUSH(63, 1);
        __syncthreads();
#undef SC_LOADKV
#undef SC_LOADQA
#undef SC_WRITE
#undef SC_STEP
#undef SC_FLUSH
    }
}
}
}

constexpr int NWAVES = 8;
constexpr int RING_OFF = 0, RING_BYTES = 131072;
constexpr int LDS_BYTES = 163840;
constexpr int LDSCTL_OFF = LDS_BYTES - 1024, MISC_OFF = LDSCTL_OFF + 320;
constexpr int LDS_BYTES_UNUSED_ = 0;
constexpr int CW_TMO = 0, CW_CODE = 1, CW_BAR = 4096;

constexpr size_t WO_IN0 = 0;
constexpr size_t WO_UQ = WO_IN0 + (size_t)1792 * 1024;
constexpr size_t WO_UKV = WO_UQ + (size_t)768 * 384;
constexpr size_t WO_OUT0 = WO_UKV + (size_t)1024 * 256;
constexpr size_t WO_GU0 = WO_OUT0 + (size_t)1024 * 1024;
constexpr size_t WO_DN0 = WO_GU0 + (size_t)5632 * 1024;
constexpr size_t WO_IN1 = WO_DN0 + (size_t)1024 * 2816;
constexpr size_t WO_OUT1 = WO_IN1 + (size_t)6144 * 1024;
constexpr size_t WO_GU1 = WO_OUT1 + (size_t)1024 * 2048;
constexpr size_t WO_DN1 = WO_GU1 + (size_t)5632 * 1024;
constexpr size_t WO_END = WO_DN1 + (size_t)1024 * 2816;
static_assert(WS_W + WO_END * 2 <= WS_XB, "bf16 weight copies fit [8,64) MiB");

#define GAS __attribute__((address_space(1)))
#define LAS __attribute__((address_space(3)))
typedef unsigned v4u __attribute__((ext_vector_type(4)));
typedef GAS unsigned gu32;
typedef GAS unsigned long long gu64;
#define RLX_AGENT __ATOMIC_RELAXED, __HIP_MEMORY_SCOPE_AGENT
#define LDS_WAIT() asm volatile("s_waitcnt lgkmcnt(0)" ::: "memory")
#define VM_WAIT() asm volatile("s_waitcnt vmcnt(0)" ::: "memory")
__device__ __forceinline__ unsigned long long rt() { return __builtin_amdgcn_s_memrealtime(); }

#define XB_TMO      128
#define XB_XCNT(j)  (256  + 64 * (j))
#define XB_XSUB(j)  (1280 + 64 * (j))
#define XB_XGEN(j)  (2304 + 64 * (j))
#define XB_TOP      3328
#define XB_TOPGEN   3392
#define XCD_BAR_WORDS 3456
#define XB_SPIN_CAP (1u << 18)

__device__ __forceinline__ unsigned xb_ld(unsigned* p)              { return __hip_atomic_load(p, __ATOMIC_RELAXED, __HIP_MEMORY_SCOPE_AGENT); }
__device__ __forceinline__ unsigned xb_add(unsigned* p, unsigned v) { return __hip_atomic_fetch_add(p, v, __ATOMIC_RELAXED, __HIP_MEMORY_SCOPE_AGENT); }
__device__ __forceinline__ unsigned xb_xcc_id() { return (unsigned)__builtin_amdgcn_s_getreg((3 << 11) | 20) & 0xFu; }
#define XB_SPIN(cond, bar) do { unsigned _sp = 0; while (cond) { __builtin_amdgcn_s_sleep(1); \
    if ((++_sp & 255u) == 0u) { if (xb_ld(&(bar)[XB_TMO])) break; if (_sp > XB_SPIN_CAP) { atomicAdd(&(bar)[XB_TMO], 1u); break; } } } } while (0)

struct XcdBarrier {
    unsigned* bar; unsigned x;
    volatile LAS unsigned* st;
};

__device__ __forceinline__ XcdBarrier xcd_barrier_post(unsigned* bar, volatile LAS unsigned* st) {
    XcdBarrier b; b.bar = bar; b.x = xb_xcc_id(); b.st = st;
    if (threadIdx.x == 0) st[2] = xb_add(&bar[XB_XCNT(b.x)], 1u);
    return b;
}
__device__ __forceinline__ void xcd_barrier_complete(unsigned* bar, unsigned x, unsigned& nloc, unsigned& nx) {
    const unsigned G = gridDim.x * gridDim.y * gridDim.z;
    unsigned sum, cnt, mine, sp = 0u;
    for (;;) {
        sum = 0u; cnt = 0u; mine = 0u;
#pragma unroll
        for (unsigned j = 0; j < 16; ++j) { const unsigned c = xb_ld(&bar[XB_XCNT(j)]); sum += c; cnt += (c > 0u) ? 1u : 0u; mine = (j == x) ? c : mine; }
        if (sum == G) break;
        __builtin_amdgcn_s_sleep(1);
        if ((++sp & 255u) == 0u) { if (xb_ld(&bar[XB_TMO])) break; if (sp > XB_SPIN_CAP) { atomicAdd(&bar[XB_TMO], 1u); break; } }
    }
    nloc = mine > 0u ? mine : 1u; nx = cnt > 0u ? cnt : 1u;
}

__device__ __forceinline__ void xcd_barrier(const XcdBarrier& b) {
    asm volatile("s_waitcnt vmcnt(0)" ::: "memory");
    __syncthreads();
    if (threadIdx.x == 0) {
        unsigned* bar = b.bar;
        __builtin_amdgcn_s_waitcnt(0);
        unsigned nloc = b.st[0], nx = b.st[1];
        if (nloc == 0u) { xcd_barrier_complete(bar, b.x, nloc, nx); b.st[0] = nloc; b.st[1] = nx; }
        const unsigned old = xb_add(&bar[XB_XSUB(b.x)], 1u);
        const unsigned gen = old / nloc;
        if (old + 1u == (gen + 1u) * nloc) {
            __builtin_amdgcn_fence(__ATOMIC_RELEASE, "agent");
            asm volatile("s_waitcnt vmcnt(0)" ::: "memory");
            const unsigned og = xb_add(&bar[XB_TOP], 1u);
            const unsigned tg = og / nx;
            if (og + 1u == (tg + 1u) * nx) xb_add(&bar[XB_TOPGEN], 1u);
            else XB_SPIN(xb_ld(&bar[XB_TOPGEN]) == tg, bar);
            __builtin_amdgcn_fence(__ATOMIC_ACQUIRE, "agent");
            xb_add(&bar[XB_XGEN(b.x)], 1u);
            asm volatile("s_waitcnt vmcnt(0)" ::: "memory");
        } else {
            XB_SPIN(xb_ld(&bar[XB_XGEN(b.x)]) == gen, bar);
            __builtin_amdgcn_fence(__ATOMIC_ACQUIRE, "agent");
            asm volatile("s_waitcnt vmcnt(0)" ::: "memory");
        }
    }
    __syncthreads();
}


#define XB_LSUB(j)  (3520 + 64 * (j))
#define XB_LGEN(j)  (4544 + 64 * (j))
__device__ __forceinline__ void xcd_barrier_local(const XcdBarrier& b) {
    asm volatile("s_waitcnt vmcnt(0)" ::: "memory");
    __syncthreads();
    if (threadIdx.x == 0) {
        unsigned* bar = b.bar;
        __builtin_amdgcn_s_waitcnt(0);
        const unsigned nloc = b.st[0];
        const unsigned old = xb_add(&bar[XB_LSUB(b.x)], 1u);
        const unsigned gen = old / nloc;
        if (old + 1u == (gen + 1u) * nloc) xb_add(&bar[XB_LGEN(b.x)], 1u);
        else XB_SPIN(xb_ld(&bar[XB_LGEN(b.x)]) == gen, bar);
        __builtin_amdgcn_fence(__ATOMIC_ACQUIRE, "agent");
        asm volatile("s_waitcnt vmcnt(0)" ::: "memory");
    }
    __syncthreads();
}
struct Args { Ptrs p; int ph_lo, ph_hi; };

struct WtItem { const float* W; bf16_t* WT; int k0; bool zero; };
typedef float wf4 __attribute__((ext_vector_type(4)));
__device__ __forceinline__ unsigned wt_cvtpk(float lo, float hi) { unsigned r; asm volatile("v_cvt_pk_bf16_f32 %0, %1, %2" : "=v"(r) : "v"(lo), "v"(hi)); return r; }
__device__ __forceinline__ void wt_load(const WtItem& it, int ldw, wf4 (&tv)[8], int lane) {
    if (it.zero) {
#pragma unroll
        for (int j = 0; j < 8; ++j) tv[j] = (wf4){0.f, 0.f, 0.f, 0.f};
    } else {
        const float* src = it.W + (size_t)(it.k0 + (lane >> 3)) * ldw + 4 * (lane & 7);
#pragma unroll
        for (int j = 0; j < 8; ++j) tv[j] = *(const wf4*)(src + (size_t)(8 * j) * ldw);
    }
}
template <bool GAIN> __device__ __forceinline__ void wt_store_t(const WtItem& it, const float* gain, int K, const wf4 (&tv)[8], LAS float* scr, int lane) {
    const int c = lane & 7;
    wf4 g0 = {1.f, 1.f, 1.f, 1.f}, g1 = {1.f, 1.f, 1.f, 1.f};
    if (GAIN) { g0 = *(const wf4*)(gain + it.k0 + 8 * c); g1 = *(const wf4*)(gain + it.k0 + 8 * c + 4); }
#pragma unroll
    for (int j = 0; j < 8; ++j) { LAS float* d = scr + ((lane >> 3) + 8 * j) * 33 + 4 * c; d[0] = tv[j].x; d[1] = tv[j].y; d[2] = tv[j].z; d[3] = tv[j].w; }
    LDS_WAIT(); asm volatile("" ::: "memory");
#pragma unroll
    for (int j = 0; j < 4; ++j) { const int n = (lane >> 3) + 8 * j; const LAS float* s = scr + (8 * c) * 33 + n;
        v4u o; o.x = wt_cvtpk(s[0 * 33] * g0.x, s[1 * 33] * g0.y); o.y = wt_cvtpk(s[2 * 33] * g0.z, s[3 * 33] * g0.w); o.z = wt_cvtpk(s[4 * 33] * g1.x, s[5 * 33] * g1.y); o.w = wt_cvtpk(s[6 * 33] * g1.z, s[7 * 33] * g1.w);
        *(GAS v4u*)(it.WT + (size_t)n * K + it.k0 + 8 * c) = o; }
    LDS_WAIT(); asm volatile("" ::: "memory");
}
__device__ __forceinline__ void wt_store(const WtItem& it, const float* gain, int K, const wf4 (&tv)[8], LAS float* scr, int lane) { if (gain) wt_store_t<true>(it, gain, K, tv, scr, lane); else wt_store_t<false>(it, gain, K, tv, scr, lane); }
__device__ __forceinline__ WtItem wt_make(const float* W, const float* W2, int ncols, int kind, int K, bf16_t* WT, int it, int nrow0, int nnb) {
    const int kb = it / nnb, nb = it % nnb, n0 = nrow0 + nb * 32; const float* src = W; int col = n0; bool zero = false;
    if (kind == 1) { src = ((n0 >> 7) & 1) ? W2 : W; col = 128 * (n0 >> 8) + (n0 & 127); } else zero = (n0 >= ncols);
    WtItem r; r.W = src + col; r.WT = WT + (size_t)n0 * K; r.k0 = kb * 64; r.zero = zero; return r;
}
__device__ __forceinline__ void wt_segment(const float* W, const float* W2, int ldw, int ncols, int kind, const float* gain, int K, int nrows, bf16_t* WT, LAS float* scr, int gw, int ngw, int lane, int nrow0 = 0) {
    const int nitems = (K / 64) * (nrows / 32);
    for (int it = gw; it < nitems; it += 2 * ngw) {
        const WtItem a = wt_make(W, W2, ncols, kind, K, WT, it, nrow0, nrows / 32); wf4 ta[8], tb[8]; wt_load(a, ldw, ta, lane);
        const bool two = (it + ngw) < nitems; WtItem b = a;
        if (two) { b = wt_make(W, W2, ncols, kind, K, WT, it + ngw, nrow0, nrows / 32); wt_load(b, ldw, tb, lane); }
        wt_store(a, gain, K, ta, scr, lane);
        if (two) wt_store(b, gain, K, tb, scr, lane);
    }
}

__global__ void __launch_bounds__(NWAVES * 64, 2) mk_fwd(Args args) {
    extern __shared__ __attribute__((aligned(16))) unsigned char lds[];
    LAS unsigned char* L = (LAS unsigned char*)lds;
    volatile LAS unsigned* MISC = (volatile LAS unsigned*)(L + MISC_OFF);
    const Ptrs& P = args.p;
    const int tid = threadIdx.x, lane = tid & 63, wave = __builtin_amdgcn_readfirstlane(tid >> 6);
    const int G = gridDim.x, bx = blockIdx.x;
    const int vcu = (G % 8 == 0) ? (bx % 8) * (G / 8) + bx / 8 : bx;
    unsigned char* ws = P.ws; gu32* ctl = (gu32*)(ws + WS_CTL);
    for (int u = tid; u < (LDS_BYTES - LDSCTL_OFF) / 4; u += NWAVES * 64) ((LAS unsigned*)(L + LDSCTL_OFF))[u] = 0u;
    __syncthreads();
    const int lo = args.ph_lo, hi = args.ph_hi;
    XcdBarrier bar; bar.bar = (unsigned*)(ctl + CW_BAR); bar.x = 0; bar.st = nullptr;
#if !USE_CG_SYNC
    if (hi - lo > 1) bar = xcd_barrier_post((unsigned*)(ctl + CW_BAR), MISC + 8);
#endif
    float* ssb = (float*)(ws + WS_SS); float* ss1 = ssb; float* ss2 = ssb + M_; float* ss3 = ssb + 2 * M_;
    bf16_t* Wb = (bf16_t*)(ws + WS_W); bf16_t* xb = (bf16_t*)(ws + WS_XB); bf16_t* zb = (bf16_t*)(ws + WS_ZB); bf16_t* mix = (bf16_t*)(ws + WS_MIX); bf16_t* act = (bf16_t*)(ws + WS_ACT);
    const int gw = vcu * NWAVES + wave, NGW = G * NWAVES;

#if USE_CG_SYNC
#define GRID_BAR() cg::this_grid().sync()
#else
#define GRID_BAR() xcd_barrier(bar)
#endif
#ifndef CG_FIRST
#define CG_FIRST 0
#endif
#ifdef TIMING
#define STAMP(k) do { if (bx == 0 && tid == 0) ((unsigned long long*)(ws + WS_CTL + 1024))[(k)] = __builtin_amdgcn_s_memrealtime(); } while (0)
#else
#define STAMP(k) do {} while (0)
#endif
#define IN(k) (lo <= (k) && (k) < hi)
#define SEAM(k) do { if (IN(k) && IN((k) + 1)) { GRID_BAR(); } STAMP((k) + 1); } while (0)
#ifndef LOCAL_SEAMS
#define LOCAL_SEAMS 1
#endif
#define LSEAM(k) do { if (IN(k) && IN((k) + 1)) { if (local_ok) xcd_barrier_local(bar); else GRID_BAR(); } STAMP((k) + 1); } while (0)
#ifndef PHASE_ON
#define PHASE_ON(k) 1
#endif
        STAMP(0);
        if (PHASE_ON(0) && IN(nv::PH_PREP)) {
            LAS float* scr = (LAS float*)(L + RING_OFF + wave * 16384);
            const float* nm = P.in[IN_NORM_MIX]; const float* nf = P.in[IN_NORM_FFN];
            wt_segment(P.in[IN_EVEN_W_IN], nullptr, EVEN_IN, EVEN_IN, 0, nm, 1024, 1792, Wb + WO_IN0, scr, gw, NGW, lane);
            wt_segment(P.in[IN_W_UQ], nullptr, 768, 768, 0, P.in[IN_Q_A_NORM], 384, 768, Wb + WO_UQ, scr, gw, NGW, lane);
            wt_segment(P.in[IN_W_UKV], nullptr, 1024, 1024, 0, P.in[IN_KV_A_NORM], 256, 1024, Wb + WO_UKV, scr, gw, NGW, lane);
            for (int row = gw; row < M_; row += 2 * NGW) {
                const int row2 = (row + NGW < M_) ? row + NGW : row;
                f32x4 va[4], vb[4];
#pragma unroll
                for (int j = 0; j < 4; ++j) { va[j] = *(const f32x4*)(P.in[IN_X] + (size_t)row * DM + j * 256 + lane * 4); vb[j] = *(const f32x4*)(P.in[IN_X] + (size_t)row2 * DM + j * 256 + lane * 4); }
                float s = 0.f, s2 = 0.f;
#pragma unroll
                for (int j = 0; j < 4; ++j) { s += va[j].x * va[j].x + va[j].y * va[j].y + va[j].z * va[j].z + va[j].w * va[j].w; s2 += vb[j].x * vb[j].x + vb[j].y * vb[j].y + vb[j].z * vb[j].z + vb[j].w * vb[j].w;
                    u32x2 o; o.x = pk2(va[j].x, va[j].y); o.y = pk2(va[j].z, va[j].w); *(u32x2*)(xb + (size_t)row * DM + j * 256 + lane * 4) = o;
                    o.x = pk2(vb[j].x, vb[j].y); o.y = pk2(vb[j].z, vb[j].w); *(u32x2*)(xb + (size_t)row2 * DM + j * 256 + lane * 4) = o; }
                s = wave_sum(s); s2 = wave_sum(s2);
                if (lane == 0) { ((float*)(ws + WS_RS0))[row] = rsqrtf(s * (1.f / DM) + EPS); ((float*)(ws + WS_RS0))[row2] = rsqrtf(s2 * (1.f / DM) + EPS); }
            }
            if (gw == 0) { for (int i = lane; i < 128; i += 64) ((float*)(ws + WS_INVR))[i] = (float)(exp(-(double)i / 128.0 * 9.210340371976184) * 0.15915494309189535);
                if (lane < 16) ((float*)(ws + WS_INVM))[lane] = (float)(exp(-(double)lane / 16.0 * 9.210340371976184) * 0.15915494309189535); }
            for (int idx = gw * 64 + lane; idx < 4 * 128 * 128; idx += NGW * 64) { const int t = (idx >> 7) & 127, s = idx & 127; ((bf16_t*)(ws + WS_WSP))[idx] = ((s >> 6) <= (t >> 6)) ? f2bf(P.in[IN_GM_W_S][idx]) : (bf16_t)0; }
        }
        if (IN(nv::PH_PREP) && IN(nv::PH_IN0)) { if (CG_FIRST || hi > 1000) cg::this_grid().sync(); else GRID_BAR(); }
        int cid = bx; bool local_ok = false;
#if !USE_CG_SYNC
        if (hi - lo > 1 && G == 256 && LOCAL_SEAMS) {
            if (tid == 0) { unsigned ok = 1u; for (unsigned j = 0; j < 16; ++j) { const unsigned c = xb_ld(&bar.bar[XB_XCNT(j)]); ok &= (j < 8) ? (c == (unsigned)G / 8u) : (c == 0u); } ok &= (bar.x < 8u) ? 1u : 0u; MISC[11] = ok; }
            __syncthreads();
            local_ok = MISC[11] != 0u;
            if (local_ok) { const int rank = (int)MISC[10]; cid = 8 * rank + (int)bar.x; }
        }
#endif
        const int vcu2 = local_ok ? ((cid & 7) * (G / 8) + (cid >> 3)) : vcu; const int gw2 = vcu2 * NWAVES + wave;
        STAMP(1);
        if (PHASE_ON(1) && IN(nv::PH_IN0)) {
            pg8::Gemm g{xb, Wb + WO_IN0, DM, 1024, 1024}; pg8::StaticOrder S; S.init(M_, ZLD, G, cid);
            pg8::EpiZ0 E{zb, (const float*)(ws + WS_RS0)};
            pg8::gemm_phase<pg8::EpiZ0, pg8::StaticOrder, true, true>(L + RING_OFF, g, S, E);
            if (cid >= 192) { LAS float* scr = (LAS float*)(L + RING_OFF + wave * 16384);
                wt_segment(P.in[IN_EVEN_W_OUT], nullptr, 1024, 1024, 0, nullptr, 1024, 1024, Wb + WO_OUT0, scr, (cid - 192) * NWAVES + wave, 64 * NWAVES, lane);
                wt_segment(P.in[IN_FFN_DOWN], nullptr, 1024, 1024, 0, nullptr, DFF, 1024, Wb + WO_DN0, scr, (cid - 192) * NWAVES + wave, 64 * NWAVES, lane); __syncthreads(); }
        }
        LSEAM(nv::PH_IN0);
        if (PHASE_ON(2) && IN(nv::PH_MLAUP)) { fp::mlaf::mla_fused_phase(P, Wb + WO_UQ, Wb + WO_UKV, (char*)lds + RING_OFF, vcu2); }
        STAMP(nv::PH_MLAUP + 1);
        if (PHASE_ON(3) && IN(nv::PH_GATING)) { fp::gating_phase(P, (char*)lds + RING_OFF, vcu2, G); }
        if (PHASE_ON(3) && IN(nv::PH_GATING)) { LAS float* scr = (LAS float*)(L + RING_OFF + wave * 16384);
            wt_segment(P.in[IN_FFN_GATE], P.in[IN_FFN_UP], DFF, DFF, 1, P.in[IN_NORM_FFN], 1024, 5632, Wb + WO_GU0, scr, gw, NGW, lane); __syncthreads(); }
        SEAM(nv::PH_GATING);
        if (PHASE_ON(5) && IN(nv::PH_ATTN)) { fp::att::attn_phase(ws, (char*)lds + RING_OFF, vcu2, G); }
        SEAM(nv::PH_ATTN);
        if (PHASE_ON(6) && IN(nv::PH_OUT0)) {
            pg8::Gemm g{mix, Wb + WO_OUT0, 1024, 1024, 1024}; pg8::StaticOrder S; S.init(M_, DM, G, cid);
            pg8::EpiResid<false, false> E{nullptr, P.out, xb, ss1};
            pg8::gemm_phase<pg8::EpiResid<false, false>, pg8::StaticOrder, true, true>(L + RING_OFF, g, S, E);
        }
        LSEAM(nv::PH_OUT0);

        if (PHASE_ON(7) && IN(nv::PH_FFN0A)) {
            const bool l1 = (nv::PH_FFN0A == nv::PH_FFN1A);
            pg8::Gemm g{xb, Wb + (l1 ? WO_GU1 : WO_GU0), DM, 1024, 1024}; pg8::StaticOrder S; S.init(M_, 2 * DFF, G, cid);
            pg8::EpiSwiglu E{act, l1 ? ss3 : ss1};
            pg8::gemm_phase<pg8::EpiSwiglu, pg8::StaticOrder, true, true>(L + RING_OFF, g, S, E);
            if (!l1 && cid >= 128) { LAS float* scr = (LAS float*)(L + RING_OFF + wave * 16384);
                wt_segment(P.in[IN_ODD_W_OUT], nullptr, 1024, 1024, 0, P.in[IN_RET_OUT_NORM], 2048, 1024, Wb + WO_OUT1, scr, (cid - 128) * NWAVES + wave, 128 * NWAVES, lane);
                wt_segment(P.in[IN_FFN_DOWN] + (size_t)DFF * DM, nullptr, 1024, 1024, 0, nullptr, DFF, 1024, Wb + WO_DN1, scr, (cid - 128) * NWAVES + wave, 128 * NWAVES, lane);
                wt_segment(P.in[IN_FFN_GATE] + (size_t)DM * DFF, P.in[IN_FFN_UP] + (size_t)DM * DFF, DFF, DFF, 1, P.in[IN_NORM_FFN] + DM, 1024, 5632, Wb + WO_GU1, scr, (cid - 128) * NWAVES + wave, 128 * NWAVES, lane);
                wt_segment(P.in[IN_ODD_W_IN], nullptr, ODD_IN, ODD_IN, 0, P.in[IN_NORM_MIX] + DM, 1024, 6144, Wb + WO_IN1, scr, (cid - 128) * NWAVES + wave, 128 * NWAVES, lane); __syncthreads(); }
        }
        LSEAM(nv::PH_FFN0A);
        if (PHASE_ON(8) && IN(nv::PH_FFN0B)) {
            const bool l1 = (nv::PH_FFN0B == nv::PH_FFN1B);
            pg8::Gemm g{act, Wb + (l1 ? WO_DN1 : WO_DN0), DFF, DFF, DFF}; pg8::StaticOrder S; S.init(M_, DM, G, cid);
            if (l1) { pg8::EpiResid<false, true> E{nullptr, P.out, xb, ss2}; pg8::gemm_phase<pg8::EpiResid<false, true>, pg8::StaticOrder, true, true>(L + RING_OFF, g, S, E); }
            else { pg8::EpiResid<false, false> E{nullptr, P.out, xb, ss2}; pg8::gemm_phase<pg8::EpiResid<false, false>, pg8::StaticOrder, true, true>(L + RING_OFF, g, S, E); }
        }

        SEAM(nv::PH_FFN0B);
        if (PHASE_ON(9) && IN(nv::PH_IN1)) {
            pg8::Gemm g{xb, Wb + WO_IN1, DM, 1024, 1024}; pg8::StaticOrder S; S.init(M_, 4096, G, cid);
            pg8::EpiIn1 E{(bf16_t*)(ws + WS_QP), (bf16_t*)(ws + WS_KPP), (bf16_t*)(ws + WS_VO), ss2, (const float*)(ws + WS_INVR), nullptr};
            pg8::gemm_phase<pg8::EpiIn1, pg8::StaticOrder, true, true>(L + RING_OFF, g, S, E);
        }
        LSEAM(nv::PH_IN1);
        if (PHASE_ON(10) && IN(nv::PH_AMAT)) { fp::amat_phase(ws, gw2, NGW, lane); }
        SEAM(nv::PH_AMAT);
        if (PHASE_ON(11) && IN(nv::PH_SCAN)) { fp::scan::scan_phase(ws, (char*)lds + RING_OFF, vcu2, G); }
        SEAM(nv::PH_SCAN);
        if (PHASE_ON(12) && IN(nv::PH_GATE)) {
            pg8::Gemm g{xb, Wb + WO_IN1 + (size_t)4096 * 1024, DM, 1024, 1024}; pg8::StaticOrder S; S.init(M_, 2048, G, cid);
            pg8::EpiGate E{(bf16_t*)(ws + WS_VO), ss2, (const float*)(ws + WS_SSP)};
            pg8::gemm_phase<pg8::EpiGate, pg8::StaticOrder, true, true>(L + RING_OFF, g, S, E);
        }
        LSEAM(nv::PH_GATE);
        if (PHASE_ON(13) && IN(nv::PH_OUT1)) {
            pg8::Gemm g{(const bf16_t*)(ws + WS_VO), Wb + WO_OUT1, 2048, 2048, 2048}; pg8::StaticOrder S; S.init(M_, DM, G, cid);
            pg8::EpiResid<false, false> E{nullptr, P.out, xb, ss3};
            pg8::gemm_phase<pg8::EpiResid<false, false>, pg8::StaticOrder, true, true>(L + RING_OFF, g, S, E);
        }
        LSEAM(nv::PH_OUT1);

        if (PHASE_ON(14) && IN(nv::PH_FFN1A)) {
            const bool l1 = (nv::PH_FFN1A == nv::PH_FFN1A);
            pg8::Gemm g{xb, Wb + (l1 ? WO_GU1 : WO_GU0), DM, 1024, 1024}; pg8::StaticOrder S; S.init(M_, 2 * DFF, G, cid);
            pg8::EpiSwiglu E{act, l1 ? ss3 : ss1};
            pg8::gemm_phase<pg8::EpiSwiglu, pg8::StaticOrder, true, true>(L + RING_OFF, g, S, E);
        }
        LSEAM(nv::PH_FFN1A);
        if (PHASE_ON(15) && IN(nv::PH_FFN1B)) {
            const bool l1 = (nv::PH_FFN1B == nv::PH_FFN1B);
            pg8::Gemm g{act, Wb + (l1 ? WO_DN1 : WO_DN0), DFF, DFF, DFF}; pg8::StaticOrder S; S.init(M_, DM, G, cid);
            if (l1) { pg8::EpiResid<false, true> E{nullptr, P.out, xb, ss2}; pg8::gemm_phase<pg8::EpiResid<false, true>, pg8::StaticOrder, true, true>(L + RING_OFF, g, S, E); }
            else { pg8::EpiResid<false, false> E{nullptr, P.out, xb, ss2}; pg8::gemm_phase<pg8::EpiResid<false, false>, pg8::StaticOrder, true, true>(L + RING_OFF, g, S, E); }
        }

    STAMP(16);
}
#ifdef TIMING
__global__ void k_poke_time(float* out, const unsigned char* ws) { const unsigned long long* ts = (const unsigned long long*)(ws + WS_CTL + 1024); out[0] += (float)(ts[T_B] - ts[T_A]) * (0.01f / T_DIV); }
#endif
extern "C" void kernel_launch(void* const* d_in, const int* in_sizes, int n_in, void* d_out, int out_size, void* d_ws, size_t ws_size, hipStream_t stream) {
    if (n_in != 20 || out_size != M_ * DM || ws_size < WS_END) { fprintf(stderr, "kernel_launch: unexpected shapes n_in %d out %d ws %zu\n", n_in, out_size, ws_size); return; }
    static int grid = 0;
    if (grid == 0) {
        int dev = 0, cus = 0, per_cu = 0;
        (void)hipGetDevice(&dev); (void)hipDeviceGetAttribute(&cus, hipDeviceAttributeMultiprocessorCount, dev);
        if (hipFuncSetAttribute((const void*)mk_fwd, hipFuncAttributeMaxDynamicSharedMemorySize, LDS_BYTES) != hipSuccess) fprintf(stderr, "kernel_launch: hipFuncSetAttribute failed\n");
        if (hipOccupancyMaxActiveBlocksPerMultiprocessor(&per_cu, (const void*)mk_fwd, NWAVES * 64, LDS_BYTES) != hipSuccess || per_cu < 1) { fprintf(stderr, "kernel_launch: occupancy query says %d\n", per_cu); per_cu = 1; }
        (void)hipGetLastError();
        grid = cus * per_cu;
        if (grid != 256) fprintf(stderr, "kernel_launch: grid %d (cus %d x %d)\n", grid, cus, per_cu);
    }
    (void)hipMemsetAsync(d_ws, 0, ZERO_BYTES, stream);
    Args a{};
    for (int i = 0; i < 20; ++i) a.p.in[i] = (const float*)d_in[i];
    a.p.out = (float*)d_out; a.p.ws = (unsigned char*)d_ws; a.ph_lo = 0; a.ph_hi = nv::PH_COUNT;
    void* kargs[] = {&a};
    const hipError_t e = hipLaunchCooperativeKernel((const void*)mk_fwd, dim3(grid), dim3(NWAVES * 64), kargs, LDS_BYTES, stream);
#ifdef TIMING
    hipLaunchKernelGGL(k_poke_time, dim3(1), dim3(1), 0, stream, (float*)d_out, (const unsigned char*)d_ws);
#endif
    if (e != hipSuccess) fprintf(stderr, "kernel_launch: cooperative launch failed: %s (grid %d)\n", hipGetErrorString(e), grid);
}
```

```cpp
#define USE_CG_SYNC 0
#include <hip/hip_runtime.h>
#include <hip/hip_cooperative_groups.h>
#include <cstdio>
#include <cstdint>
namespace cg = cooperative_groups;

constexpr int BATCH = 4, SEQ = 4096, DM = 1024, M_ = BATCH * SEQ;
constexpr int CHUNK = 64;
constexpr float EPS = 1e-6f;
constexpr int GM_G = 4, GM_D = 128, GM_W = 512, GM_BLK = 128;
constexpr int MH = 8, MQR = 384, MKVR = 256, MNOPE = 64, MROPE = 32, MV = 64, MQK = 96;
constexpr int EVEN_IN = 1696, ZLD = 1792;
constexpr int RH = 4, RQK = 256, RV = 512, ODD_IN = 6144;
constexpr int DFF = 2816;
constexpr int ZO_U = 0, ZO_V = 512, ZO_CQ = 1024, ZO_CKV = 1408, ZO_KPE = 1664;

typedef unsigned short bf16_t;
typedef short bf16x8 __attribute__((ext_vector_type(8)));
typedef float f32x4 __attribute__((ext_vector_type(4)));
typedef float f32x16 __attribute__((ext_vector_type(16)));
typedef unsigned u32x4 __attribute__((ext_vector_type(4)));
typedef unsigned u32x2 __attribute__((ext_vector_type(2)));

__device__ __forceinline__ float bf2f(bf16_t v) { return __uint_as_float(((unsigned)v) << 16); }
__device__ __forceinline__ bf16_t f2bf(float f) { unsigned u = __float_as_uint(f); return (bf16_t)((u + 0x7fffu + ((u >> 16) & 1u)) >> 16); }
__device__ __forceinline__ unsigned pk2(float lo, float hi) { return (unsigned)f2bf(lo) | ((unsigned)f2bf(hi) << 16); }
__device__ __forceinline__ float gelu_tanh(float x) {
    const float u = 0.7978845608028654f * (x + 0.044715f * x * x * x);
    return x / (1.f + __expf(-2.f * u));
}
__device__ __forceinline__ float silu_f(float x) { return x / (1.f + __expf(-x)); }
__device__ __forceinline__ float wave_sum(float v) {
#pragma unroll
    for (int o = 1; o < 64; o <<= 1) v += __shfl_xor(v, o);
    return v;
}

constexpr size_t MiB = 1u << 20;
constexpr size_t WS_CTL = 0;
constexpr size_t WS_SS = 1 * MiB;
constexpr size_t ZERO_BYTES = 2 * MiB;
constexpr size_t WS_RS0 = 2 * MiB;
constexpr size_t WS_INVR = 2 * MiB + 128 * 1024;
constexpr size_t WS_INVM = 2 * MiB + 128 * 1024 + 1024;
constexpr size_t WS_COSR = 3 * MiB;
constexpr size_t WS_SINR = 5 * MiB;
constexpr size_t WS_WSP = 7 * MiB;
constexpr size_t WS_W = 8 * MiB;
constexpr size_t WS_XB = 64 * MiB;
constexpr size_t WS_ARENA = 96 * MiB;
constexpr size_t WS_ZB = 96 * MiB;
constexpr size_t WS_QRAW = 152 * MiB;
constexpr size_t WS_KVRAW = 176 * MiB;
constexpr size_t WS_MIX = 208 * MiB;
constexpr size_t WS_VB = 240 * MiB;
constexpr size_t WS_ACT = 96 * MiB;
constexpr size_t WS_QP = 96 * MiB;
constexpr size_t WS_KPP = 128 * MiB;
constexpr size_t WS_VO = 160 * MiB;
constexpr size_t WS_AMAT = 224 * MiB;
constexpr size_t WS_SSP = 232 * MiB;
constexpr size_t WS_SSQ = 3 * MiB;
constexpr size_t WS_END = 256 * MiB;

struct Ptrs {
    const float* in[20];
    float* out;
    unsigned char* ws;
};
#define IN_X 0
#define IN_NORM_MIX 1
#define IN_NORM_FFN 2
#define IN_EVEN_W_IN 3
#define IN_GM_V_NORM 4
#define IN_GM_W_S 5
#define IN_GM_B_S 6
#define IN_Q_A_NORM 7
#define IN_W_UQ 8
#define IN_KV_A_NORM 9
#define IN_W_UKV 10
#define IN_Q_NORM 11
#define IN_K_NORM 12
#define IN_EVEN_W_OUT 13
#define IN_ODD_W_IN 14
#define IN_RET_OUT_NORM 15
#define IN_ODD_W_OUT 16
#define IN_FFN_GATE 17
#define IN_FFN_UP 18
#define IN_FFN_DOWN 19

__device__ __forceinline__ float* ws_f32(const Ptrs& p, size_t off) { return (float*)(p.ws + off); }
__device__ __forceinline__ bf16_t* ws_bf(const Ptrs& p, size_t off) { return (bf16_t*)(p.ws + off); }
namespace nv {
enum Phase { PH_PREP = 0, PH_IN0, PH_MLAUP, PH_GATING, PH_MLANORM, PH_ATTN, PH_OUT0, PH_FFN0A, PH_FFN0B, PH_IN1, PH_AMAT, PH_SCAN, PH_GATE, PH_OUT1, PH_FFN1A, PH_FFN1B, PH_COUNT };
}

namespace pg8 {
#define PG8_LAS __attribute__((address_space(3)))
constexpr int BM = 256, BK = 64, HALF = 128, HTB = HALF * BK * 2  , STAGE_BYTES = 8 * HTB, NXCD = 8, WGM = 8;

__host__ __device__ __forceinline__ int lds_byte(int r, int c) { const int st = (r >> 4) * 2 + (c >> 5), rr = r & 15, cc = c & 31, ob = rr * 64 + cc * 2; return st * 1024 + (ob ^ (((ob >> 9) & 1) << 5)); }
__host__ __device__ __forceinline__ void stage_rc(int b, int& R, int& C) { const int st = b / 1024, sb = b % 1024, swz = sb ^ (((sb >> 9) & 1) << 5); R = (st >> 1) * 16 + swz / 64; C = (st & 1) * 32 + (swz % 64) / 2; }
__host__ __device__ __forceinline__ int perm32(int rho) { const int n = rho >> 4, i = rho & 15; return 8 * (i >> 2) + 4 * n + (i & 3); }

struct Unit { int pm, pn; };
struct Gemm { const bf16_t* A; const bf16_t* Bt; int lda, ldb, K; };

struct StaticOrder {
    int nM, nN, nwg, G, c;
    __host__ __device__ void init(int M, int N, int G_, int c_) { nM = M / BM; nN = N / BM; nwg = nM * nN; G = G_; c = c_; }
    __host__ __device__ bool next(int i, Unit& u) const {
        const long L = (long)i * G + c; if (L >= nwg) return false;
        int wgid = (int)L; { const int q = nwg / NXCD, r = nwg % NXCD, xcd = wgid % NXCD, off = wgid / NXCD; wgid = (xcd < r ? xcd * (q + 1) : r * (q + 1) + (xcd - r) * q) + off; }
        const int nig = WGM * nN, gid = wgid / nig, fm = gid * WGM, gsz = (nM - fm) < WGM ? (nM - fm) : WGM;
        u.pm = fm + ((wgid % nig) % gsz); u.pn = (wgid % nig) / gsz; return true;
    }
    __device__ __forceinline__ void a_ready(const Unit&) const {}
    __device__ __forceinline__ void done(const Unit&) const {}
};

__device__ __forceinline__ unsigned cvt_pk_bf16(float lo, float hi) { unsigned r; asm volatile("v_cvt_pk_bf16_f32 %0, %1, %2" : "=v"(r) : "v"(lo), "v"(hi)); return r; }
__device__ __forceinline__ u32x4 pack8(const f32x4 v0, const f32x4 v1) { u32x4 w; w.x = cvt_pk_bf16(v0[0], v0[1]); w.y = cvt_pk_bf16(v0[2], v0[3]); w.z = cvt_pk_bf16(v1[0], v1[1]); w.w = cvt_pk_bf16(v1[2], v1[3]); return w; }
__device__ __forceinline__ float gelu_fast(float x) {
    const float u2 = x * (1.5957691216057308f + 0.07135481627260025f * x * x);
    return x * __builtin_amdgcn_rcpf(1.f + __builtin_amdgcn_exp2f(-1.4426950408889634f * u2)); }
__device__ __forceinline__ float sigmoid_fast(float x) { return __builtin_amdgcn_rcpf(1.f + __builtin_amdgcn_exp2f(-1.4426950408889634f * x)); }
__device__ __forceinline__ f32x4 gelu4(f32x4 v) { return (f32x4){gelu_fast(v[0]), gelu_fast(v[1]), gelu_fast(v[2]), gelu_fast(v[3])}; }


struct EpiZ0 { static constexpr bool PERM = true, AFTER_DRAIN = false; bf16_t* zb; const float* rs0;
    __device__ __forceinline__ void operator()(const f32x4 (&acc)[2][2][4][2], const Unit& u, int wr, int wc, int fr, int fq) const {
        const int row0 = u.pm * BM + wr * 64 + fr, col0 = u.pn * BM + wc * 32 + 8 * fq; const bool act = u.pn < 4;
#pragma unroll
        for (int ai = 0; ai < 2; ++ai)
#pragma unroll
            for (int m = 0; m < 4; ++m) { const int row = row0 + ai * HALF + m * 16; const float rs = rs0[row]; bf16_t* rowp = zb + (size_t)row * ZLD + col0;
#pragma unroll
                for (int bj = 0; bj < 2; ++bj) { f32x4 v0 = acc[ai][bj][m][0] * rs, v1 = acc[ai][bj][m][1] * rs; if (act) { v0 = gelu4(v0); v1 = gelu4(v1); }
                    *(u32x4*)(rowp + bj * HALF) = pack8(v0, v1); } }
    } };
struct EpiStore { static constexpr bool PERM = true, AFTER_DRAIN = false; bf16_t* O; int ldo; int pad;
    __device__ __forceinline__ void operator()(const f32x4 (&acc)[2][2][4][2], const Unit& u, int wr, int wc, int fr, int fq) const {
        const int row0 = u.pm * BM + wr * 64 + fr, col0 = u.pn * BM + wc * 32 + 8 * fq;
#pragma unroll
        for (int ai = 0; ai < 2; ++ai)
#pragma unroll
            for (int m = 0; m < 4; ++m) { bf16_t* rowp = O + (size_t)(row0 + ai * HALF + m * 16) * ldo + col0;
#pragma unroll
                for (int bj = 0; bj < 2; ++bj) *(u32x4*)(rowp + bj * HALF) = pack8(acc[ai][bj][m][0], acc[ai][bj][m][1]); }
    } };
template <bool FIRST, bool LAST> struct EpiResid { static constexpr bool PERM = !LAST, AFTER_DRAIN = false; const float* basef; float* out; bf16_t* xb; float* ss;
    __device__ __forceinline__ void operator()(const f32x4 (&acc)[2][2][4][2], const Unit& u, int wr, int wc, int fr, int fq) const {
        const int row0 = u.pm * BM + wr * 64 + fr;
        if constexpr (!LAST) {
            const int col0 = u.pn * BM + wc * 32 + 8 * fq;
            u32x4 rb[2][4][2];
#pragma unroll
            for (int ai = 0; ai < 2; ++ai)
#pragma unroll
                for (int m = 0; m < 4; ++m)
#pragma unroll
                    for (int bj = 0; bj < 2; ++bj) rb[ai][m][bj] = *(const u32x4*)(xb + (size_t)(row0 + ai * HALF + m * 16) * DM + col0 + bj * HALF);
#pragma unroll
            for (int ai = 0; ai < 2; ++ai)
#pragma unroll
                for (int m = 0; m < 4; ++m) { const int row = row0 + ai * HALF + m * 16; bf16_t* rowp = xb + (size_t)row * DM + col0; float sq = 0.f;
#pragma unroll
                    for (int bj = 0; bj < 2; ++bj) { const u32x4 b = rb[ai][m][bj];
                        f32x4 v0 = (f32x4){__uint_as_float(b.x << 16), __uint_as_float(b.x & 0xffff0000u), __uint_as_float(b.y << 16), __uint_as_float(b.y & 0xffff0000u)} + acc[ai][bj][m][0];
                        f32x4 v1 = (f32x4){__uint_as_float(b.z << 16), __uint_as_float(b.z & 0xffff0000u), __uint_as_float(b.w << 16), __uint_as_float(b.w & 0xffff0000u)} + acc[ai][bj][m][1];
                        *(u32x4*)(rowp + bj * HALF) = pack8(v0, v1);
                        sq += (v0[0] * v0[0] + v0[1] * v0[1]) + (v0[2] * v0[2] + v0[3] * v0[3]) + (v1[0] * v1[0] + v1[1] * v1[1]) + (v1[2] * v1[2] + v1[3] * v1[3]); }
                    sq += __shfl_xor(sq, 16); sq += __shfl_xor(sq, 32); if (fq == 0) atomicAdd(ss + row, sq);
                    if (m & 1) asm volatile("" ::: "memory"); }
        } else {
            const int col0 = u.pn * BM + wc * 32 + 4 * fq;
            u32x2 rb[2][4][2][2];
#pragma unroll
            for (int ai = 0; ai < 2; ++ai)
#pragma unroll
                for (int m = 0; m < 4; ++m)
#pragma unroll
                    for (int bj = 0; bj < 2; ++bj)
#pragma unroll
                        for (int n = 0; n < 2; ++n) rb[ai][m][bj][n] = *(const u32x2*)(xb + (size_t)(row0 + ai * HALF + m * 16) * DM + col0 + bj * HALF + n * 16);
#pragma unroll
            for (int ai = 0; ai < 2; ++ai)
#pragma unroll
                for (int m = 0; m < 4; ++m) { const int row = row0 + ai * HALF + m * 16; const size_t off = (size_t)row * DM + col0;
#pragma unroll
                    for (int bj = 0; bj < 2; ++bj)
#pragma unroll
                        for (int n = 0; n < 2; ++n) { const size_t o2 = off + bj * HALF + n * 16; const u32x2 b = rb[ai][m][bj][n];
                            const f32x4 v = (f32x4){__uint_as_float(b.x << 16), __uint_as_float(b.x & 0xffff0000u), __uint_as_float(b.y << 16), __uint_as_float(b.y & 0xffff0000u)} + acc[ai][bj][m][n];
                            *(f32x4*)(out + o2) = v; }
                    if (m & 1) asm volatile("" ::: "memory"); }
        }
    } };
struct EpiSwiglu { static constexpr bool PERM = true, AFTER_DRAIN = false; bf16_t* act; const float* ss;
    __device__ __forceinline__ void operator()(const f32x4 (&acc)[2][2][4][2], const Unit& u, int wr, int wc, int fr, int fq) const {
        const int row0 = u.pm * BM + wr * 64 + fr, col0 = u.pn * HALF + wc * 32 + 8 * fq;
#pragma unroll
        for (int ai = 0; ai < 2; ++ai)
#pragma unroll
            for (int m = 0; m < 4; ++m) { const int row = row0 + ai * HALF + m * 16; const float rs = __builtin_amdgcn_rsqf(ss[row] * (1.f / DM) + EPS);
                f32x4 o[2];
#pragma unroll
                for (int n = 0; n < 2; ++n) { const f32x4 g = acc[ai][0][m][n] * rs, up = acc[ai][1][m][n] * rs;
#pragma unroll
                    for (int j = 0; j < 4; ++j) o[n][j] = g[j] * sigmoid_fast(g[j]) * up[j]; }
                *(u32x4*)(act + (size_t)row * DFF + col0) = pack8(o[0], o[1]); }
    } };
struct EpiIn1 { static constexpr bool PERM = true, AFTER_DRAIN = false; bf16_t* qp; bf16_t* kpp; bf16_t* v; const float* ss; const float* inv2pi; const float* unused_;
    __device__ __forceinline__ void operator()(const f32x4 (&acc)[2][2][4][2], const Unit& u, int wr, int wc, int fr, int fq) const {
        const int row0 = u.pm * BM + wr * 64 + fr;
        if (u.pn < 8) {
            const int h = u.pn & 3, d0 = wc * 32 + 8 * fq; const bool isq = u.pn < 4; bf16_t* dst = isq ? qp : kpp;
            const float lg2 = __log2f(1.f - __builtin_amdgcn_exp2f(-5.f - (float)h)) * (isq ? 1.f : -1.f), mul = isq ? 1.f : 0.0625f;
            f32x4 iv[2]; iv[0] = *(const f32x4*)(inv2pi + d0); iv[1] = *(const f32x4*)(inv2pi + d0 + 4);
#pragma unroll
            for (int ai = 0; ai < 2; ++ai)
#pragma unroll
                for (int m = 0; m < 4; ++m) { const int row = row0 + ai * HALF + m * 16, pos = row & (SEQ - 1), jj = row & 63;
                    const float rs = __builtin_amdgcn_rsqf(ss[row] * (1.f / DM) + EPS), sc = __builtin_amdgcn_exp2f(lg2 * (float)(jj + 1)) * mul;
                    f32x4 y1[2], y2[2];
#pragma unroll
                    for (int n = 0; n < 2; ++n) { f32x4 c, s;
#pragma unroll
                        for (int j = 0; j < 4; ++j) { const float rev = __builtin_amdgcn_fractf((float)pos * iv[n][j]); c[j] = __builtin_amdgcn_cosf(rev); s[j] = __builtin_amdgcn_sinf(rev); }
                        const f32x4 x1 = acc[ai][0][m][n] * rs, x2 = acc[ai][1][m][n] * rs;
                        y1[n] = (x1 * c - x2 * s) * sc; y2[n] = (x2 * c + x1 * s) * sc; }
                    bf16_t* rowp = dst + (size_t)row * 1024 + h * 256;
                    if (isq) { const int p0 = (d0 & ~15) + 4 * ((d0 >> 3) & 1);
                        u32x2 w; w.x = cvt_pk_bf16(y1[0][0], y1[0][1]); w.y = cvt_pk_bf16(y1[0][2], y1[0][3]); *(u32x2*)(rowp + p0) = w;
                        w.x = cvt_pk_bf16(y1[1][0], y1[1][1]); w.y = cvt_pk_bf16(y1[1][2], y1[1][3]); *(u32x2*)(rowp + p0 + 8) = w;
                        w.x = cvt_pk_bf16(y2[0][0], y2[0][1]); w.y = cvt_pk_bf16(y2[0][2], y2[0][3]); *(u32x2*)(rowp + 128 + p0) = w;
                        w.x = cvt_pk_bf16(y2[1][0], y2[1][1]); w.y = cvt_pk_bf16(y2[1][2], y2[1][3]); *(u32x2*)(rowp + 128 + p0 + 8) = w; }
                    else { *(u32x4*)(rowp + d0) = pack8(y1[0], y1[1]); *(u32x4*)(rowp + d0 + 128) = pack8(y2[0], y2[1]); } }
        } else {
            const int col0 = (u.pn - 8) * BM + wc * 32 + 8 * fq;
#pragma unroll
            for (int ai = 0; ai < 2; ++ai)
#pragma unroll
                for (int m = 0; m < 4; ++m) { const int row = row0 + ai * HALF + m * 16; const float rs = __builtin_amdgcn_rsqf(ss[row] * (1.f / DM) + EPS); bf16_t* rowp = v + (size_t)row * 2048 + col0;
#pragma unroll
                    for (int bj = 0; bj < 2; ++bj) *(u32x4*)(rowp + bj * HALF) = pack8(acc[ai][bj][m][0] * rs, acc[ai][bj][m][1] * rs); }
        }
    } };
struct EpiGate { static constexpr bool PERM = true, AFTER_DRAIN = false; bf16_t* o; const float* ss; const float* ssp;
    __device__ __forceinline__ void operator()(const f32x4 (&acc)[2][2][4][2], const Unit& u, int wr, int wc, int fr, int fq) const {
        const int row0 = u.pm * BM + wr * 64 + fr, col0 = u.pn * BM + wc * 32 + 8 * fq, h = u.pn >> 1;
#pragma unroll
        for (int ai = 0; ai < 2; ++ai)
#pragma unroll
            for (int m = 0; m < 4; ++m) { const int row = row0 + ai * HALF + m * 16; const float rs = __builtin_amdgcn_rsqf(ss[row] * (1.f / DM) + EPS);
                float sq = 0.f;
#pragma unroll
                for (int s4 = 0; s4 < 4; ++s4) sq += ssp[(size_t)((4 * fq + s4) * 4 + h) * M_ + row];
                sq += __shfl_xor(sq, 16); sq += __shfl_xor(sq, 32);
                const float rinv = __builtin_amdgcn_rsqf(sq * (1.f / RV) + EPS); bf16_t* rowp = o + (size_t)row * 2048 + col0;
#pragma unroll
                for (int bj = 0; bj < 2; ++bj) { const u32x4 ow = *(const u32x4*)(rowp + bj * HALF); f32x4 r[2];
#pragma unroll
                    for (int n = 0; n < 2; ++n) { const f32x4 g = acc[ai][bj][m][n] * rs; const unsigned w0 = n ? ow.z : ow.x, w1 = n ? ow.w : ow.y;
                        const float o0 = __uint_as_float(w0 << 16), o1 = __uint_as_float(w0 & 0xffff0000u), o2 = __uint_as_float(w1 << 16), o3 = __uint_as_float(w1 & 0xffff0000u);
                        r[n][0] = o0 * rinv * g[0] * sigmoid_fast(g[0]); r[n][1] = o1 * rinv * g[1] * sigmoid_fast(g[1]); r[n][2] = o2 * rinv * g[2] * sigmoid_fast(g[2]); r[n][3] = o3 * rinv * g[3] * sigmoid_fast(g[3]); }
                    *(u32x4*)(rowp + bj * HALF) = pack8(r[0], r[1]); } }
    } };

template <class Epi, class Sched, bool ALIGN_EPI = false, bool SP2 = false>
__device__ __forceinline__ void gemm_phase(PG8_LAS unsigned char* lds, const Gemm g, const Sched& S, const Epi& E) {
    const int tid = threadIdx.x, wid = __builtin_amdgcn_readfirstlane(tid >> 6), lane = tid & 63, wr = wid >> 2, wc = wid & 3, fr = lane & 15, fq = lane >> 4;
    const int K = g.K, nt = K / BK;
    unsigned voffA[2], voffB[2];
#pragma unroll
    for (int i = 0; i < 2; ++i) { int R, C; stage_rc(tid * 16 + i * 8192, R, C); const int Rb = Epi::PERM ? ((R & ~31) + perm32(R & 31)) : R;
        voffA[i] = (unsigned)(R * g.lda + C) * 2u; voffB[i] = (unsigned)(Rb * g.ldb + C) * 2u; }
    const size_t kstep = (size_t)(BK * 2);
    const size_t hstepA = (size_t)HALF * g.lda * 2, hstepB = (size_t)HALF * g.ldb * 2;
    const size_t tstepA = 2 * hstepA, tstepB = 2 * hstepB;
    const unsigned ldsw = (unsigned)wid * 1024u;
    const int aoff = lds_byte(wr * 64 + fr, fq * 8), boff = lds_byte(wc * 32 + fr, fq * 8);
#define PG8_SA(b, h) (((b) * 2 + (h)) * HTB)
#define PG8_SB(b, h) ((4 + (b) * 2 + (h)) * HTB)
#define PG8_STAGE(bufoff, gbase, voff) do { _Pragma("unroll") for (int _i = 0; _i < 2; ++_i) \
        __builtin_amdgcn_global_load_lds((const unsigned*)((const char*)(gbase) + (voff)[_i]), (PG8_LAS unsigned*)(lds + (bufoff) + ldsw + _i * 8192), 16, 0, 0); } while (0)
#define PG8_LDA(dst, b, h) do { _Pragma("unroll") for (int m = 0; m < 4; ++m) _Pragma("unroll") for (int k = 0; k < 2; ++k) dst[m][k] = *(const PG8_LAS bf16x8*)(lds + PG8_SA(b, h) + aoff + m * 2048 + k * 1024); } while (0)
#define PG8_LDB(dst, b, h) do { _Pragma("unroll") for (int n = 0; n < 2; ++n) _Pragma("unroll") for (int k = 0; k < 2; ++k) dst[n][k] = *(const PG8_LAS bf16x8*)(lds + PG8_SB(b, h) + boff + n * 2048 + k * 1024); } while (0)
#define PG8_MMA(ai, bj, At, Bt) do { __builtin_amdgcn_s_setprio(1); _Pragma("unroll") for (int m = 0; m < 4; ++m) _Pragma("unroll") for (int n = 0; n < 2; ++n) _Pragma("unroll") for (int k = 0; k < 2; ++k) \
        acc[ai][bj][m][n] = __builtin_amdgcn_mfma_f32_16x16x32_bf16(Bt[n][k], At[m][k], acc[ai][bj][m][n], 0, 0, 0); __builtin_amdgcn_s_setprio(0); } while (0)
#define PG8_WAIT_V(n) asm volatile("s_waitcnt vmcnt(" #n ")" ::: "memory")
#define PG8_WAIT_L(n) asm volatile("s_waitcnt lgkmcnt(" #n ")" ::: "memory")
#define PG8_BAR __builtin_amdgcn_s_barrier()
#define PG8_SCHED __builtin_amdgcn_sched_barrier(0)
    Unit cur, nxt; int ui = 0;
    if (!S.next(0, cur)) return;
    f32x4 acc[2][2][4][2];
#pragma unroll
    for (int a = 0; a < 2; ++a)
#pragma unroll
        for (int b = 0; b < 2; ++b)
#pragma unroll
            for (int m = 0; m < 4; ++m)
#pragma unroll
                for (int n = 0; n < 2; ++n) acc[a][b][m][n] = (f32x4){0.f, 0.f, 0.f, 0.f};
    bf16x8 At[4][2], B0[2][2], B1[2][2];
    const char* cA = (const char*)g.A + (size_t)cur.pm * tstepA; const char* cB = (const char*)g.Bt + (size_t)cur.pn * tstepB;
    S.a_ready(cur);
    if constexpr (SP2) {
        PG8_STAGE(PG8_SB(0, 0), cB, voffB); PG8_STAGE(PG8_SB(0, 1), cB + hstepB, voffB); PG8_STAGE(PG8_SA(0, 0), cA, voffA); PG8_STAGE(PG8_SA(0, 1), cA + hstepA, voffA);
        if (wr == 1) PG8_BAR;
        PG8_WAIT_V(2); PG8_BAR;
        PG8_STAGE(PG8_SB(1, 0), cB + kstep, voffB); PG8_STAGE(PG8_SA(1, 0), cA + kstep, voffA); PG8_STAGE(PG8_SB(1, 1), cB + hstepB + kstep, voffB);
        PG8_WAIT_V(6); PG8_BAR;
    } else {
        PG8_STAGE(PG8_SB(0, 0), cB, voffB); PG8_STAGE(PG8_SA(0, 0), cA, voffA); PG8_STAGE(PG8_SB(0, 1), cB + hstepB, voffB); PG8_STAGE(PG8_SA(0, 1), cA + hstepA, voffA);
        if (wr == 1) PG8_BAR;
        PG8_WAIT_V(4); PG8_BAR;
        PG8_STAGE(PG8_SB(1, 0), cB + kstep, voffB); PG8_STAGE(PG8_SA(1, 0), cA + kstep, voffA); PG8_STAGE(PG8_SB(1, 1), cB + hstepB + kstep, voffB);
        PG8_WAIT_V(6); PG8_BAR;
    }
    for (;;) {
        const bool has_next = S.next(ui + 1, nxt);
        const char* nA = has_next ? (const char*)g.A + (size_t)nxt.pm * tstepA : cA; const char* nB = has_next ? (const char*)g.Bt + (size_t)nxt.pn * tstepB : cB;
        for (int t = 0; t < nt; t += 2) {
            const bool last = (t == nt - 2);
            const char* a1 = cA + (size_t)(t + 1) * kstep;
            const char* a2 = last ? nA : cA + (size_t)(t + 2) * kstep; const char* b2 = last ? nB : cB + (size_t)(t + 2) * kstep;
            const char* a3 = a2 + kstep; const char* b3 = b2 + kstep;
            if (last && has_next) S.a_ready(nxt);
            if constexpr (SP2) {
            PG8_LDB(B0, 0, 0); PG8_LDB(B1, 0, 1); PG8_SCHED; PG8_LDA(At, 0, 0); PG8_STAGE(PG8_SA(1, 1), a1 + hstepA, voffA);
            PG8_WAIT_V(8); PG8_WAIT_L(0); PG8_BAR; PG8_MMA(0, 0, At, B0); PG8_MMA(0, 1, At, B1); PG8_BAR; PG8_SCHED;
            PG8_LDA(At, 0, 1); PG8_STAGE(PG8_SB(0, 0), b2, voffB); PG8_STAGE(PG8_SB(0, 1), b2 + hstepB, voffB); PG8_STAGE(PG8_SA(0, 0), a2, voffA);
            PG8_WAIT_V(8); PG8_WAIT_L(0); PG8_BAR; PG8_MMA(1, 0, At, B0); PG8_MMA(1, 1, At, B1); PG8_BAR; PG8_SCHED;
            PG8_LDB(B0, 1, 0); PG8_LDB(B1, 1, 1); PG8_SCHED; PG8_LDA(At, 1, 0); PG8_STAGE(PG8_SA(0, 1), a2 + hstepA, voffA);
            PG8_WAIT_V(8); PG8_WAIT_L(0); PG8_BAR; PG8_MMA(0, 0, At, B0); PG8_MMA(0, 1, At, B1); PG8_BAR; PG8_SCHED;
            PG8_LDA(At, 1, 1); PG8_STAGE(PG8_SB(1, 0), b3, voffB); PG8_STAGE(PG8_SB(1, 1), b3 + hstepB, voffB); PG8_STAGE(PG8_SA(1, 0), a3, voffA);
            PG8_WAIT_V(8); PG8_WAIT_L(0); PG8_BAR; PG8_MMA(1, 0, At, B0); PG8_MMA(1, 1, At, B1); PG8_BAR; PG8_SCHED;
            } else {
            PG8_LDB(B0, 0, 0); PG8_SCHED; PG8_LDA(At, 0, 0); PG8_STAGE(PG8_SA(1, 1), a1 + hstepA, voffA);
            PG8_WAIT_L(8); PG8_BAR; PG8_WAIT_L(0); PG8_MMA(0, 0, At, B0); PG8_BAR; PG8_SCHED;
            PG8_LDB(B1, 0, 1); PG8_STAGE(PG8_SB(0, 0), b2, voffB);
            PG8_BAR; PG8_WAIT_L(0); PG8_MMA(0, 1, At, B1); PG8_BAR;
            PG8_LDA(At, 0, 1); PG8_STAGE(PG8_SA(0, 0), a2, voffA);
            PG8_BAR; PG8_WAIT_L(0); PG8_MMA(1, 0, At, B0); PG8_BAR; PG8_SCHED;
            PG8_STAGE(PG8_SB(0, 1), b2 + hstepB, voffB);
            PG8_WAIT_V(6); PG8_BAR; PG8_MMA(1, 1, At, B1); PG8_BAR;
            PG8_LDB(B0, 1, 0); PG8_SCHED; PG8_LDA(At, 1, 0); PG8_STAGE(PG8_SA(0, 1), a2 + hstepA, voffA);
            PG8_WAIT_L(8); PG8_BAR; PG8_WAIT_L(0); PG8_MMA(0, 0, At, B0); PG8_BAR; PG8_SCHED;
            PG8_LDB(B1, 1, 1); PG8_STAGE(PG8_SB(1, 0), b3, voffB);
            PG8_BAR; PG8_WAIT_L(0); PG8_MMA(0, 1, At, B1); PG8_BAR;
            PG8_LDA(At, 1, 1); PG8_STAGE(PG8_SA(1, 0), a3, voffA);
            PG8_BAR; PG8_WAIT_L(0); PG8_MMA(1, 0, At, B0); PG8_BAR; PG8_SCHED;
            PG8_STAGE(PG8_SB(1, 1), b3 + hstepB, voffB);
            PG8_WAIT_V(6); PG8_BAR; PG8_MMA(1, 1, At, B1); PG8_BAR;
            }
        }
        if constexpr (ALIGN_EPI) { if (wr == 0) PG8_BAR; }
        if constexpr (!Epi::AFTER_DRAIN) { E(acc, cur, wr, wc, fr, fq); S.done(cur); }
        if (!has_next) break;
#pragma unroll
        for (int a = 0; a < 2; ++a)
#pragma unroll
            for (int b = 0; b < 2; ++b)
#pragma unroll
                for (int m = 0; m < 4; ++m)
#pragma unroll
                    for (int n = 0; n < 2; ++n) acc[a][b][m][n] = (f32x4){0.f, 0.f, 0.f, 0.f};
        cur = nxt; cA = nA; cB = nB; ++ui;
        if constexpr (ALIGN_EPI) { if (wr == 1) PG8_BAR; }
    }
    PG8_WAIT_V(0);
    if constexpr (!ALIGN_EPI) { if (wr == 0) PG8_BAR; }
    PG8_BAR;
    if constexpr (Epi::AFTER_DRAIN) { E.fused(acc, cur, wr, wc, fr, fq, lds, wid, lane); S.done(cur); }
#undef PG8_SA
#undef PG8_SB
#undef PG8_STAGE
#undef PG8_LDA
#undef PG8_LDB
#undef PG8_MMA
#undef PG8_WAIT_V
#undef PG8_WAIT_L
#undef PG8_BAR
#undef PG8_SCHED
}
}


namespace fp {
using s16x4 = __attribute__((ext_vector_type(4))) short;
#define SBAR() __builtin_amdgcn_sched_barrier(0)
__device__ __forceinline__ int crow(int r, int hi) { return (r & 3) + 8 * (r >> 2) + 4 * hi; }
__device__ __forceinline__ unsigned cvtpk(float lo, float hi) { unsigned r; asm volatile("v_cvt_pk_bf16_f32 %0, %1, %2" : "=v"(r) : "v"(lo), "v"(hi)); return r; }
template <int NCB> __device__ __forceinline__ int t_st(int k, int c) { const int kk = (k & ~0xC) | ((k & 4) << 1) | ((k & 8) >> 1); return ((kk >> 3) * NCB + (c >> 5)) * 512 + ((kk & 7) * 32 + (c & 31)) * 2; }
__device__ __forceinline__ int t_rd_base(int lane) { return ((lane & 3) << 3) | (((lane >> 2) & 3) << 6) | (((lane >> 4) & 1) << 5) | (((lane >> 5) & 1) << 8); }
template <int OFF> __device__ __forceinline__ s16x4 tr_read(int vb) { s16x4 r; asm volatile("ds_read_b64_tr_b16 %0, %1 offset:%2" : "=&v"(r) : "v"(vb), "i"(OFF) : "memory"); return r; }
#define TPK(L, H) (bf16x8){L[0], L[1], L[2], L[3], H[0], H[1], H[2], H[3]}

namespace att {
#ifndef ATT_K_AT
#define ATT_K_AT WS_KVRAW
#define ATT_LDK 1024
#define ATT_V_AT WS_VB
#define ATT_LDV 512
#define ATT_VOFF(h) ((h) * 64)
#endif
constexpr int NW = 8, QBLK = 32, KVBLK = 64, LDQ = 768, LDK = ATT_LDK, LDV = ATT_LDV, LDO = 1024;
#ifndef ATT_THR
#define ATT_THR 8.f
#endif
constexpr float QSCALE = 0.10206207261596575f * 1.4426950408889634f, THRL = ATT_THR * 1.4426950408889634f;
constexpr int SHM_V = 8192, SHM_K = 16384, OFF_V = 0, OFF_K = 2 * SHM_V, OFF_WS = OFF_K + 2 * SHM_K, LDS_NEED = OFF_WS + NW * 64 * 4;
#define KSWZ(row, colB) ((row) * 256 + ((colB) ^ (((row) & 7) << 4)))
__device__ __forceinline__ float max3f(float a, float b, float c) { return __builtin_fmaxf(__builtin_fmaxf(a, b), c); }
__device__ __forceinline__ void partialSM(f32x16& p0, f32x16& p1, float& mhat, f32x16& negm, float& alpha) {
    float a = max3f(p0[0], p0[1], p1[0]), b = max3f(p0[2], p0[3], p1[1]); a = max3f(a, p1[2], p1[3]);
#pragma unroll
    for (int r = 4; r < 16; r += 4) { a = max3f(a, p0[r], p0[r + 1]); b = max3f(b, p0[r + 2], p0[r + 3]); a = max3f(a, p1[r], p1[r + 1]); b = max3f(b, p1[r + 2], p1[r + 3]); }
    float rm = fmaxf(a, b);
    { auto rr = __builtin_amdgcn_permlane32_swap(__float_as_uint(rm), __float_as_uint(rm), false, false); rm = fmaxf(__uint_as_float(rr[0]), __uint_as_float(rr[1])); }
    if (__builtin_expect(__all(rm <= THRL), 1)) { alpha = 1.f; }
    else { const float dl = fmaxf(rm, 0.f); mhat += dl; alpha = __builtin_amdgcn_exp2f(-dl);
#pragma unroll
        for (int r = 0; r < 16; ++r) { p0[r] -= dl; p1[r] -= dl; }
#pragma unroll
        for (int r = 0; r < 16; ++r) negm[r] = -mhat; }
#pragma unroll
    for (int r = 0; r < 16; ++r) p0[r] = __builtin_amdgcn_exp2f(p0[r]);
}
__device__ __forceinline__ void finishSM(f32x16& p0, f32x16& p1, float alpha, float& l_reg, bf16x8& pa0, bf16x8& pa1, bf16x8& pa2, bf16x8& pa3) {
#pragma unroll
    for (int r = 0; r < 16; ++r) p1[r] = __builtin_amdgcn_exp2f(p1[r]);
    float ps = 0;
#pragma unroll
    for (int r = 0; r < 16; ++r) ps += p0[r];
#pragma unroll
    for (int r = 0; r < 16; ++r) ps += p1[r];
    { auto rr = __builtin_amdgcn_permlane32_swap(__float_as_uint(ps), __float_as_uint(ps), false, false); ps = __uint_as_float(rr[0]) + __uint_as_float(rr[1]); }
    l_reg = l_reg * alpha + ps;
#define PK4(P, BASE, OUT) do { unsigned a0 = cvtpk(P[BASE + 0], P[BASE + 1]), a1 = cvtpk(P[BASE + 2], P[BASE + 3]);   \
    unsigned b0 = cvtpk(P[BASE + 4], P[BASE + 5]), b1 = cvtpk(P[BASE + 6], P[BASE + 7]);                              \
    auto r0 = __builtin_amdgcn_permlane32_swap(a0, b0, false, false); auto r1 = __builtin_amdgcn_permlane32_swap(a1, b1, false, false); \
    u32x4 w = {r0[0], r1[0], r0[1], r1[1]}; OUT = *reinterpret_cast<bf16x8*>(&w); } while (0)
    PK4(p0, 0, pa0); PK4(p0, 8, pa1); PK4(p1, 0, pa2); PK4(p1, 8, pa3);
#undef PK4
}
__device__ __forceinline__ void qkt(f32x16& p0, f32x16& p1, const char* Ks, const bf16x8* qr, const f32x16& negm, int r32, int hi) {
#pragma unroll
    for (int d0 = 0; d0 < 6; ++d0) { const int cb = (d0 * 16 + hi * 8) * 2;
        const bf16x8 b0 = *reinterpret_cast<const bf16x8*>(Ks + KSWZ(r32, cb));
        const bf16x8 b1 = *reinterpret_cast<const bf16x8*>(Ks + KSWZ(32 + r32, cb));
        if (d0 == 0) { p0 = __builtin_amdgcn_mfma_f32_32x32x16_bf16(b0, qr[0], negm, 0, 0, 0); p1 = __builtin_amdgcn_mfma_f32_32x32x16_bf16(b1, qr[0], negm, 0, 0, 0); }
        else { p0 = __builtin_amdgcn_mfma_f32_32x32x16_bf16(b0, qr[d0], p0, 0, 0, 0); p1 = __builtin_amdgcn_mfma_f32_32x32x16_bf16(b1, qr[d0], p1, 0, 0, 0); } }
}
constexpr int v_rd_off(int d0, int ks, int half) { return d0 * 512 + ks * 2048 + half * 1024; }
template <int D0> __device__ __forceinline__ void pv_one(f32x16& od, int vb, bf16x8 pa0, bf16x8 pa1, bf16x8 pa2, bf16x8 pa3) {
    const s16x4 l0 = tr_read<v_rd_off(D0, 0, 0)>(vb), h0 = tr_read<v_rd_off(D0, 0, 1)>(vb), l1 = tr_read<v_rd_off(D0, 1, 0)>(vb), h1 = tr_read<v_rd_off(D0, 1, 1)>(vb);
    const s16x4 l2 = tr_read<v_rd_off(D0, 2, 0)>(vb), h2 = tr_read<v_rd_off(D0, 2, 1)>(vb), l3 = tr_read<v_rd_off(D0, 3, 0)>(vb), h3 = tr_read<v_rd_off(D0, 3, 1)>(vb);
    asm volatile("s_waitcnt lgkmcnt(0)" ::: "memory"); SBAR();
    od = __builtin_amdgcn_mfma_f32_32x32x16_bf16(pa0, TPK(l0, h0), od, 0, 0, 0);
    od = __builtin_amdgcn_mfma_f32_32x32x16_bf16(pa1, TPK(l1, h1), od, 0, 0, 0);
    od = __builtin_amdgcn_mfma_f32_32x32x16_bf16(pa2, TPK(l2, h2), od, 0, 0, 0);
    od = __builtin_amdgcn_mfma_f32_32x32x16_bf16(pa3, TPK(l3, h3), od, 0, 0, 0);
}
__device__ __forceinline__ void pv_d0(f32x16* o, int vb, bf16x8 pa0, bf16x8 pa1, bf16x8 pa2, bf16x8 pa3) { pv_one<0>(o[0], vb, pa0, pa1, pa2, pa3); pv_one<1>(o[1], vb, pa0, pa1, pa2, pa3); }

__device__ __forceinline__ void attn_unit(const bf16_t* __restrict__ Qb, const bf16_t* __restrict__ Kh, const bf16_t* __restrict__ Vh, bf16_t* __restrict__ Ob, int q0, char* lds) {
    const int tid = threadIdx.x, wid = tid >> 6, lane = tid & 63, r32 = lane & 31, hi = lane >> 5;
    char* V_lds = lds + OFF_V; char* K_lds = lds + OFF_K;
    float* wsf = (float*)(lds + OFF_WS) + wid * 64; float* li_l = wsf; float* al_l = wsf + 32;
    float mhat = 0.f, l_reg = 0; f32x16 o[2] = {}; bf16x8 qr[6]; f32x16 negm = {};
    const bf16_t* Qw = Qb + (long)(wid * QBLK + r32) * LDQ + hi * 8;
#pragma unroll
    for (int d0 = 0; d0 < 6; ++d0) qr[d0] = *reinterpret_cast<const bf16x8*>(Qw + d0 * 16);
    const int srow = tid >> 3, sch = tid & 7;
    const int vst = t_st<2>(srow, sch * 8), kst0 = KSWZ(srow, sch * 16), kst1 = KSWZ(srow, (sch + 8) * 16);
    const int vb0 = (int)(uintptr_t)V_lds + t_rd_base(lane);
    const int koff1 = (sch & 4) ? 32 : 64;
    struct { bf16x8 k0, k1, v0; } sr_[1];
#define SLOAD(i, key0) do { const bf16_t* kp_ = Kh + (long)((key0) + srow) * LDK + sch * 8; sr_[i].k0 = *reinterpret_cast<const bf16x8*>(kp_); sr_[i].k1 = *reinterpret_cast<const bf16x8*>(kp_ + koff1); \
    sr_[i].v0 = *reinterpret_cast<const bf16x8*>(Vh + (long)((key0) + srow) * LDV + sch * 8); } while (0)
#define SWRITE(b, i) do { *(bf16x8*)(K_lds + (b) * SHM_K + kst0) = sr_[i].k0; *(bf16x8*)(K_lds + (b) * SHM_K + kst1) = sr_[i].k1; *(bf16x8*)(V_lds + (b) * SHM_V + vst) = sr_[i].v0; } while (0)
#define SWAIT() asm volatile("s_waitcnt vmcnt(0)" ::: "memory")
#define RESC(a) do { if (__any((a) < 1.f)) { if (hi == 0) al_l[r32] = (a); asm volatile("s_waitcnt lgkmcnt(0)" ::: "memory"); \
    _Pragma("unroll") for (int d = 0; d < 2; ++d) _Pragma("unroll") for (int r = 0; r < 16; ++r) o[d][r] *= al_l[crow(r, hi)]; } } while (0)
#define MASKT(P0, P1, t) do { if ((t) > tmaxw) { _Pragma("unroll") for (int r = 0; r < 16; ++r) { P0[r] = -1e30f; P1[r] = -1e30f; } } } while (0)
    f32x16 pA0, pA1, pB0, pB1; float alA, alB; bf16x8 pa0, pa1, pa2, pa3;
    const int NT = q0 / KVBLK + 4; const int tmaxw = (q0 + wid * QBLK) / KVBLK;
    constexpr int SE = 0, SO = 0;
    SLOAD(SE, 0); asm volatile("s_waitcnt vmcnt(0)" ::: "memory"); SWRITE(0, SE); __syncthreads();
    qkt(pA0, pA1, K_lds, qr, negm, r32, hi); partialSM(pA0, pA1, mhat, negm, alA);
    SLOAD(SO, KVBLK);
    SWAIT(); SWRITE(1, SO); __syncthreads();
    for (int j = 1; j + 1 < NT; j += 2) {
        SBAR(); qkt(pB0, pB1, K_lds + SHM_K, qr, negm, r32, hi); MASKT(pB0, pB1, j);
        finishSM(pA0, pA1, alA, l_reg, pa0, pa1, pa2, pa3); SBAR();
        SLOAD(SO, (j + 1) * KVBLK); SBAR();
        pv_d0(o, vb0, pa0, pa1, pa2, pa3); partialSM(pB0, pB1, mhat, negm, alB);
        __syncthreads(); SWAIT(); SWRITE(0, SE);
        RESC(alB); __syncthreads();
        SBAR(); qkt(pA0, pA1, K_lds, qr, negm, r32, hi); MASKT(pA0, pA1, j + 1);
        finishSM(pB0, pB1, alB, l_reg, pa0, pa1, pa2, pa3); SBAR();
        SLOAD(SE, (j + 2) * KVBLK); SBAR();
        pv_d0(o, vb0 + SHM_V, pa0, pa1, pa2, pa3); partialSM(pA0, pA1, mhat, negm, alA);
        __syncthreads(); SWAIT(); SWRITE(1, SO);
        RESC(alA); __syncthreads();
    }
    SBAR(); qkt(pB0, pB1, K_lds + SHM_K, qr, negm, r32, hi); MASKT(pB0, pB1, NT - 1);
    finishSM(pA0, pA1, alA, l_reg, pa0, pa1, pa2, pa3); SBAR();
    pv_d0(o, vb0, pa0, pa1, pa2, pa3); partialSM(pB0, pB1, mhat, negm, alB);
    __syncthreads(); RESC(alB);
    finishSM(pB0, pB1, alB, l_reg, pa0, pa1, pa2, pa3); SBAR();
    pv_d0(o, vb0 + SHM_V, pa0, pa1, pa2, pa3);
    if (hi == 0) li_l[r32] = l_reg; asm volatile("s_waitcnt lgkmcnt(0)" ::: "memory");
    float rli[16];
#pragma unroll
    for (int r = 0; r < 16; ++r) rli[r] = __builtin_amdgcn_rcpf(li_l[crow(r, hi)]);
    bf16_t* Ow = Ob + (long)(wid * QBLK) * LDO;
#pragma unroll
    for (int r = 0; r < 16; ++r) { const int orow = crow(r, hi);
#pragma unroll
        for (int d0 = 0; d0 < 2; ++d0) Ow[(long)orow * LDO + d0 * 32 + r32] = f2bf(o[d0][r] * rli[r]); }
    __syncthreads();
#undef SLOAD
#undef SWRITE
#undef SWAIT
#undef RESC
#undef MASKT
}
__device__ __forceinline__ void attn_phase(unsigned char* ws, char* lds, int vcu, int G) {
    const bf16_t* q = (const bf16_t*)(ws + WS_QRAW); const bf16_t* k = (const bf16_t*)(ws + ATT_K_AT); const bf16_t* v = (const bf16_t*)(ws + ATT_V_AT);
#ifdef ATT_DEBUG_ALT
    bf16_t* mix = (bf16_t*)(ws + WS_XB);
#else
    bf16_t* mix = (bf16_t*)(ws + WS_MIX);
#endif
    for (int pi = vcu; pi < 256; pi += G) {
        const int bh = pi >> 3, s = pi & 7, b = bh >> 3, h = bh & 7;
        const size_t rb = (size_t)b * SEQ;
#pragma unroll 1
        for (int u = 0; u < 2; ++u) { const int qb = u ? 15 - s : s, q0 = qb * 256;
#ifdef ATT_QBMASK
            if (!((ATT_QBMASK >> qb) & 1)) continue;
#endif
            attn_unit(q + (rb + q0) * LDQ + h * 96, k + rb * LDK + h * 96, v + rb * LDV + ATT_VOFF(h), mix + (rb + q0) * LDO + 512 + h * 64, q0, lds); }
    }
}
#undef KSWZ
}

template <int CTRL> __device__ __forceinline__ float dppf(float x) { return __builtin_bit_cast(float, __builtin_amdgcn_update_dpp(0, __builtin_bit_cast(int, x), CTRL, 0xF, 0xF, true)); }
__device__ __forceinline__ float sum8(float x) { x += dppf<0xB1>(x); x += dppf<0x4E>(x); x += dppf<0x141>(x); return x; }
__device__ __forceinline__ float sum64(float x) { x = sum8(x); x += dppf<0x140>(x);
    { auto rr = __builtin_amdgcn_permlane16_swap(__float_as_uint(x), __float_as_uint(x), false, false); x = __uint_as_float(rr[0]) + __uint_as_float(rr[1]); }
    { auto rr = __builtin_amdgcn_permlane32_swap(__float_as_uint(x), __float_as_uint(x), false, false); x = __uint_as_float(rr[0]) + __uint_as_float(rr[1]); } return x; }
__device__ __forceinline__ float lo16(unsigned u) { return __uint_as_float(u << 16); }
__device__ __forceinline__ float hi16(unsigned u) { return __uint_as_float(u & 0xffff0000u); }
__device__ __forceinline__ float sq8(u32x4 w) { float s = 0.f; s += lo16(w.x) * lo16(w.x) + hi16(w.x) * hi16(w.x); s += lo16(w.y) * lo16(w.y) + hi16(w.y) * hi16(w.y); s += lo16(w.z) * lo16(w.z) + hi16(w.z) * hi16(w.z); s += lo16(w.w) * lo16(w.w) + hi16(w.w) * hi16(w.w); return s; }


namespace mlaf {
constexpr int PQ = 784, PKV = 528;
__device__ __forceinline__ float sq8b(bf16x8 v) { const u32x4 w = *reinterpret_cast<const u32x4*>(&v); return sq8(w); }
#define TRIG(cs_, sn_, rev_) asm volatile("v_cos_f32 %0, %2\n\tv_sin_f32 %1, %2\n\ts_nop 7\n\ts_nop 7\n\ts_nop 7" : "=&v"(cs_), "=&v"(sn_) : "v"(rev_))
__device__ __forceinline__ float rsq_guarded(float x) { float r; asm volatile("v_rsq_f32 %0, %1\n\ts_nop 7\n\ts_nop 7" : "=&v"(r) : "v"(x)); return r; }
__device__ __forceinline__ float swap32_sum(float x) { auto rr = __builtin_amdgcn_permlane32_swap(__float_as_uint(x), __float_as_uint(x), false, false); return __uint_as_float(rr[0]) + __uint_as_float(rr[1]); }
struct Ctx { const bf16_t* zb; bf16_t* qo; bf16_t* ko; bf16_t* vo; char* lds; const float* qn; const float* kn; const float* invm; int h, r32, hi; };
constexpr int WBUF = 96 * PQ;
static_assert(128 * PKV <= WBUF && 2 * WBUF + 832 <= 160 * 1024 - 1024, "two weight buffers + the gains fit the LDS");
__device__ __forceinline__ void ld_wq(const bf16_t* Wq, int h, int tid, bf16x8 (&w)[9]) {
#pragma unroll
    for (int i = 0; i < 9; ++i) { const int cc = tid + 512 * i, n = cc / 48, kc = cc % 48; w[i] = *reinterpret_cast<const bf16x8*>(Wq + (size_t)(96 * h + n) * 384 + 8 * kc); } }
__device__ __forceinline__ void st_wq(char* buf, int tid, const bf16x8 (&w)[9]) {
#pragma unroll
    for (int i = 0; i < 9; ++i) { const int cc = tid + 512 * i, n = cc / 48, kc = cc % 48; *(bf16x8*)(buf + n * PQ + 16 * kc) = w[i]; } }
__device__ __forceinline__ void ld_wkv(const bf16_t* Wkv, int h, int tid, bf16x8 (&w)[8]) {
#pragma unroll
    for (int i = 0; i < 8; ++i) { const int cc = tid + 512 * i, n = cc >> 5, kc = cc & 31; w[i] = *reinterpret_cast<const bf16x8*>(Wkv + (size_t)(128 * h + n) * 256 + 8 * kc); } }
__device__ __forceinline__ void st_wkv(char* buf, int tid, const bf16x8 (&w)[8]) {
#pragma unroll
    for (int i = 0; i < 8; ++i) { const int cc = tid + 512 * i, n = cc >> 5, kc = cc & 31; *(bf16x8*)(buf + n * PKV + 16 * kc) = w[i]; } }
__device__ __forceinline__ void q_epi(const Ctx& c, int h, int tok, float pos, float rq, const f32x16& a0, const f32x16& a1, const f32x16& a2) {
    const int hi = c.hi;
    float s = 0.f;
#pragma unroll
    for (int r = 0; r < 16; ++r) s += a0[r] * a0[r] + a1[r] * a1[r] + a2[r] * a2[r];
    const float rn = rsq_guarded(swap32_sum(s) * (rq * rq) * (1.f / MQK) + EPS) * (att::QSCALE * rq);
    bf16_t* qrow = c.qo + (size_t)tok * 768 + h * 96 + 4 * hi; const float* gq = (const float*)(c.lds + 2 * WBUF) + 4 * hi;
#pragma unroll
    for (int g = 0; g < 4; ++g) { const f32x4 gn = *(const f32x4*)(gq + 8 * g);
        u32x2 w; w.x = cvtpk(a0[4 * g] * rn * gn[0], a0[4 * g + 1] * rn * gn[1]); w.y = cvtpk(a0[4 * g + 2] * rn * gn[2], a0[4 * g + 3] * rn * gn[3]);
        *(u32x2*)(qrow + 8 * g) = w; asm volatile("" ::: "memory"); }
#pragma unroll
    for (int g = 0; g < 4; ++g) { const f32x4 gn = *(const f32x4*)(gq + 32 + 8 * g);
        u32x2 w; w.x = cvtpk(a1[4 * g] * rn * gn[0], a1[4 * g + 1] * rn * gn[1]); w.y = cvtpk(a1[4 * g + 2] * rn * gn[2], a1[4 * g + 3] * rn * gn[3]);
        *(u32x2*)(qrow + 32 + 8 * g) = w; asm volatile("" ::: "memory"); }
#pragma unroll
    for (int g = 0; g < 2; ++g) { const f32x4 g1 = *(const f32x4*)(gq + 64 + 8 * g), g2 = *(const f32x4*)(gq + 80 + 8 * g), iv = *(const f32x4*)(c.lds + 2 * WBUF + 768 + 16 * hi + 32 * g);
        float o1[4], o2[4];
#pragma unroll
        for (int j = 0; j < 4; ++j) { const float x1 = a2[4 * g + j] * rn * g1[j], x2 = a2[4 * g + 8 + j] * rn * g2[j];
            const float rev = __builtin_amdgcn_fractf(pos * iv[j]); float cs, sn; TRIG(cs, sn, rev);
            o1[j] = x1 * cs - x2 * sn; o2[j] = x2 * cs + x1 * sn; }
        u32x2 w; w.x = cvtpk(o1[0], o1[1]); w.y = cvtpk(o1[2], o1[3]); *(u32x2*)(qrow + 64 + 8 * g) = w;
        w.x = cvtpk(o2[0], o2[1]); w.y = cvtpk(o2[2], o2[3]); *(u32x2*)(qrow + 80 + 8 * g) = w; asm volatile("" ::: "memory"); }
}
__device__ __forceinline__ void kv_epi(const Ctx& c, int h, int tok, float pos, float rk, const float (&pf)[4][4], float sp, const f32x16& a0, const f32x16& a1, const f32x16& a2, const f32x16& a3) {
    const int hi = c.hi;
    float s = 0.f;
#pragma unroll
    for (int r = 0; r < 16; ++r) s += a0[r] * a0[r] + a1[r] * a1[r];
    const float rp = rsq_guarded(swap32_sum(s * (rk * rk) + sp) * (1.f / MQK) + EPS), rn = rp * rk;
    bf16_t* krow = c.ko + (size_t)tok * 1024 + h * 96 + 4 * hi; bf16_t* vrow = c.vo + (size_t)tok * 512 + h * 64 + 4 * hi; const float* gk = (const float*)(c.lds + 2 * WBUF) + 96 + 4 * hi;
#pragma unroll
    for (int g = 0; g < 4; ++g) { const f32x4 gn = *(const f32x4*)(gk + 8 * g);
        u32x2 w; w.x = cvtpk(a0[4 * g] * rn * gn[0], a0[4 * g + 1] * rn * gn[1]); w.y = cvtpk(a0[4 * g + 2] * rn * gn[2], a0[4 * g + 3] * rn * gn[3]);
        *(u32x2*)(krow + 8 * g) = w; asm volatile("" ::: "memory"); }
#pragma unroll
    for (int g = 0; g < 4; ++g) { const f32x4 gn = *(const f32x4*)(gk + 32 + 8 * g);
        u32x2 w; w.x = cvtpk(a1[4 * g] * rn * gn[0], a1[4 * g + 1] * rn * gn[1]); w.y = cvtpk(a1[4 * g + 2] * rn * gn[2], a1[4 * g + 3] * rn * gn[3]);
        *(u32x2*)(krow + 32 + 8 * g) = w; asm volatile("" ::: "memory"); }
#pragma unroll
    for (int g = 0; g < 2; ++g) { const f32x4 g1 = *(const f32x4*)(gk + 64 + 8 * g), g2 = *(const f32x4*)(gk + 80 + 8 * g), iv = *(const f32x4*)(c.lds + 2 * WBUF + 768 + 16 * hi + 32 * g);
        float o1[4], o2[4];
#pragma unroll
        for (int j = 0; j < 4; ++j) { const float x1 = pf[g][j] * rp * g1[j], x2 = pf[g + 2][j] * rp * g2[j];
            const float rev = __builtin_amdgcn_fractf(pos * iv[j]); float cs, sn; TRIG(cs, sn, rev);
            o1[j] = x1 * cs - x2 * sn; o2[j] = x2 * cs + x1 * sn; }
        u32x2 w; w.x = cvtpk(o1[0], o1[1]); w.y = cvtpk(o1[2], o1[3]); *(u32x2*)(krow + 64 + 8 * g) = w;
        w.x = cvtpk(o2[0], o2[1]); w.y = cvtpk(o2[2], o2[3]); *(u32x2*)(krow + 80 + 8 * g) = w; asm volatile("" ::: "memory"); }
#pragma unroll
    for (int g = 0; g < 4; ++g) { u32x2 w; w.x = cvtpk(a2[4 * g] * rk, a2[4 * g + 1] * rk); w.y = cvtpk(a2[4 * g + 2] * rk, a2[4 * g + 3] * rk); *(u32x2*)(vrow + 8 * g) = w;
        w.x = cvtpk(a3[4 * g] * rk, a3[4 * g + 1] * rk); w.y = cvtpk(a3[4 * g + 2] * rk, a3[4 * g + 3] * rk); *(u32x2*)(vrow + 32 + 8 * g) = w; asm volatile("" ::: "memory"); }
}
__device__ __forceinline__ void mla_fused_phase(const Ptrs& p, const bf16_t* Wq, const bf16_t* Wkv, char* lds, int vcu) {
    const int tid = threadIdx.x, wid = tid >> 6, lane = tid & 63, r32 = lane & 31, hi = lane >> 5;
    Ctx c; c.zb = (const bf16_t*)(p.ws + WS_ZB); c.qo = (bf16_t*)(p.ws + WS_QRAW); c.ko = (bf16_t*)(p.ws + WS_KVRAW); c.vo = (bf16_t*)(p.ws + WS_VB); c.lds = lds;
    c.qn = p.in[IN_Q_NORM]; c.kn = p.in[IN_K_NORM]; c.invm = (const float*)(p.ws + WS_INVM);
    c.r32 = r32; c.hi = hi; c.h = 0;
    const int h0 = 2 * (vcu & 3), pm = 8 * (vcu >> 5) + ((vcu & 31) >> 2), tok = 256 * pm + 32 * wid + r32;
    const bf16_t* arow = c.zb + (size_t)tok * ZLD + 8 * hi;
    const float pos = (float)(tok & (SEQ - 1));
    char* buf0 = lds; char* buf1 = lds + WBUF;
    if (tid < 52) { const f32x4 gv = (tid < 24) ? *(const f32x4*)(c.qn + 4 * tid) : (tid < 48) ? *(const f32x4*)(c.kn + 4 * (tid - 24)) : *(const f32x4*)(c.invm + 4 * (tid - 48)); *(f32x4*)(lds + 2 * WBUF + 16 * tid) = gv; }
    constexpr int DQ = 8, DK = 4;
    bf16x8 af[DQ];
#pragma unroll
    for (int i = 0; i < DQ; ++i) af[i] = *reinterpret_cast<const bf16x8*>(arow + ZO_CQ + 16 * i);
    { bf16x8 w[9]; ld_wq(Wq, h0, tid, w); st_wq(buf0, tid, w); }
    { bf16x8 w[9]; ld_wq(Wq, h0 + 1, tid, w); st_wq(buf1, tid, w); }
    __syncthreads();
    bf16x8 wk0[8], wk1[8];
    {
        f32x16 acc[6] = {}; float ssa = 0.f;
        const char* wb0 = buf0 + r32 * PQ + 16 * hi; const char* wb1 = buf1 + r32 * PQ + 16 * hi;
        bf16x8 wf[2][6];
#pragma unroll
        for (int tt = 0; tt < 3; ++tt) { wf[0][tt] = *reinterpret_cast<const bf16x8*>(wb0 + tt * 32 * PQ); wf[0][3 + tt] = *reinterpret_cast<const bf16x8*>(wb1 + tt * 32 * PQ); }
#pragma unroll
        for (int ks = 0; ks < 24; ++ks) { const bf16x8 cur = af[ks % DQ]; ssa += sq8b(cur);
            if (ks + 1 < 24) {
#pragma unroll
                for (int tt = 0; tt < 3; ++tt) { wf[(ks + 1) & 1][tt] = *reinterpret_cast<const bf16x8*>(wb0 + tt * 32 * PQ + 32 * (ks + 1)); wf[(ks + 1) & 1][3 + tt] = *reinterpret_cast<const bf16x8*>(wb1 + tt * 32 * PQ + 32 * (ks + 1)); } }
            SBAR();
#pragma unroll
            for (int tt = 0; tt < 6; ++tt) acc[tt] = __builtin_amdgcn_mfma_f32_32x32x16_bf16(wf[ks & 1][tt], cur, acc[tt], 0, 0, 0);
            SBAR();
            if (ks + DQ < 24) af[ks % DQ] = *reinterpret_cast<const bf16x8*>(arow + ZO_CQ + 16 * (ks + DQ)); }
        ld_wkv(Wkv, h0, tid, wk0); ld_wkv(Wkv, h0 + 1, tid, wk1);
        const float rq = rsq_guarded(swap32_sum(ssa) * (1.f / MQR) + EPS);
        q_epi(c, h0, tok, pos, rq, acc[0], acc[1], acc[2]);
        q_epi(c, h0 + 1, tok, pos, rq, acc[3], acc[4], acc[5]);
    }
    __syncthreads();
    st_wkv(buf0, tid, wk0); st_wkv(buf1, tid, wk1);
    bf16x8 ak[DK];
#pragma unroll
    for (int i = 0; i < DK; ++i) ak[i] = *reinterpret_cast<const bf16x8*>(arow + ZO_CKV + 16 * i);
    u32x2 pe[4];
#pragma unroll
    for (int g = 0; g < 4; ++g) pe[g] = *(const u32x2*)(c.zb + (size_t)tok * ZLD + ZO_KPE + 8 * g + 4 * hi);
    __syncthreads();
    {
        f32x16 acc[8] = {}; float ssk = 0.f;
        const char* wb0 = buf0 + r32 * PKV + 16 * hi; const char* wb1 = buf1 + r32 * PKV + 16 * hi;
#pragma unroll
        for (int ks = 0; ks < 16; ++ks) { const bf16x8 cur = ak[ks % DK]; ssk += sq8b(cur);
            bf16x8 wk8[8];
#pragma unroll
            for (int tt = 0; tt < 4; ++tt) { wk8[tt] = *reinterpret_cast<const bf16x8*>(wb0 + tt * 32 * PKV + 32 * ks); wk8[4 + tt] = *reinterpret_cast<const bf16x8*>(wb1 + tt * 32 * PKV + 32 * ks); }
            SBAR();
#pragma unroll
            for (int tt = 0; tt < 8; ++tt) acc[tt] = __builtin_amdgcn_mfma_f32_32x32x16_bf16(wk8[tt], cur, acc[tt], 0, 0, 0);
            SBAR();
            if (ks + DK < 16) ak[ks % DK] = *reinterpret_cast<const bf16x8*>(arow + ZO_CKV + 16 * (ks + DK)); }
        const float rk = rsq_guarded(swap32_sum(ssk) * (1.f / MKVR) + EPS);
        float pf[4][4], sp = 0.f;
#pragma unroll
        for (int g = 0; g < 4; ++g) { pf[g][0] = __uint_as_float(pe[g].x << 16); pf[g][1] = __uint_as_float(pe[g].x & 0xffff0000u); pf[g][2] = __uint_as_float(pe[g].y << 16); pf[g][3] = __uint_as_float(pe[g].y & 0xffff0000u);
            sp += (pf[g][0] * pf[g][0] + pf[g][1] * pf[g][1]) + (pf[g][2] * pf[g][2] + pf[g][3] * pf[g][3]); }
        kv_epi(c, h0, tok, pos, rk, pf, sp, acc[0], acc[1], acc[2], acc[3]);
        kv_epi(c, h0 + 1, tok, pos, rk, pf, sp, acc[4], acc[5], acc[6], acc[7]);
    }
    __syncthreads();
}
}

__device__ __forceinline__ void gating_phase(const Ptrs& p, char* lds, int vcu, int G) {
    const int tid = threadIdx.x, wid = tid >> 6, lane = tid & 63, r32 = lane & 31, hi = lane >> 5;
    const bf16_t* zb = (const bf16_t*)(p.ws + WS_ZB); bf16_t* mix = (bf16_t*)(p.ws + WS_MIX); const bf16_t* Wsp = (const bf16_t*)(p.ws + WS_WSP);
    const int vb = (int)(uintptr_t)lds + t_rd_base(lane);
    for (int it2 = 0; it2 < 2; ++it2) {
        const int k = 2 * (vcu & 31) + it2, g = k & 3, blk = 16 * (vcu >> 5) + (k >> 2), row0 = blk * 128;
        {
            const int r = tid >> 2, qd = tid & 3; const bf16_t* vr = zb + (size_t)(row0 + r) * ZLD + ZO_V + g * 128 + qd * 32; const float* vn = p.in[IN_GM_V_NORM] + g * 128 + qd * 32;
            bf16x8 x[4]; float s = 0.f;
#pragma unroll
            for (int i = 0; i < 4; ++i) { x[i] = *reinterpret_cast<const bf16x8*>(vr + i * 8);
#pragma unroll
                for (int u = 0; u < 8; ++u) { const float f = bf2f((bf16_t)x[i][u]); s += f * f; } }
            s += __shfl_xor(s, 1); s += __shfl_xor(s, 2);
            const float rn = rsqrtf(s * (1.f / 128.f) + EPS);
#pragma unroll
            for (int i = 0; i < 4; ++i) { u32x4 w; const f32x4 g0 = *(const f32x4*)(vn + i * 8), g1 = *(const f32x4*)(vn + i * 8 + 4);
                w.x = pk2(bf2f((bf16_t)x[i][0]) * rn * g0[0], bf2f((bf16_t)x[i][1]) * rn * g0[1]); w.y = pk2(bf2f((bf16_t)x[i][2]) * rn * g0[2], bf2f((bf16_t)x[i][3]) * rn * g0[3]);
                w.z = pk2(bf2f((bf16_t)x[i][4]) * rn * g1[0], bf2f((bf16_t)x[i][5]) * rn * g1[1]); w.w = pk2(bf2f((bf16_t)x[i][6]) * rn * g1[2], bf2f((bf16_t)x[i][7]) * rn * g1[3]);
                *(u32x4*)(lds + t_st<4>(r, qd * 32 + i * 8)) = w; }
        }
        __syncthreads();
        const int mt = wid >> 1, cb0 = (wid & 1) * 2;
        f32x16 acc0 = {}, acc1 = {};
        const bf16_t* wrow = Wsp + (size_t)g * 16384 + (size_t)(mt * 32 + r32) * 128 + hi * 8;
        const int nks = (mt < 2) ? 4 : 8;
        bf16x8 afr[8];
#pragma unroll
        for (int ks = 0; ks < 8; ++ks) afr[ks] = *reinterpret_cast<const bf16x8*>(wrow + ks * 16);
        const float* bs = p.in[IN_GM_B_S] + g * 128 + mt * 32;
        bf16_t ur0[16], ur1[16]; float br[16];
#pragma unroll
        for (int r = 0; r < 16; ++r) { const int t = crow(r, hi); const size_t row = (size_t)(row0 + mt * 32 + t); const int c0 = g * 128 + cb0 * 32 + r32;
            ur0[r] = zb[row * ZLD + ZO_U + c0]; ur1[r] = zb[row * ZLD + ZO_U + c0 + 32]; br[r] = bs[t]; }
#pragma unroll
        for (int ks = 0; ks < 8; ++ks) { if (ks < nks) {
            const bf16x8 a = afr[ks];
            s16x4 l0, h0, l1, h1; const int off = vb + ks * 4096 + cb0 * 512;
            asm volatile("ds_read_b64_tr_b16 %0, %1" : "=&v"(l0) : "v"(off) : "memory"); asm volatile("ds_read_b64_tr_b16 %0, %1 offset:2048" : "=&v"(h0) : "v"(off) : "memory");
            asm volatile("ds_read_b64_tr_b16 %0, %1 offset:512" : "=&v"(l1) : "v"(off) : "memory"); asm volatile("ds_read_b64_tr_b16 %0, %1 offset:2560" : "=&v"(h1) : "v"(off) : "memory");
            asm volatile("s_waitcnt lgkmcnt(0)" ::: "memory"); SBAR();
            acc0 = __builtin_amdgcn_mfma_f32_32x32x16_bf16(a, TPK(l0, h0), acc0, 0, 0, 0);
            acc1 = __builtin_amdgcn_mfma_f32_32x32x16_bf16(a, TPK(l1, h1), acc1, 0, 0, 0); } }
#pragma unroll
        for (int r = 0; r < 16; ++r) { const int t = crow(r, hi); const float b = br[r]; const size_t row = (size_t)(row0 + mt * 32 + t);
            const int c0 = g * 128 + cb0 * 32 + r32;
            const float u0 = bf2f(ur0[r]), u1 = bf2f(ur1[r]);
            mix[row * 1024 + c0] = f2bf(u0 * (acc0[r] + b)); mix[row * 1024 + c0 + 32] = f2bf(u1 * (acc1[r] + b)); }
        __syncthreads();
    }
}

__device__ __forceinline__ void amat_phase(unsigned char* ws, int gw, int ngw, int lane) {
    const int r32 = lane & 31, hi = lane >> 5;
    {
        const int x = gw >> 8, wl = gw & 255, il = wl >> 1, mt = wl & 1, h = il & 3, chunk = 32 * (x & 1) + (il >> 2), b = x >> 1, bh = b * 4 + h, item = bh * 64 + chunk;
        const size_t row0 = (size_t)b * SEQ + chunk * 64;
        const bf16_t* qp = (const bf16_t*)(ws + WS_QP) + (row0 + mt * 32 + r32) * 1024 + h * 256 + hi * 8;
        const bf16_t* kp = (const bf16_t*)(ws + WS_KPP) + (row0 + r32) * 1024 + h * 256 + hi * 8;
        f32x16 a0 = {}, a1 = {};
#pragma unroll 4
        for (int ks = 0; ks < 16; ++ks) { const bf16x8 a = *reinterpret_cast<const bf16x8*>(qp + ks * 16);
            const u32x4 k0 = *reinterpret_cast<const u32x4*>(kp + ks * 16), k1 = *reinterpret_cast<const u32x4*>(kp + 32 * 1024 + ks * 16);
            auto s0 = __builtin_amdgcn_permlane32_swap(k0.x, k0.z, false, false); auto s1 = __builtin_amdgcn_permlane32_swap(k0.y, k0.w, false, false);
            auto s2 = __builtin_amdgcn_permlane32_swap(k1.x, k1.z, false, false); auto s3 = __builtin_amdgcn_permlane32_swap(k1.y, k1.w, false, false);
            u32x4 w0 = {s0[0], s1[0], s0[1], s1[1]}, w1 = {s2[0], s3[0], s2[1], s3[1]};
            a0 = __builtin_amdgcn_mfma_f32_32x32x16_bf16(a, *reinterpret_cast<bf16x8*>(&w0), a0, 0, 0, 0); a1 = __builtin_amdgcn_mfma_f32_32x32x16_bf16(a, *reinterpret_cast<bf16x8*>(&w1), a1, 0, 0, 0); }
        bf16_t* A = (bf16_t*)(ws + WS_AMAT) + (size_t)item * 4096;
#pragma unroll
        for (int r = 0; r < 16; ++r) { const int j = mt * 32 + crow(r, hi); const int m0 = r32, m1 = 32 + r32;
            A[j * 64 + m0] = (j >= m0) ? f2bf(a0[r]) : (bf16_t)0; A[j * 64 + m1] = (j >= m1) ? f2bf(a1[r]) : (bf16_t)0; }
    }
}
namespace scan {
constexpr int KSL = 4160;
constexpr int OFF_K = 0, OFF_V = 2 * 8 * KSL, OFF_RED = OFF_V + 2 * 4096, OFF_OT = OFF_RED + 2 * 32768, OFF_SS = OFF_OT + 2 * 4096, LDS_NEED = OFF_SS + 2 * 256;
template <int CTRL> __device__ __forceinline__ float dpp_f(float x) { return __builtin_bit_cast(float, __builtin_amdgcn_update_dpp(0, __builtin_bit_cast(int, x), CTRL, 0xF, 0xF, true)); }
__device__ __forceinline__ float sum32(float x) {
    x += dpp_f<0xB1>(x); x += dpp_f<0x4E>(x); x += dpp_f<0x141>(x); x += dpp_f<0x140>(x);
    auto rr = __builtin_amdgcn_permlane16_swap(__float_as_uint(x), __float_as_uint(x), false, false);
    return __uint_as_float(rr[0]) + __uint_as_float(rr[1]);
}
struct Stage { bf16x8 kq[4], vq, qf[2][2], af; };
__device__ __forceinline__ void scan_phase(unsigned char* ws, char* lds, int vcu, int G) {
    const int tid = threadIdx.x, wid = __builtin_amdgcn_readfirstlane(tid >> 6), lane = tid & 63, r32 = lane & 31, hi = lane >> 5;
    float* ssp = (float*)(ws + WS_SSP);
    const int lds0 = (int)(uintptr_t)lds, rdb = t_rd_base(lane);
    int kdst[4];
#pragma unroll
    for (int i2 = 0; i2 < 4; ++i2) { const int idx = tid + 512 * i2, m = idx >> 5, c = idx & 31; kdst[i2] = OFF_K + (c >> 2) * KSL + t_st<1>(m, 8 * (c & 3)); }
    const int vdst = OFF_V + t_st<1>(tid >> 2, 8 * (tid & 3));
    for (int item = vcu; item < 256; item += G) {
        const int bh = item >> 4, sl = item & 15, b = bh >> 2, h = bh & 3;
        const float g = __builtin_amdgcn_exp2f(64.f * __log2f(1.f - __builtin_amdgcn_exp2f(-5.f - (float)h)));
        const bf16_t* qbase = (const bf16_t*)(ws + WS_QP) + (size_t)b * SEQ * 1024 + h * 256 + 32 * wid + 8 * hi + (size_t)r32 * 1024;
        const bf16_t* kfull = (const bf16_t*)(ws + WS_KPP) + (size_t)b * SEQ * 1024 + h * 256 + (size_t)(tid >> 5) * 1024 + 8 * (tid & 31);
        bf16_t* vbase = (bf16_t*)(ws + WS_VO) + (size_t)b * SEQ * 2048 + h * 512 + 32 * sl;
        const bf16_t* vld = vbase + (size_t)(tid >> 2) * 2048 + 8 * (tid & 3);
        const bf16_t* abase = (const bf16_t*)(ws + WS_AMAT) + (size_t)bh * 64 * 4096 + (32 * (wid & 1) + r32) * 64 + 16 * (wid >> 1) + 8 * hi;
        float* sspb = ssp + (size_t)(sl * 4 + h) * M_ + (size_t)b * SEQ;
        f32x16 S = {};
        Stage st0, st1;
#define SC_LOADKV(ST, i) do { const size_t ro_ = (size_t)(i) * 64; \
        _Pragma("unroll") for (int i2 = 0; i2 < 4; ++i2) ST.kq[i2] = *reinterpret_cast<const bf16x8*>(kfull + (ro_ + 16 * i2) * 1024); \
        if (tid < 256) ST.vq = *reinterpret_cast<const bf16x8*>(vld + ro_ * 2048); } while (0)
#define SC_LOADQA(ST, i) do { const size_t ro_ = (size_t)(i) * 64; \
        _Pragma("unroll") for (int mt = 0; mt < 2; ++mt) _Pragma("unroll") for (int s2 = 0; s2 < 2; ++s2) ST.qf[mt][s2] = *reinterpret_cast<const bf16x8*>(qbase + (ro_ + 32 * mt) * 1024 + 16 * s2); \
        ST.af = *reinterpret_cast<const bf16x8*>(abase + (size_t)(i) * 4096); } while (0)
#define SC_WRITE(ST, bsel) do { _Pragma("unroll") for (int i2 = 0; i2 < 4; ++i2) *(bf16x8*)(lds + (bsel) * 8 * KSL + kdst[i2]) = ST.kq[i2]; if (tid < 256) *(bf16x8*)(lds + (bsel) * 4096 + vdst) = ST.vq; } while (0)
#define SC_FLUSH(i, BSEL) do { if (tid < 256) { const u32x4 w = *(const u32x4*)(lds + OFF_OT + (BSEL) * 4096 + tid * 16); *(u32x4*)(vbase + (size_t)((i) * 64 + (tid >> 2)) * 2048 + 8 * (tid & 3)) = w; } \
        else if (tid < 320) sspb[(i) * 64 + (tid - 256)] = ((const float*)(lds + OFF_SS + (BSEL) * 256))[tid - 256]; } while (0)
#define SC_STEP(i, CUR, OTH, BSEL) do { \
            const int row0 = (i) * 64; const int ld_ = ((i) + 2 < 64) ? (i) + 2 : 63; \
            SC_LOADKV(CUR, ld_); \
            bf16x8 sb[2]; \
            _Pragma("unroll") for (int s2 = 0; s2 < 2; ++s2) { u32x4 w = {cvtpk(S[8 * s2 + 0], S[8 * s2 + 1]), cvtpk(S[8 * s2 + 2], S[8 * s2 + 3]), cvtpk(S[8 * s2 + 4], S[8 * s2 + 5]), cvtpk(S[8 * s2 + 6], S[8 * s2 + 7])}; sb[s2] = *reinterpret_cast<bf16x8*>(&w); } \
            f32x16 op0 = {}, op1 = {}; \
            op0 = __builtin_amdgcn_mfma_f32_32x32x16_bf16(CUR.qf[0][0], sb[0], op0, 0, 0, 0); op1 = __builtin_amdgcn_mfma_f32_32x32x16_bf16(CUR.qf[1][0], sb[0], op1, 0, 0, 0); \
            op0 = __builtin_amdgcn_mfma_f32_32x32x16_bf16(CUR.qf[0][1], sb[1], op0, 0, 0, 0); op1 = __builtin_amdgcn_mfma_f32_32x32x16_bf16(CUR.qf[1][1], sb[1], op1, 0, 0, 0); \
            const int kvb = lds0 + OFF_K + (BSEL) * 8 * KSL + wid * KSL + rdb, vvb = lds0 + OFF_V + (BSEL) * 4096 + rdb; \
            s16x4 kl[4], kh[4], vl[4], vh[4], xl, xh; \
            kl[0] = tr_read<0>(kvb); kh[0] = tr_read<512>(kvb); kl[1] = tr_read<1024>(kvb); kh[1] = tr_read<1536>(kvb); kl[2] = tr_read<2048>(kvb); kh[2] = tr_read<2560>(kvb); kl[3] = tr_read<3072>(kvb); kh[3] = tr_read<3584>(kvb); \
            vl[0] = tr_read<0>(vvb); vh[0] = tr_read<512>(vvb); vl[1] = tr_read<1024>(vvb); vh[1] = tr_read<1536>(vvb); vl[2] = tr_read<2048>(vvb); vh[2] = tr_read<2560>(vvb); vl[3] = tr_read<3072>(vvb); vh[3] = tr_read<3584>(vvb); \
            { const int xo = vvb + (wid >> 1) * 1024; xl = tr_read<0>(xo); xh = tr_read<512>(xo); } \
            asm volatile("s_waitcnt lgkmcnt(0)" ::: "memory"); SBAR(); \
            if (wid & 1) op1 = __builtin_amdgcn_mfma_f32_32x32x16_bf16(CUR.af, TPK(xl, xh), op1, 0, 0, 0); \
            else         op0 = __builtin_amdgcn_mfma_f32_32x32x16_bf16(CUR.af, TPK(xl, xh), op0, 0, 0, 0); \
            _Pragma("unroll") for (int ks = 0; ks < 4; ++ks) S = __builtin_amdgcn_mfma_f32_32x32x16_bf16(TPK(kl[ks], kh[ks]), TPK(vl[ks], vh[ks]), S, 0, 0, 0); \
            SC_LOADQA(CUR, ld_); \
            _Pragma("unroll") for (int r = 0; r < 16; ++r) S[r] *= g; \
            unsigned* red = (unsigned*)(lds + OFF_RED + (BSEL) * 32768); \
            _Pragma("unroll") for (int p = 0; p < 8; ++p) { red[((wid * 2 + 0) * 8 + p) * 64 + lane] = cvtpk(op0[2 * p], op0[2 * p + 1]); red[((wid * 2 + 1) * 8 + p) * 64 + lane] = cvtpk(op1[2 * p], op1[2 * p + 1]); } \
            SC_WRITE(OTH, (BSEL) ^ 1); \
            __syncthreads(); \
            if ((i) > 0) SC_FLUSH((i) - 1, (BSEL) ^ 1); \
            _Pragma("unroll") for (int q = 0; q < 2; ++q) { const int idx = wid * 2 + q, mt = idx >> 3, p = idx & 7; float v0 = 0.f, v1 = 0.f; \
                _Pragma("unroll") for (int w2 = 0; w2 < 8; ++w2) { const unsigned u = red[((w2 * 2 + mt) * 8 + p) * 64 + lane]; v0 += __uint_as_float(u << 16); v1 += __uint_as_float(u & 0xffff0000u); } \
                const int j = 32 * mt + crow(2 * p, hi); \
                bf16_t* ot = (bf16_t*)(lds + OFF_OT + (BSEL) * 4096) + j * 32 + r32; \
                ot[0] = f2bf(v0); ot[32] = f2bf(v1); \
                const float s0 = sum32(v0 * v0), s1 = sum32(v1 * v1); \
                if (r32 == 0) { float* sp = (float*)(lds + OFF_SS + (BSEL) * 256) + j; sp[0] = s0; sp[1] = s1; } } \
        } while (0)
        SC_LOADKV(st0, 0); SC_LOADQA(st0, 0); SC_LOADKV(st1, 1); SC_LOADQA(st1, 1);
        SC_WRITE(st0, 0);
        __syncthreads();
#pragma unroll 1
        for (int i = 0; i < 64; i += 2) { SC_STEP(i, st0, st1, 0); SC_STEP(i + 1, st1, st0, 1); }
        __syncthreads();
        SC_FLUSH(63, 1);
        __syncthreads();
#undef SC_LOADKV
#undef SC_LOADQA
#undef SC_WRITE
#undef SC_STEP
#undef SC_FLUSH
    }
}
}
}

constexpr int NWAVES = 8;
constexpr int RING_OFF = 0, RING_BYTES = 131072;
constexpr int LDS_BYTES = 163840;
constexpr int LDSCTL_OFF = LDS_BYTES - 1024, MISC_OFF = LDSCTL_OFF + 320;
constexpr int LDS_BYTES_UNUSED_ = 0;
constexpr int CW_TMO = 0, CW_CODE = 1, CW_BAR = 4096;

constexpr size_t WO_IN0 = 0;
constexpr size_t WO_UQ = WO_IN0 + (size_t)1792 * 1024;
constexpr size_t WO_UKV = WO_UQ + (size_t)768 * 384;
constexpr size_t WO_OUT0 = WO_UKV + (size_t)1024 * 256;
constexpr size_t WO_GU0 = WO_OUT0 + (size_t)1024 * 1024;
constexpr size_t WO_DN0 = WO_GU0 + (size_t)5632 * 1024;
constexpr size_t WO_IN1 = WO_DN0 + (size_t)1024 * 2816;
constexpr size_t WO_OUT1 = WO_IN1 + (size_t)6144 * 1024;
constexpr size_t WO_GU1 = WO_OUT1 + (size_t)1024 * 2048;
constexpr size_t WO_DN1 = WO_GU1 + (size_t)5632 * 1024;
constexpr size_t WO_END = WO_DN1 + (size_t)1024 * 2816;
static_assert(WS_W + WO_END * 2 <= WS_XB, "bf16 weight copies fit [8,64) MiB");

#define GAS __attribute__((address_space(1)))
#define LAS __attribute__((address_space(3)))
typedef unsigned v4u __attribute__((ext_vector_type(4)));
typedef GAS unsigned gu32;
typedef GAS unsigned long long gu64;
#define RLX_AGENT __ATOMIC_RELAXED, __HIP_MEMORY_SCOPE_AGENT
#define LDS_WAIT() asm volatile("s_waitcnt lgkmcnt(0)" ::: "memory")
#define VM_WAIT() asm volatile("s_waitcnt vmcnt(0)" ::: "memory")
__device__ __forceinline__ unsigned long long rt() { return __builtin_amdgcn_s_memrealtime(); }

#define XB_TMO      128
#define XB_XCNT(j)  (256  + 64 * (j))
#define XB_XSUB(j)  (1280 + 64 * (j))
#define XB_XGEN(j)  (2304 + 64 * (j))
#define XB_TOP      3328
#define XB_TOPGEN   3392
#define XCD_BAR_WORDS 3456
#define XB_SPIN_CAP (1u << 18)

__device__ __forceinline__ unsigned xb_ld(unsigned* p)              { return __hip_atomic_load(p, __ATOMIC_RELAXED, __HIP_MEMORY_SCOPE_AGENT); }
__device__ __forceinline__ unsigned xb_add(unsigned* p, unsigned v) { return __hip_atomic_fetch_add(p, v, __ATOMIC_RELAXED, __HIP_MEMORY_SCOPE_AGENT); }
__device__ __forceinline__ unsigned xb_xcc_id() { return (unsigned)__builtin_amdgcn_s_getreg((3 << 11) | 20) & 0xFu; }
#define XB_SPIN(cond, bar) do { unsigned _sp = 0; while (cond) { __builtin_amdgcn_s_sleep(1); \
    if ((++_sp & 255u) == 0u) { if (xb_ld(&(bar)[XB_TMO])) break; if (_sp > XB_SPIN_CAP) { atomicAdd(&(bar)[XB_TMO], 1u); break; } } } } while (0)

struct XcdBarrier {
    unsigned* bar; unsigned x;
    volatile LAS unsigned* st;
};

__device__ __forceinline__ XcdBarrier xcd_barrier_post(unsigned* bar, volatile LAS unsigned* st) {
    XcdBarrier b; b.bar = bar; b.x = xb_xcc_id(); b.st = st;
    if (threadIdx.x == 0) st[2] = xb_add(&bar[XB_XCNT(b.x)], 1u);
    return b;
}
__device__ __forceinline__ void xcd_barrier_complete(unsigned* bar, unsigned x, unsigned& nloc, unsigned& nx) {
    const unsigned G = gridDim.x * gridDim.y * gridDim.z;
    unsigned sum, cnt, mine, sp = 0u;
    for (;;) {
        sum = 0u; cnt = 0u; mine = 0u;
#pragma unroll
        for (unsigned j = 0; j < 16; ++j) { const unsigned c = xb_ld(&bar[XB_XCNT(j)]); sum += c; cnt += (c > 0u) ? 1u : 0u; mine = (j == x) ? c : mine; }
        if (sum == G) break;
        __builtin_amdgcn_s_sleep(1);
        if ((++sp & 255u) == 0u) { if (xb_ld(&bar[XB_TMO])) break; if (sp > XB_SPIN_CAP) { atomicAdd(&bar[XB_TMO], 1u); break; } }
    }
    nloc = mine > 0u ? mine : 1u; nx = cnt > 0u ? cnt : 1u;
}

__device__ __forceinline__ void xcd_barrier(const XcdBarrier& b) {
    asm volatile("s_waitcnt vmcnt(0)" ::: "memory");
    __syncthreads();
    if (threadIdx.x == 0) {
        unsigned* bar = b.bar;
        __builtin_amdgcn_s_waitcnt(0);
        unsigned nloc = b.st[0], nx = b.st[1];
        if (nloc == 0u) { xcd_barrier_complete(bar, b.x, nloc, nx); b.st[0] = nloc; b.st[1] = nx; }
        const unsigned old = xb_add(&bar[XB_XSUB(b.x)], 1u);
        const unsigned gen = old / nloc;
        if (old + 1u == (gen + 1u) * nloc) {
            __builtin_amdgcn_fence(__ATOMIC_RELEASE, "agent");
            asm volatile("s_waitcnt vmcnt(0)" ::: "memory");
            const unsigned og = xb_add(&bar[XB_TOP], 1u);
            const unsigned tg = og / nx;
            if (og + 1u == (tg + 1u) * nx) xb_add(&bar[XB_TOPGEN], 1u);
            else XB_SPIN(xb_ld(&bar[XB_TOPGEN]) == tg, bar);
            __builtin_amdgcn_fence(__ATOMIC_ACQUIRE, "agent");
            xb_add(&bar[XB_XGEN(b.x)], 1u);
            asm volatile("s_waitcnt vmcnt(0)" ::: "memory");
        } else {
            XB_SPIN(xb_ld(&bar[XB_XGEN(b.x)]) == gen, bar);
            __builtin_amdgcn_fence(__ATOMIC_ACQUIRE, "agent");
            asm volatile("s_waitcnt vmcnt(0)" ::: "memory");
        }
    }
    __syncthreads();
}


#define XB_LSUB(j)  (3520 + 64 * (j))
#define XB_LGEN(j)  (4544 + 64 * (j))
__device__ __forceinline__ void xcd_barrier_local(const XcdBarrier& b) {
    asm volatile("s_waitcnt vmcnt(0)" ::: "memory");
    __syncthreads();
    if (threadIdx.x == 0) {
        unsigned* bar = b.bar;
        __builtin_amdgcn_s_waitcnt(0);
        const unsigned nloc = b.st[0];
        const unsigned old = xb_add(&bar[XB_LSUB(b.x)], 1u);
        const unsigned gen = old / nloc;
        if (old + 1u == (gen + 1u) * nloc) xb_add(&bar[XB_LGEN(b.x)], 1u);
        else XB_SPIN(xb_ld(&bar[XB_LGEN(b.x)]) == gen, bar);
        __builtin_amdgcn_fence(__ATOMIC_ACQUIRE, "agent");
        asm volatile("s_waitcnt vmcnt(0)" ::: "memory");
    }
    __syncthreads();
}
struct Args { Ptrs p; int ph_lo, ph_hi; };

struct WtItem { const float* W; bf16_t* WT; int k0; bool zero; };
typedef float wf4 __attribute__((ext_vector_type(4)));
__device__ __forceinline__ unsigned wt_cvtpk(float lo, float hi) { unsigned r; asm volatile("v_cvt_pk_bf16_f32 %0, %1, %2" : "=v"(r) : "v"(lo), "v"(hi)); return r; }
__device__ __forceinline__ void wt_load(const WtItem& it, int ldw, wf4 (&tv)[8], int lane) {
    if (it.zero) {
#pragma unroll
        for (int j = 0; j < 8; ++j) tv[j] = (wf4){0.f, 0.f, 0.f, 0.f};
    } else {
        const float* src = it.W + (size_t)(it.k0 + (lane >> 3)) * ldw + 4 * (lane & 7);
#pragma unroll
        for (int j = 0; j < 8; ++j) tv[j] = *(const wf4*)(src + (size_t)(8 * j) * ldw);
    }
}
template <bool GAIN> __device__ __forceinline__ void wt_store_t(const WtItem& it, const float* gain, int K, const wf4 (&tv)[8], LAS float* scr, int lane) {
    const int c = lane & 7;
    wf4 g0 = {1.f, 1.f, 1.f, 1.f}, g1 = {1.f, 1.f, 1.f, 1.f};
    if (GAIN) { g0 = *(const wf4*)(gain + it.k0 + 8 * c); g1 = *(const wf4*)(gain + it.k0 + 8 * c + 4); }
#pragma unroll
    for (int j = 0; j < 8; ++j) { LAS float* d = scr + ((lane >> 3) + 8 * j) * 33 + 4 * c; d[0] = tv[j].x; d[1] = tv[j].y; d[2] = tv[j].z; d[3] = tv[j].w; }
    LDS_WAIT(); asm volatile("" ::: "memory");
#pragma unroll
    for (int j = 0; j < 4; ++j) { const int n = (lane >> 3) + 8 * j; const LAS float* s = scr + (8 * c) * 33 + n;
        v4u o; o.x = wt_cvtpk(s[0 * 33] * g0.x, s[1 * 33] * g0.y); o.y = wt_cvtpk(s[2 * 33] * g0.z, s[3 * 33] * g0.w); o.z = wt_cvtpk(s[4 * 33] * g1.x, s[5 * 33] * g1.y); o.w = wt_cvtpk(s[6 * 33] * g1.z, s[7 * 33] * g1.w);
        *(GAS v4u*)(it.WT + (size_t)n * K + it.k0 + 8 * c) = o; }
    LDS_WAIT(); asm volatile("" ::: "memory");
}
__device__ __forceinline__ void wt_store(const WtItem& it, const float* gain, int K, const wf4 (&tv)[8], LAS float* scr, int lane) { if (gain) wt_store_t<true>(it, gain, K, tv, scr, lane); else wt_store_t<false>(it, gain, K, tv, scr, lane); }
__device__ __forceinline__ WtItem wt_make(const float* W, const float* W2, int ncols, int kind, int K, bf16_t* WT, int it, int nrow0, int nnb) {
    const int kb = it / nnb, nb = it % nnb, n0 = nrow0 + nb * 32; const float* src = W; int col = n0; bool zero = false;
    if (kind == 1) { src = ((n0 >> 7) & 1) ? W2 : W; col = 128 * (n0 >> 8) + (n0 & 127); } else zero = (n0 >= ncols);
    WtItem r; r.W = src + col; r.WT = WT + (size_t)n0 * K; r.k0 = kb * 64; r.zero = zero; return r;
}
__device__ __forceinline__ void wt_segment(const float* W, const float* W2, int ldw, int ncols, int kind, const float* gain, int K, int nrows, bf16_t* WT, LAS float* scr, int gw, int ngw, int lane, int nrow0 = 0) {
    const int nitems = (K / 64) * (nrows / 32);
    for (int it = gw; it < nitems; it += 2 * ngw) {
        const WtItem a = wt_make(W, W2, ncols, kind, K, WT, it, nrow0, nrows / 32); wf4 ta[8], tb[8]; wt_load(a, ldw, ta, lane);
        const bool two = (it + ngw) < nitems; WtItem b = a;
        if (two) { b = wt_make(W, W2, ncols, kind, K, WT, it + ngw, nrow0, nrows / 32); wt_load(b, ldw, tb, lane); }
        wt_store(a, gain, K, ta, scr, lane);
        if (two) wt_store(b, gain, K, tb, scr, lane);
    }
}

__global__ void __launch_bounds__(NWAVES * 64, 2) mk_fwd(Args args) {
    extern __shared__ __attribute__((aligned(16))) unsigned char lds[];
    LAS unsigned char* L = (LAS unsigned char*)lds;
    volatile LAS unsigned* MISC = (volatile LAS unsigned*)(L + MISC_OFF);
    const Ptrs& P = args.p;
    const int tid = threadIdx.x, lane = tid & 63, wave = __builtin_amdgcn_readfirstlane(tid >> 6);
    const int G = gridDim.x, bx = blockIdx.x;
    const int vcu = (G % 8 == 0) ? (bx % 8) * (G / 8) + bx / 8 : bx;
    unsigned char* ws = P.ws; gu32* ctl = (gu32*)(ws + WS_CTL);
    for (int u = tid; u < (LDS_BYTES - LDSCTL_OFF) / 4; u += NWAVES * 64) ((LAS unsigned*)(L + LDSCTL_OFF))[u] = 0u;
    __syncthreads();
    const int lo = args.ph_lo, hi = args.ph_hi;
    XcdBarrier bar; bar.bar = (unsigned*)(ctl + CW_BAR); bar.x = 0; bar.st = nullptr;
#if !USE_CG_SYNC
    if (hi - lo > 1) bar = xcd_barrier_post((unsigned*)(ctl + CW_BAR), MISC + 8);
#endif
    float* ssb = (float*)(ws + WS_SS); float* ss1 = ssb; float* ss2 = ssb + M_; float* ss3 = ssb + 2 * M_;
    bf16_t* Wb = (bf16_t*)(ws + WS_W); bf16_t* xb = (bf16_t*)(ws + WS_XB); bf16_t* zb = (bf16_t*)(ws + WS_ZB); bf16_t* mix = (bf16_t*)(ws + WS_MIX); bf16_t* act = (bf16_t*)(ws + WS_ACT);
    const int gw = vcu * NWAVES + wave, NGW = G * NWAVES;

#if USE_CG_SYNC
#define GRID_BAR() cg::this_grid().sync()
#else
#define GRID_BAR() xcd_barrier(bar)
#endif
#ifndef CG_FIRST
#define CG_FIRST 0
#endif
#ifdef TIMING
#define STAMP(k) do { if (bx == 0 && tid == 0) ((unsigned long long*)(ws + WS_CTL + 1024))[(k)] = __builtin_amdgcn_s_memrealtime(); } while (0)
#else
#define STAMP(k) do {} while (0)
#endif
#define IN(k) (lo <= (k) && (k) < hi)
#define SEAM(k) do { if (IN(k) && IN((k) + 1)) { GRID_BAR(); } STAMP((k) + 1); } while (0)
#ifndef LOCAL_SEAMS
#define LOCAL_SEAMS 1
#endif
#define LSEAM(k) do { if (IN(k) && IN((k) + 1)) { if (local_ok) xcd_barrier_local(bar); else GRID_BAR(); } STAMP((k) + 1); } while (0)
#ifndef PHASE_ON
#define PHASE_ON(k) 1
#endif
        STAMP(0);
        if (PHASE_ON(0) && IN(nv::PH_PREP)) {
            LAS float* scr = (LAS float*)(L + RING_OFF + wave * 16384);
            const float* nm = P.in[IN_NORM_MIX]; const float* nf = P.in[IN_NORM_FFN];
            wt_segment(P.in[IN_EVEN_W_IN], nullptr, EVEN_IN, EVEN_IN, 0, nm, 1024, 1792, Wb + WO_IN0, scr, gw, NGW, lane);
            wt_segment(P.in[IN_W_UQ], nullptr, 768, 768, 0, P.in[IN_Q_A_NORM], 384, 768, Wb + WO_UQ, scr, gw, NGW, lane);
            wt_segment(P.in[IN_W_UKV], nullptr, 1024, 1024, 0, P.in[IN_KV_A_NORM], 256, 1024, Wb + WO_UKV, scr, gw, NGW, lane);
            for (int row = gw; row < M_; row += 2 * NGW) {
                const int row2 = (row + NGW < M_) ? row + NGW : row;
                f32x4 va[4], vb[4];
#pragma unroll
                for (int j = 0; j < 4; ++j) { va[j] = *(const f32x4*)(P.in[IN_X] + (size_t)row * DM + j * 256 + lane * 4); vb[j] = *(const f32x4*)(P.in[IN_X] + (size_t)row2 * DM + j * 256 + lane * 4); }
                float s = 0.f, s2 = 0.f;
#pragma unroll
                for (int j = 0; j < 4; ++j) { s += va[j].x * va[j].x + va[j].y * va[j].y + va[j].z * va[j].z + va[j].w * va[j].w; s2 += vb[j].x * vb[j].x + vb[j].y * vb[j].y + vb[j].z * vb[j].z + vb[j].w * vb[j].w;
                    u32x2 o; o.x = pk2(va[j].x, va[j].y); o.y = pk2(va[j].z, va[j].w); *(u32x2*)(xb + (size_t)row * DM + j * 256 + lane * 4) = o;
                    o.x = pk2(vb[j].x, vb[j].y); o.y = pk2(vb[j].z, vb[j].w); *(u32x2*)(xb + (size_t)row2 * DM + j * 256 + lane * 4) = o; }
                s = wave_sum(s); s2 = wave_sum(s2);
                if (lane == 0) { ((float*)(ws + WS_RS0))[row] = rsqrtf(s * (1.f / DM) + EPS); ((float*)(ws + WS_RS0))[row2] = rsqrtf(s2 * (1.f / DM) + EPS); }
            }
            if (gw == 0) { for (int i = lane; i < 128; i += 64) ((float*)(ws + WS_INVR))[i] = (float)(exp(-(double)i / 128.0 * 9.210340371976184) * 0.15915494309189535);
                if (lane < 16) ((float*)(ws + WS_INVM))[lane] = (float)(exp(-(double)lane / 16.0 * 9.210340371976184) * 0.15915494309189535); }
            for (int idx = gw * 64 + lane; idx < 4 * 128 * 128; idx += NGW * 64) { const int t = (idx >> 7) & 127, s = idx & 127; ((bf16_t*)(ws + WS_WSP))[idx] = ((s >> 6) <= (t >> 6)) ? f2bf(P.in[IN_GM_W_S][idx]) : (bf16_t)0; }
        }
        if (IN(nv::PH_PREP) && IN(nv::PH_IN0)) { if (CG_FIRST || hi > 1000) cg::this_grid().sync(); else GRID_BAR(); }
        int cid = bx; bool local_ok = false;
#if !USE_CG_SYNC
        if (hi - lo > 1 && G == 256 && LOCAL_SEAMS) {
            if (tid == 0) { unsigned ok = 1u; for (unsigned j = 0; j < 16; ++j) { const unsigned c = xb_ld(&bar.bar[XB_XCNT(j)]); ok &= (j < 8) ? (c == (unsigned)G / 8u) : (c == 0u); } ok &= (bar.x < 8u) ? 1u : 0u; MISC[11] = ok; }
            __syncthreads();
            local_ok = MISC[11] != 0u;
            if (local_ok) { const int rank = (int)MISC[10]; cid = 8 * rank + (int)bar.x; }
        }
#endif
        const int vcu2 = local_ok ? ((cid & 7) * (G / 8) + (cid >> 3)) : vcu; const int gw2 = vcu2 * NWAVES + wave;
        STAMP(1);
        if (PHASE_ON(1) && IN(nv::PH_IN0)) {
            pg8::Gemm g{xb, Wb + WO_IN0, DM, 1024, 1024}; pg8::StaticOrder S; S.init(M_, ZLD, G, cid);
            pg8::EpiZ0 E{zb, (const float*)(ws + WS_RS0)};
            pg8::gemm_phase<pg8::EpiZ0, pg8::StaticOrder, true, true>(L + RING_OFF, g, S, E);
            if (cid >= 192) { LAS float* scr = (LAS float*)(L + RING_OFF + wave * 16384);
                wt_segment(P.in[IN_EVEN_W_OUT], nullptr, 1024, 1024, 0, nullptr, 1024, 1024, Wb + WO_OUT0, scr, (cid - 192) * NWAVES + wave, 64 * NWAVES, lane);
                wt_segment(P.in[IN_FFN_DOWN], nullptr, 1024, 1024, 0, nullptr, DFF, 1024, Wb + WO_DN0, scr, (cid - 192) * NWAVES + wave, 64 * NWAVES, lane); __syncthreads(); }
        }
        LSEAM(nv::PH_IN0);
        if (PHASE_ON(2) && IN(nv::PH_MLAUP)) { fp::mlaf::mla_fused_phase(P, Wb + WO_UQ, Wb + WO_UKV, (char*)lds + RING_OFF, vcu2); }
        STAMP(nv::PH_MLAUP + 1);
        if (PHASE_ON(3) && IN(nv::PH_GATING)) { fp::gating_phase(P, (char*)lds + RING_OFF, vcu2, G); }
        if (PHASE_ON(3) && IN(nv::PH_GATING)) { LAS float* scr = (LAS float*)(L + RING_OFF + wave * 16384);
            wt_segment(P.in[IN_FFN_GATE], P.in[IN_FFN_UP], DFF, DFF, 1, P.in[IN_NORM_FFN], 1024, 5632, Wb + WO_GU0, scr, gw, NGW, lane); __syncthreads(); }
        SEAM(nv::PH_GATING);
        if (PHASE_ON(5) && IN(nv::PH_ATTN)) { fp::att::attn_phase(ws, (char*)lds + RING_OFF, vcu2, G); }
        SEAM(nv::PH_ATTN);
        if (PHASE_ON(6) && IN(nv::PH_OUT0)) {
            pg8::Gemm g{mix, Wb + WO_OUT0, 1024, 1024, 1024}; pg8::StaticOrder S; S.init(M_, DM, G, cid);
            pg8::EpiResid<false, false> E{nullptr, P.out, xb, ss1};
            pg8::gemm_phase<pg8::EpiResid<false, false>, pg8::StaticOrder, true, true>(L + RING_OFF, g, S, E);
        }
        LSEAM(nv::PH_OUT0);

        if (PHASE_ON(7) && IN(nv::PH_FFN0A)) {
            const bool l1 = (nv::PH_FFN0A == nv::PH_FFN1A);
            pg8::Gemm g{xb, Wb + (l1 ? WO_GU1 : WO_GU0), DM, 1024, 1024}; pg8::StaticOrder S; S.init(M_, 2 * DFF, G, cid);
            pg8::EpiSwiglu E{act, l1 ? ss3 : ss1};
            pg8::gemm_phase<pg8::EpiSwiglu, pg8::StaticOrder, true, true>(L + RING_OFF, g, S, E);
            if (!l1 && cid >= 128) { LAS float* scr = (LAS float*)(L + RING_OFF + wave * 16384);
                wt_segment(P.in[IN_ODD_W_OUT], nullptr, 1024, 1024, 0, P.in[IN_RET_OUT_NORM], 2048, 1024, Wb + WO_OUT1, scr, (cid - 128) * NWAVES + wave, 128 * NWAVES, lane);
                wt_segment(P.in[IN_FFN_DOWN] + (size_t)DFF * DM, nullptr, 1024, 1024, 0, nullptr, DFF, 1024, Wb + WO_DN1, scr, (cid - 128) * NWAVES + wave, 128 * NWAVES, lane);
                wt_segment(P.in[IN_FFN_GATE] + (size_t)DM * DFF, P.in[IN_FFN_UP] + (size_t)DM * DFF, DFF, DFF, 1, P.in[IN_NORM_FFN] + DM, 1024, 5632, Wb + WO_GU1, scr, (cid - 128) * NWAVES + wave, 128 * NWAVES, lane);
                wt_segment(P.in[IN_ODD_W_IN], nullptr, ODD_IN, ODD_IN, 0, P.in[IN_NORM_MIX] + DM, 1024, 6144, Wb + WO_IN1, scr, (cid - 128) * NWAVES + wave, 128 * NWAVES, lane); __syncthreads(); }
        }
        LSEAM(nv::PH_FFN0A);
        if (PHASE_ON(8) && IN(nv::PH_FFN0B)) {
            const bool l1 = (nv::PH_FFN0B == nv::PH_FFN1B);
            pg8::Gemm g{act, Wb + (l1 ? WO_DN1 : WO_DN0), DFF, DFF, DFF}; pg8::StaticOrder S; S.init(M_, DM, G, cid);
            if (l1) { pg8::EpiResid<false, true> E{nullptr, P.out, xb, ss2}; pg8::gemm_phase<pg8::EpiResid<false, true>, pg8::StaticOrder, true, true>(L + RING_OFF, g, S, E); }
            else { pg8::EpiResid<false, false> E{nullptr, P.out, xb, ss2}; pg8::gemm_phase<pg8::EpiResid<false, false>, pg8::StaticOrder, true, true>(L + RING_OFF, g, S, E); }
        }

        SEAM(nv::PH_FFN0B);
        if (PHASE_ON(9) && IN(nv::PH_IN1)) {
            pg8::Gemm g{xb, Wb + WO_IN1, DM, 1024, 1024}; pg8::StaticOrder S; S.init(M_, 4096, G, cid);
            pg8::EpiIn1 E{(bf16_t*)(ws + WS_QP), (bf16_t*)(ws + WS_KPP), (bf16_t*)(ws + WS_VO), ss2, (const float*)(ws + WS_INVR), nullptr};
            pg8::gemm_phase<pg8::EpiIn1, pg8::StaticOrder, true, true>(L + RING_OFF, g, S, E);
        }
        LSEAM(nv::PH_IN1);
        if (PHASE_ON(10) && IN(nv::PH_AMAT)) { fp::amat_phase(ws, gw2, NGW, lane); }
        SEAM(nv::PH_AMAT);
        if (PHASE_ON(11) && IN(nv::PH_SCAN)) { fp::scan::scan_phase(ws, (char*)lds + RING_OFF, vcu2, G); }
        SEAM(nv::PH_SCAN);
        if (PHASE_ON(12) && IN(nv::PH_GATE)) {
            pg8::Gemm g{xb, Wb + WO_IN1 + (size_t)4096 * 1024, DM, 1024, 1024}; pg8::StaticOrder S; S.init(M_, 2048, G, cid);
            pg8::EpiGate E{(bf16_t*)(ws + WS_VO), ss2, (const float*)(ws + WS_SSP)};
            pg8::gemm_phase<pg8::EpiGate, pg8::StaticOrder, true, true>(L + RING_OFF, g, S, E);
        }
        LSEAM(nv::PH_GATE);
        if (PHASE_ON(13) && IN(nv::PH_OUT1)) {
            pg8::Gemm g{(const bf16_t*)(ws + WS_VO), Wb + WO_OUT1, 2048, 2048, 2048}; pg8::StaticOrder S; S.init(M_, DM, G, cid);
            pg8::EpiResid<false, false> E{nullptr, P.out, xb, ss3};
            pg8::gemm_phase<pg8::EpiResid<false, false>, pg8::StaticOrder, true, true>(L + RING_OFF, g, S, E);
        }
        LSEAM(nv::PH_OUT1);

        if (PHASE_ON(14) && IN(nv::PH_FFN1A)) {
            const bool l1 = (nv::PH_FFN1A == nv::PH_FFN1A);
            pg8::Gemm g{xb, Wb + (l1 ? WO_GU1 : WO_GU0), DM, 1024, 1024}; pg8::StaticOrder S; S.init(M_, 2 * DFF, G, cid);
            pg8::EpiSwiglu E{act, l1 ? ss3 : ss1};
            pg8::gemm_phase<pg8::EpiSwiglu, pg8::StaticOrder, true, true>(L + RING_OFF, g, S, E);
        }
        LSEAM(nv::PH_FFN1A);
        if (PHASE_ON(15) && IN(nv::PH_FFN1B)) {
            const bool l1 = (nv::PH_FFN1B == nv::PH_FFN1B);
            pg8::Gemm g{act, Wb + (l1 ? WO_DN1 : WO_DN0), DFF, DFF, DFF}; pg8::StaticOrder S; S.init(M_, DM, G, cid);
            if (l1) { pg8::EpiResid<false, true> E{nullptr, P.out, xb, ss2}; pg8::gemm_phase<pg8::EpiResid<false, true>, pg8::StaticOrder, true, true>(L + RING_OFF, g, S, E); }
            else { pg8::EpiResid<false, false> E{nullptr, P.out, xb, ss2}; pg8::gemm_phase<pg8::EpiResid<false, false>, pg8::StaticOrder, true, true>(L + RING_OFF, g, S, E); }
        }

    STAMP(16);
}
#ifdef TIMING
__global__ void k_poke_time(float* out, const unsigned char* ws) { const unsigned long long* ts = (const unsigned long long*)(ws + WS_CTL + 1024); out[0] += (float)(ts[T_B] - ts[T_A]) * (0.01f / T_DIV); }
#endif
extern "C" void kernel_launch(void* const* d_in, const int* in_sizes, int n_in, void* d_out, int out_size, void* d_ws, size_t ws_size, hipStream_t stream) {
    if (n_in != 20 || out_size != M_ * DM || ws_size < WS_END) { fprintf(stderr, "kernel_launch: unexpected shapes n_in %d out %d ws %zu\n", n_in, out_size, ws_size); return; }
    static int grid = 0;
    if (grid == 0) {
        int dev = 0, cus = 0, per_cu = 0;
        (void)hipGetDevice(&dev); (void)hipDeviceGetAttribute(&cus, hipDeviceAttributeMultiprocessorCount, dev);
        if (hipFuncSetAttribute((const void*)mk_fwd, hipFuncAttributeMaxDynamicSharedMemorySize, LDS_BYTES) != hipSuccess) fprintf(stderr, "kernel_launch: hipFuncSetAttribute failed\n");
        if (hipOccupancyMaxActiveBlocksPerMultiprocessor(&per_cu, (const void*)mk_fwd, NWAVES * 64, LDS_BYTES) != hipSuccess || per_cu < 1) { fprintf(stderr, "kernel_launch: occupancy query says %d\n", per_cu); per_cu = 1; }
        (void)hipGetLastError();
        grid = cus * per_cu;
        if (grid != 256) fprintf(stderr, "kernel_launch: grid %d (cus %d x %d)\n", grid, cus, per_cu);
    }
    (void)hipMemsetAsync(d_ws, 0, ZERO_BYTES, stream);
    Args a{};
    for (int i = 0; i < 20; ++i) a.p.in[i] = (const float*)d_in[i];
    a.p.out = (float*)d_out; a.p.ws = (unsigned char*)d_ws; a.ph_lo = 0; a.ph_hi = nv::PH_COUNT;
    void* kargs[] = {&a};
    const hipError_t e = hipLaunchCooperativeKernel((const void*)mk_fwd, dim3(grid), dim3(NWAVES * 64), kargs, LDS_BYTES, stream);
#ifdef TIMING
    hipLaunchKernelGGL(k_poke_time, dim3(1), dim3(1), 0, stream, (float*)d_out, (const unsigned char*)d_ws);
#endif
    if (e != hipSuccess) fprintf(stderr, "kernel_launch: cooperative launch failed: %s (grid %d)\n", hipGetErrorString(e), grid);
}
```

```cpp
#define USE_CG_SYNC 0
#include <hip/hip_runtime.h>
#include <hip/hip_cooperative_groups.h>
#include <cstdio>
#include <cstdint>
namespace cg = cooperative_groups;

constexpr int BATCH = 4, SEQ = 4096, DM = 1024, M_ = BATCH * SEQ;
constexpr int CHUNK = 64;
constexpr float EPS = 1e-6f;
constexpr int GM_G = 4, GM_D = 128, GM_W = 512, GM_BLK = 128;
constexpr int MH = 8, MQR = 384, MKVR = 256, MNOPE = 64, MROPE = 32, MV = 64, MQK = 96;
constexpr int EVEN_IN = 1696, ZLD = 1792;
constexpr int RH = 4, RQK = 256, RV = 512, ODD_IN = 6144;
constexpr int DFF = 2816;
constexpr int ZO_U = 0, ZO_V = 512, ZO_CQ = 1024, ZO_CKV = 1408, ZO_KPE = 1664;

typedef unsigned short bf16_t;
typedef short bf16x8 __attribute__((ext_vector_type(8)));
typedef float f32x4 __attribute__((ext_vector_type(4)));
typedef float f32x16 __attribute__((ext_vector_type(16)));
typedef unsigned u32x4 __attribute__((ext_vector_type(4)));
typedef unsigned u32x2 __attribute__((ext_vector_type(2)));

__device__ __forceinline__ float bf2f(bf16_t v) { return __uint_as_float(((unsigned)v) << 16); }
__device__ __forceinline__ bf16_t f2bf(float f) { unsigned u = __float_as_uint(f); return (bf16_t)((u + 0x7fffu + ((u >> 16) & 1u)) >> 16); }
__device__ __forceinline__ unsigned pk2(float lo, float hi) { return (unsigned)f2bf(lo) | ((unsigned)f2bf(hi) << 16); }
__device__ __forceinline__ float gelu_tanh(float x) {
    const float u = 0.7978845608028654f * (x + 0.044715f * x * x * x);
    return x / (1.f + __expf(-2.f * u));
}
__device__ __forceinline__ float silu_f(float x) { return x / (1.f + __expf(-x)); }
__device__ __forceinline__ float wave_sum(float v) {
#pragma unroll
    for (int o = 1; o < 64; o <<= 1) v += __shfl_xor(v, o);
    return v;
}

constexpr size_t MiB = 1u << 20;
constexpr size_t WS_CTL = 0;
constexpr size_t WS_SS = 1 * MiB;
constexpr size_t ZERO_BYTES = 2 * MiB;
constexpr size_t WS_RS0 = 2 * MiB;
constexpr size_t WS_INVR = 2 * MiB + 128 * 1024;
constexpr size_t WS_INVM = 2 * MiB + 128 * 1024 + 1024;
constexpr size_t WS_COSR = 3 * MiB;
constexpr size_t WS_SINR = 5 * MiB;
constexpr size_t WS_WSP = 7 * MiB;
constexpr size_t WS_W = 8 * MiB;
constexpr size_t WS_XB = 64 * MiB;
constexpr size_t WS_ARENA = 96 * MiB;
constexpr size_t WS_ZB = 96 * MiB;
constexpr size_t WS_QRAW = 152 * MiB;
constexpr size_t WS_KVRAW = 176 * MiB;
constexpr size_t WS_MIX = 208 * MiB;
constexpr size_t WS_VB = 240 * MiB;
constexpr size_t WS_ACT = 96 * MiB;
constexpr size_t WS_QP = 96 * MiB;
constexpr size_t WS_KPP = 128 * MiB;
constexpr size_t WS_VO = 160 * MiB;
constexpr size_t WS_AMAT = 224 * MiB;
constexpr size_t WS_SSP = 232 * MiB;
constexpr size_t WS_SSQ = 3 * MiB;
constexpr size_t WS_END = 256 * MiB;

struct Ptrs {
    const float* in[20];
    float* out;
    unsigned char* ws;
};
#define IN_X 0
#define IN_NORM_MIX 1
#define IN_NORM_FFN 2
#define IN_EVEN_W_IN 3
#define IN_GM_V_NORM 4
#define IN_GM_W_S 5
#define IN_GM_B_S 6
#define IN_Q_A_NORM 7
#define IN_W_UQ 8
#define IN_KV_A_NORM 9
#define IN_W_UKV 10
#define IN_Q_NORM 11
#define IN_K_NORM 12
#define IN_EVEN_W_OUT 13
#define IN_ODD_W_IN 14
#define IN_RET_OUT_NORM 15
#define IN_ODD_W_OUT 16
#define IN_FFN_GATE 17
#define IN_FFN_UP 18
#define IN_FFN_DOWN 19

__device__ __forceinline__ float* ws_f32(const Ptrs& p, size_t off) { return (float*)(p.ws + off); }
__device__ __forceinline__ bf16_t* ws_bf(const Ptrs& p, size_t off) { return (bf16_t*)(p.ws + off); }
namespace nv {
enum Phase { PH_PREP = 0, PH_IN0, PH_MLAUP, PH_GATING, PH_MLANORM, PH_ATTN, PH_OUT0, PH_FFN0A, PH_FFN0B, PH_IN1, PH_AMAT, PH_SCAN, PH_GATE, PH_OUT1, PH_FFN1A, PH_FFN1B, PH_COUNT };
}

namespace pg8 {
#define PG8_LAS __attribute__((address_space(3)))
constexpr int BM = 256, BK = 64, HALF = 128, HTB = HALF * BK * 2  , STAGE_BYTES = 8 * HTB, NXCD = 8, WGM = 8;

__host__ __device__ __forceinline__ int lds_byte(int r, int c) { const int st = (r >> 4) * 2 + (c >> 5), rr = r & 15, cc = c & 31, ob = rr * 64 + cc * 2; return st * 1024 + (ob ^ (((ob >> 9) & 1) << 5)); }
__host__ __device__ __forceinline__ void stage_rc(int b, int& R, int& C) { const int st = b / 1024, sb = b % 1024, swz = sb ^ (((sb >> 9) & 1) << 5); R = (st >> 1) * 16 + swz / 64; C = (st & 1) * 32 + (swz % 64) / 2; }
__host__ __device__ __forceinline__ int perm32(int rho) { const int n = rho >> 4, i = rho & 15; return 8 * (i >> 2) + 4 * n + (i & 3); }

struct Unit { int pm, pn; };
struct Gemm { const bf16_t* A; const bf16_t* Bt; int lda, ldb, K; };

struct StaticOrder {
    int nM, nN, nwg, G, c;
    __host__ __device__ void init(int M, int N, int G_, int c_) { nM = M / BM; nN = N / BM; nwg = nM * nN; G = G_; c = c_; }
    __host__ __device__ bool next(int i, Unit& u) const {
        const long L = (long)i * G + c; if (L >= nwg) return false;
        int wgid = (int)L; { const int q = nwg / NXCD, r = nwg % NXCD, xcd = wgid % NXCD, off = wgid / NXCD; wgid = (xcd < r ? xcd * (q + 1) : r * (q + 1) + (xcd - r) * q) + off; }
        const int nig = WGM * nN, gid = wgid / nig, fm = gid * WGM, gsz = (nM - fm) < WGM ? (nM - fm) : WGM;
        u.pm = fm + ((wgid % nig) % gsz); u.pn = (wgid % nig) / gsz; return true;
    }
    __device__ __forceinline__ void a_ready(const Unit&) const {}
    __device__ __forceinline__ void done(const Unit&) const {}
};

__device__ __forceinline__ unsigned cvt_pk_bf16(float lo, float hi) { unsigned r; asm volatile("v_cvt_pk_bf16_f32 %0, %1, %2" : "=v"(r) : "v"(lo), "v"(hi)); return r; }
__device__ __forceinline__ u32x4 pack8(const f32x4 v0, const f32x4 v1) { u32x4 w; w.x = cvt_pk_bf16(v0[0], v0[1]); w.y = cvt_pk_bf16(v0[2], v0[3]); w.z = cvt_pk_bf16(v1[0], v1[1]); w.w = cvt_pk_bf16(v1[2], v1[3]); return w; }
__device__ __forceinline__ float gelu_fast(float x) {
    const float u2 = x * (1.5957691216057308f + 0.07135481627260025f * x * x);
    return x * __builtin_amdgcn_rcpf(1.f + __builtin_amdgcn_exp2f(-1.4426950408889634f * u2)); }
__device__ __forceinline__ float sigmoid_fast(float x) { return __builtin_amdgcn_rcpf(1.f + __builtin_amdgcn_exp2f(-1.4426950408889634f * x)); }
__device__ __forceinline__ f32x4 gelu4(f32x4 v) { return (f32x4){gelu_fast(v[0]), gelu_fast(v[1]), gelu_fast(v[2]), gelu_fast(v[3])}; }


struct EpiZ0 { static constexpr bool PERM = true, AFTER_DRAIN = false; bf16_t* zb; const float* rs0;
    __device__ __forceinline__ void operator()(const f32x4 (&acc)[2][2][4][2], const Unit& u, int wr, int wc, int fr, int fq) const {
        const int row0 = u.pm * BM + wr * 64 + fr, col0 = u.pn * BM + wc * 32 + 8 * fq; const bool act = u.pn < 4;
#pragma unroll
        for (int ai = 0; ai < 2; ++ai)
#pragma unroll
            for (int m = 0; m < 4; ++m) { const int row = row0 + ai * HALF + m * 16; const float rs = rs0[row]; bf16_t* rowp = zb + (size_t)row * ZLD + col0;
#pragma unroll
                for (int bj = 0; bj < 2; ++bj) { f32x4 v0 = acc[ai][bj][m][0] * rs, v1 = acc[ai][bj][m][1] * rs; if (act) { v0 = gelu4(v0); v1 = gelu4(v1); }
                    *(u32x4*)(rowp + bj * HALF) = pack8(v0, v1); } }
    } };
struct EpiStore { static constexpr bool PERM = true, AFTER_DRAIN = false; bf16_t* O; int ldo; int pad;
    __device__ __forceinline__ void operator()(const f32x4 (&acc)[2][2][4][2], const Unit& u, int wr, int wc, int fr, int fq) const {
        const int row0 = u.pm * BM + wr * 64 + fr, col0 = u.pn * BM + wc * 32 + 8 * fq;
#pragma unroll
        for (int ai = 0; ai < 2; ++ai)
#pragma unroll
            for (int m = 0; m < 4; ++m) { bf16_t* rowp = O + (size_t)(row0 + ai * HALF + m * 16) * ldo + col0;
#pragma unroll
                for (int bj = 0; bj < 2; ++bj) *(u32x4*)(rowp + bj * HALF) = pack8(acc[ai][bj][m][0], acc[ai][bj][m][1]); }
    } };
template <bool FIRST, bool LAST> struct EpiResid { static constexpr bool PERM = !LAST, AFTER_DRAIN = false; const float* basef; float* out; bf16_t* xb; float* ss;
    __device__ __forceinline__ void operator()(const f32x4 (&acc)[2][2][4][2], const Unit& u, int wr, int wc, int fr, int fq) const {
        const int row0 = u.pm * BM + wr * 64 + fr;
        if constexpr (!LAST) {
            const int col0 = u.pn * BM + wc * 32 + 8 * fq;
            u32x4 rb[2][4][2];
#pragma unroll
            for (int ai = 0; ai < 2; ++ai)
#pragma unroll
                for (int m = 0; m < 4; ++m)
#pragma unroll
                    for (int bj = 0; bj < 2; ++bj) rb[ai][m][bj] = *(const u32x4*)(xb + (size_t)(row0 + ai * HALF + m * 16) * DM + col0 + bj * HALF);
#pragma unroll
            for (int ai = 0; ai < 2; ++ai)
#pragma unroll
                for (int m = 0; m < 4; ++m) { const int row = row0 + ai * HALF + m * 16; bf16_t* rowp = xb + (size_t)row * DM + col0; float sq = 0.f;
#pragma unroll
                    for (int bj = 0; bj < 2; ++bj) { const u32x4 b = rb[ai][m][bj];
                        f32x4 v0 = (f32x4){__uint_as_float(b.x << 16), __uint_as_float(b.x & 0xffff0000u), __uint_as_float(b.y << 16), __uint_as_float(b.y & 0xffff0000u)} + acc[ai][bj][m][0];
                        f32x4 v1 = (f32x4){__uint_as_float(b.z << 16), __uint_as_float(b.z & 0xffff0000u), __uint_as_float(b.w << 16), __uint_as_float(b.w & 0xffff0000u)} + acc[ai][bj][m][1];
                        *(u32x4*)(rowp + bj * HALF) = pack8(v0, v1);
                        sq += (v0[0] * v0[0] + v0[1] * v0[1]) + (v0[2] * v0[2] + v0[3] * v0[3]) + (v1[0] * v1[0] + v1[1] * v1[1]) + (v1[2] * v1[2] + v1[3] * v1[3]); }
                    sq += __shfl_xor(sq, 16); sq += __shfl_xor(sq, 32); if (fq == 0) atomicAdd(ss + row, sq);
                    if (m & 1) asm volatile("" ::: "memory"); }
        } else {
            const int col0 = u.pn * BM + wc * 32 + 4 * fq;
            u32x2 rb[2][4][2][2];
#pragma unroll
            for (int ai = 0; ai < 2; ++ai)
#pragma unroll
                for (int m = 0; m < 4; ++m)
#pragma unroll
                    for (int bj = 0; bj < 2; ++bj)
#pragma unroll
                        for (int n = 0; n < 2; ++n) rb[ai][m][bj][n] = *(const u32x2*)(xb + (size_t)(row0 + ai * HALF + m * 16) * DM + col0 + bj * HALF + n * 16);
#pragma unroll
            for (int ai = 0; ai < 2; ++ai)
#pragma unroll
                for (int m = 0; m < 4; ++m) { const int row = row0 + ai * HALF + m * 16; const size_t off = (size_t)row * DM + col0;
#pragma unroll
                    for (int bj = 0; bj < 2; ++bj)
#pragma unroll
                        for (int n = 0; n < 2; ++n) { const size_t o2 = off + bj * HALF + n * 16; const u32x2 b = rb[ai][m][bj][n];
                            const f32x4 v = (f32x4){__uint_as_float(b.x << 16), __uint_as_float(b.x & 0xffff0000u), __uint_as_float(b.y << 16), __uint_as_float(b.y & 0xffff0000u)} + acc[ai][bj][m][n];
                            *(f32x4*)(out + o2) = v; }
                    if (m & 1) asm volatile("" ::: "memory"); }
        }
    } };
struct EpiSwiglu { static constexpr bool PERM = true, AFTER_DRAIN = false; bf16_t* act; const float* ss;
    __device__ __forceinline__ void operator()(const f32x4 (&acc)[2][2][4][2], const Unit& u, int wr, int wc, int fr, int fq) const {
        const int row0 = u.pm * BM + wr * 64 + fr, col0 = u.pn * HALF + wc * 32 + 8 * fq;
#pragma unroll
        for (int ai = 0; ai < 2; ++ai)
#pragma unroll
            for (int m = 0; m < 4; ++m) { const int row = row0 + ai * HALF + m * 16; const float rs = __builtin_amdgcn_rsqf(ss[row] * (1.f / DM) + EPS);
                f32x4 o[2];
#pragma unroll
                for (int n = 0; n < 2; ++n) { const f32x4 g = acc[ai][0][m][n] * rs, up = acc[ai][1][m][n] * rs;
#pragma unroll
                    for (int j = 0; j < 4; ++j) o[n][j] = g[j] * sigmoid_fast(g[j]) * up[j]; }
                *(u32x4*)(act + (size_t)row * DFF + col0) = pack8(o[0], o[1]); }
    } };
struct EpiIn1 { static constexpr bool PERM = true, AFTER_DRAIN = false; bf16_t* qp; bf16_t* kpp; bf16_t* v; const float* ss; const float* inv2pi; const float* unused_;
    __device__ __forceinline__ void operator()(const f32x4 (&acc)[2][2][4][2], const Unit& u, int wr, int wc, int fr, int fq) const {
        const int row0 = u.pm * BM + wr * 64 + fr;
        if (u.pn < 8) {
            const int h = u.pn & 3, d0 = wc * 32 + 8 * fq; const bool isq = u.pn < 4; bf16_t* dst = isq ? qp : kpp;
            const float lg2 = __log2f(1.f - __builtin_amdgcn_exp2f(-5.f - (float)h)) * (isq ? 1.f : -1.f), mul = isq ? 1.f : 0.0625f;
            f32x4 iv[2]; iv[0] = *(const f32x4*)(inv2pi + d0); iv[1] = *(const f32x4*)(inv2pi + d0 + 4);
#pragma unroll
            for (int ai = 0; ai < 2; ++ai)
#pragma unroll
                for (int m = 0; m < 4; ++m) { const int row = row0 + ai * HALF + m * 16, pos = row & (SEQ - 1), jj = row & 63;
                    const float rs = __builtin_amdgcn_rsqf(ss[row] * (1.f / DM) + EPS), sc = __builtin_amdgcn_exp2f(lg2 * (float)(jj + 1)) * mul;
                    f32x4 y1[2], y2[2];
#pragma unroll
                    for (int n = 0; n < 2; ++n) { f32x4 c, s;
#pragma unroll
                        for (int j = 0; j < 4; ++j) { const float rev = __builtin_amdgcn_fractf((float)pos * iv[n][j]); c[j] = __builtin_amdgcn_cosf(rev); s[j] = __builtin_amdgcn_sinf(rev); }
                        const f32x4 x1 = acc[ai][0][m][n] * rs, x2 = acc[ai][1][m][n] * rs;
                        y1[n] = (x1 * c - x2 * s) * sc; y2[n] = (x2 * c + x1 * s) * sc; }
                    bf16_t* rowp = dst + (size_t)row * 1024 + h * 256;
                    if (isq) { const int p0 = (d0 & ~15) + 4 * ((d0 >> 3) & 1);
                        u32x2 w; w.x = cvt_pk_bf16(y1[0][0], y1[0][1]); w.y = cvt_pk_bf16(y1[0][2], y1[0][3]); *(u32x2*)(rowp + p0) = w;
                        w.x = cvt_pk_bf16(y1[1][0], y1[1][1]); w.y = cvt_pk_bf16(y1[1][2], y1[1][3]); *(u32x2*)(rowp + p0 + 8) = w;
                        w.x = cvt_pk_bf16(y2[0][0], y2[0][1]); w.y = cvt_pk_bf16(y2[0][2], y2[0][3]); *(u32x2*)(rowp + 128 + p0) = w;
                        w.x = cvt_pk_bf16(y2[1][0], y2[1][1]); w.y = cvt_pk_bf16(y2[1][2], y2[1][3]); *(u32x2*)(rowp + 128 + p0 + 8) = w; }
                    else { *(u32x4*)(rowp + d0) = pack8(y1[0], y1[1]); *(u32x4*)(rowp + d0 + 128) = pack8(y2[0], y2[1]); } }
        } else {
            const int col0 = (u.pn - 8) * BM + wc * 32 + 8 * fq;
#pragma unroll
            for (int ai = 0; ai < 2; ++ai)
#pragma unroll
                for (int m = 0; m < 4; ++m) { const int row = row0 + ai * HALF + m * 16; const float rs = __builtin_amdgcn_rsqf(ss[row] * (1.f / DM) + EPS); bf16_t* rowp = v + (size_t)row * 2048 + col0;
#pragma unroll
                    for (int bj = 0; bj < 2; ++bj) *(u32x4*)(rowp + bj * HALF) = pack8(acc[ai][bj][m][0] * rs, acc[ai][bj][m][1] * rs); }
        }
    } };
struct EpiGate { static constexpr bool PERM = true, AFTER_DRAIN = false; bf16_t* o; const float* ss; const float* ssp;
    __device__ __forceinline__ void operator()(const f32x4 (&acc)[2][2][4][2], const Unit& u, int wr, int wc, int fr, int fq) const {
        const int row0 = u.pm * BM + wr * 64 + fr, col0 = u.pn * BM + wc * 32 + 8 * fq, h = u.pn >> 1;
#pragma unroll
        for (int ai = 0; ai < 2; ++ai)
#pragma unroll
            for (int m = 0; m < 4; ++m) { const int row = row0 + ai * HALF + m * 16; const float rs = __builtin_amdgcn_rsqf(ss[row] * (1.f / DM) + EPS);
                float sq = 0.f;
#pragma unroll
                for (int s4 = 0; s4 < 4; ++s4) sq += ssp[(size_t)((4 * fq + s4) * 4 + h) * M_ + row];
                sq += __shfl_xor(sq, 16); sq += __shfl_xor(sq, 32);
                const float rinv = __builtin_amdgcn_rsqf(sq * (1.f / RV) + EPS); bf16_t* rowp = o + (size_t)row * 2048 + col0;
#pragma unroll
                for (int bj = 0; bj < 2; ++bj) { const u32x4 ow = *(const u32x4*)(rowp + bj * HALF); f32x4 r[2];
#pragma unroll
                    for (int n = 0; n < 2; ++n) { const f32x4 g = acc[ai][bj][m][n] * rs; const unsigned w0 = n ? ow.z : ow.x, w1 = n ? ow.w : ow.y;
                        const float o0 = __uint_as_float(w0 << 16), o1 = __uint_as_float(w0 & 0xffff0000u), o2 = __uint_as_float(w1 << 16), o3 = __uint_as_float(w1 & 0xffff0000u);
                        r[n][0] = o0 * rinv * g[0] * sigmoid_fast(g[0]); r[n][1] = o1 * rinv * g[1] * sigmoid_fast(g[1]); r[n][2] = o2 * rinv * g[2] * sigmoid_fast(g[2]); r[n][3] = o3 * rinv * g[3] * sigmoid_fast(g[3]); }
                    *(u32x4*)(rowp + bj * HALF) = pack8(r[0], r[1]); } }
    } };

template <class Epi, class Sched, bool ALIGN_EPI = false, bool SP2 = false>
__device__ __forceinline__ void gemm_phase(PG8_LAS unsigned char* lds, const Gemm g, const Sched& S, const Epi& E) {
    const int tid = threadIdx.x, wid = __builtin_amdgcn_readfirstlane(tid >> 6), lane = tid & 63, wr = wid >> 2, wc = wid & 3, fr = lane & 15, fq = lane >> 4;
    const int K = g.K, nt = K / BK;
    unsigned voffA[2], voffB[2];
#pragma unroll
    for (int i = 0; i < 2; ++i) { int R, C; stage_rc(tid * 16 + i * 8192, R, C); const int Rb = Epi::PERM ? ((R & ~31) + perm32(R & 31)) : R;
        voffA[i] = (unsigned)(R * g.lda + C) * 2u; voffB[i] = (unsigned)(Rb * g.ldb + C) * 2u; }
    const size_t kstep = (size_t)(BK * 2);
    const size_t hstepA = (size_t)HALF * g.lda * 2, hstepB = (size_t)HALF * g.ldb * 2;
    const size_t tstepA = 2 * hstepA, tstepB = 2 * hstepB;
    const unsigned ldsw = (unsigned)wid * 1024u;
    const int aoff = lds_byte(wr * 64 + fr, fq * 8), boff = lds_byte(wc * 32 + fr, fq * 8);
#define PG8_SA(b, h) (((b) * 2 + (h)) * HTB)
#define PG8_SB(b, h) ((4 + (b) * 2 + (h)) * HTB)
#define PG8_STAGE(bufoff, gbase, voff) do { _Pragma("unroll") for (int _i = 0; _i < 2; ++_i) \
        __builtin_amdgcn_global_load_lds((const unsigned*)((const char*)(gbase) + (voff)[_i]), (PG8_LAS unsigned*)(lds + (bufoff) + ldsw + _i * 8192), 16, 0, 0); } while (0)
#define PG8_LDA(dst, b, h) do { _Pragma("unroll") for (int m = 0; m < 4; ++m) _Pragma("unroll") for (int k = 0; k < 2; ++k) dst[m][k] = *(const PG8_LAS bf16x8*)(lds + PG8_SA(b, h) + aoff + m * 2048 + k * 1024); } while (0)
#define PG8_LDB(dst, b, h) do { _Pragma("unroll") for (int n = 0; n < 2; ++n) _Pragma("unroll") for (int k = 0; k < 2; ++k) dst[n][k] = *(const PG8_LAS bf16x8*)(lds + PG8_SB(b, h) + boff + n * 2048 + k * 1024); } while (0)
#define PG8_MMA(ai, bj, At, Bt) do { __builtin_amdgcn_s_setprio(1); _Pragma("unroll") for (int m = 0; m < 4; ++m) _Pragma("unroll") for (int n = 0; n < 2; ++n) _Pragma("unroll") for (int k = 0; k < 2; ++k) \
        acc[ai][bj][m][n] = __builtin_amdgcn_mfma_f32_16x16x32_bf16(Bt[n][k], At[m][k], acc[ai][bj][m][n], 0, 0, 0); __builtin_amdgcn_s_setprio(0); } while (0)
#define PG8_WAIT_V(n) asm volatile("s_waitcnt vmcnt(" #n ")" ::: "memory")
#define PG8_WAIT_L(n) asm volatile("s_waitcnt lgkmcnt(" #n ")" ::: "memory")
#define PG8_BAR __builtin_amdgcn_s_barrier()
#define PG8_SCHED __builtin_amdgcn_sched_barrier(0)
    Unit cur, nxt; int ui = 0;
    if (!S.next(0, cur)) return;
    f32x4 acc[2][2][4][2];
#pragma unroll
    for (int a = 0; a < 2; ++a)
#pragma unroll
        for (int b = 0; b < 2; ++b)
#pragma unroll
            for (int m = 0; m < 4; ++m)
#pragma unroll
                for (int n = 0; n < 2; ++n) acc[a][b][m][n] = (f32x4){0.f, 0.f, 0.f, 0.f};
    bf16x8 At[4][2], B0[2][2], B1[2][2];
    const char* cA = (const char*)g.A + (size_t)cur.pm * tstepA; const char* cB = (const char*)g.Bt + (size_t)cur.pn * tstepB;
    S.a_ready(cur);
    if constexpr (SP2) {
        PG8_STAGE(PG8_SB(0, 0), cB, voffB); PG8_STAGE(PG8_SB(0, 1), cB + hstepB, voffB); PG8_STAGE(PG8_SA(0, 0), cA, voffA); PG8_STAGE(PG8_SA(0, 1), cA + hstepA, voffA);
        if (wr == 1) PG8_BAR;
        PG8_WAIT_V(2); PG8_BAR;
        PG8_STAGE(PG8_SB(1, 0), cB + kstep, voffB); PG8_STAGE(PG8_SA(1, 0), cA + kstep, voffA); PG8_STAGE(PG8_SB(1, 1), cB + hstepB + kstep, voffB);
        PG8_WAIT_V(6); PG8_BAR;
    } else {
        PG8_STAGE(PG8_SB(0, 0), cB, voffB); PG8_STAGE(PG8_SA(0, 0), cA, voffA); PG8_STAGE(PG8_SB(0, 1), cB + hstepB, voffB); PG8_STAGE(PG8_SA(0, 1), cA + hstepA, voffA);
        if (wr == 1) PG8_BAR;
        PG8_WAIT_V(4); PG8_BAR;
        PG8_STAGE(PG8_SB(1, 0), cB + kstep, voffB); PG8_STAGE(PG8_SA(1, 0), cA + kstep, voffA); PG8_STAGE(PG8_SB(1, 1), cB + hstepB + kstep, voffB);
        PG8_WAIT_V(6); PG8_BAR;
    }
    for (;;) {
        const bool has_next = S.next(ui + 1, nxt);
        const char* nA = has_next ? (const char*)g.A + (size_t)nxt.pm * tstepA : cA; const char* nB = has_next ? (const char*)g.Bt + (size_t)nxt.pn * tstepB : cB;
        for (int t = 0; t < nt; t += 2) {
            const bool last = (t == nt - 2);
            const char* a1 = cA + (size_t)(t + 1) * kstep;
            const char* a2 = last ? nA : cA + (size_t)(t + 2) * kstep; const char* b2 = last ? nB : cB + (size_t)(t + 2) * kstep;
            const char* a3 = a2 + kstep; const char* b3 = b2 + kstep;
            if (last && has_next) S.a_ready(nxt);
            if constexpr (SP2) {
            PG8_LDB(B0, 0, 0); PG8_LDB(B1, 0, 1); PG8_SCHED; PG8_LDA(At, 0, 0); PG8_STAGE(PG8_SA(1, 1), a1 + hstepA, voffA);
            PG8_WAIT_V(8); PG8_WAIT_L(0); PG8_BAR; PG8_MMA(0, 0, At, B0); PG8_MMA(0, 1, At, B1); PG8_BAR; PG8_SCHED;
            PG8_LDA(At, 0, 1); PG8_STAGE(PG8_SB(0, 0), b2, voffB); PG8_STAGE(PG8_SB(0, 1), b2 + hstepB, voffB); PG8_STAGE(PG8_SA(0, 0), a2, voffA);
            PG8_WAIT_V(8); PG8_WAIT_L(0); PG8_BAR; PG8_MMA(1, 0, At, B0); PG8_MMA(1, 1, At, B1); PG8_BAR; PG8_SCHED;
            PG8_LDB(B0, 1, 0); PG8_LDB(B1, 1, 1); PG8_SCHED; PG8_LDA(At, 1, 0); PG8_STAGE(PG8_SA(0, 1), a2 + hstepA, voffA);
            PG8_WAIT_V(8); PG8_WAIT_L(0); PG8_BAR; PG8_MMA(0, 0, At, B0); PG8_MMA(0, 1, At, B1); PG8_BAR; PG8_SCHED;
            PG8_LDA(At, 1, 1); PG8_STAGE(PG8_SB(1, 0), b3, voffB); PG8_STAGE(PG8_SB(1, 1), b3 + hstepB, voffB); PG8_STAGE(PG8_SA(1, 0), a3, voffA);
            PG8_WAIT_V(8); PG8_WAIT_L(0); PG8_BAR; PG8_MMA(1, 0, At, B0); PG8_MMA(1, 1, At, B1); PG8_BAR; PG8_SCHED;
            } else {
            PG8_LDB(B0, 0, 0); PG8_SCHED; PG8_LDA(At, 0, 0); PG8_STAGE(PG8_SA(1, 1), a1 + hstepA, voffA);
            PG8_WAIT_L(8); PG8_BAR; PG8_WAIT_L(0); PG8_MMA(0, 0, At, B0); PG8_BAR; PG8_SCHED;
            PG8_LDB(B1, 0, 1); PG8_STAGE(PG8_SB(0, 0), b2, voffB);
            PG8_BAR; PG8_WAIT_L(0); PG8_MMA(0, 1, At, B1); PG8_BAR;
            PG8_LDA(At, 0, 1); PG8_STAGE(PG8_SA(0, 0), a2, voffA);
            PG8_BAR; PG8_WAIT_L(0); PG8_MMA(1, 0, At, B0); PG8_BAR; PG8_SCHED;
            PG8_STAGE(PG8_SB(0, 1), b2 + hstepB, voffB);
            PG8_WAIT_V(6); PG8_BAR; PG8_MMA(1, 1, At, B1); PG8_BAR;
            PG8_LDB(B0, 1, 0); PG8_SCHED; PG8_LDA(At, 1, 0); PG8_STAGE(PG8_SA(0, 1), a2 + hstepA, voffA);
            PG8_WAIT_L(8); PG8_BAR; PG8_WAIT_L(0); PG8_MMA(0, 0, At, B0); PG8_BAR; PG8_SCHED;
            PG8_LDB(B1, 1, 1); PG8_STAGE(PG8_SB(1, 0), b3, voffB);
            PG8_BAR; PG8_WAIT_L(0); PG8_MMA(0, 1, At, B1); PG8_BAR;
            PG8_LDA(At, 1, 1); PG8_STAGE(PG8_SA(1, 0), a3, voffA);
            PG8_BAR; PG8_WAIT_L(0); PG8_MMA(1, 0, At, B0); PG8_BAR; PG8_SCHED;
            PG8_STAGE(PG8_SB(1, 1), b3 + hstepB, voffB);
            PG8_WAIT_V(6); PG8_BAR; PG8_MMA(1, 1, At, B1); PG8_BAR;
            }
        }
        if constexpr (ALIGN_EPI) { if (wr == 0) PG8_BAR; }
        if constexpr (!Epi::AFTER_DRAIN) { E(acc, cur, wr, wc, fr, fq); S.done(cur); }
        if (!has_next) break;
#pragma unroll
        for (int a = 0; a < 2; ++a)
#pragma unroll
            for (int b = 0; b < 2; ++b)
#pragma unroll
                for (int m = 0; m < 4; ++m)
#pragma unroll
                    for (int n = 0; n < 2; ++n) acc[a][b][m][n] = (f32x4){0.f, 0.f, 0.f, 0.f};
        cur = nxt; cA = nA; cB = nB; ++ui;
        if constexpr (ALIGN_EPI) { if (wr == 1) PG8_BAR; }
    }
    PG8_WAIT_V(0);
    if constexpr (!ALIGN_EPI) { if (wr == 0) PG8_BAR; }
    PG8_BAR;
    if constexpr (Epi::AFTER_DRAIN) { E.fused(acc, cur, wr, wc, fr, fq, lds, wid, lane); S.done(cur); }
#undef PG8_SA
#undef PG8_SB
#undef PG8_STAGE
#undef PG8_LDA
#undef PG8_LDB
#undef PG8_MMA
#undef PG8_WAIT_V
#undef PG8_WAIT_L
#undef PG8_BAR
#undef PG8_SCHED
}
}


namespace fp {
using s16x4 = __attribute__((ext_vector_type(4))) short;
#define SBAR() __builtin_amdgcn_sched_barrier(0)
__device__ __forceinline__ int crow(int r, int hi) { return (r & 3) + 8 * (r >> 2) + 4 * hi; }
__device__ __forceinline__ unsigned cvtpk(float lo, float hi) { unsigned r; asm volatile("v_cvt_pk_bf16_f32 %0, %1, %2" : "=v"(r) : "v"(lo), "v"(hi)); return r; }
template <int NCB> __device__ __forceinline__ int t_st(int k, int c) { const int kk = (k & ~0xC) | ((k & 4) << 1) | ((k & 8) >> 1); return ((kk >> 3) * NCB + (c >> 5)) * 512 + ((kk & 7) * 32 + (c & 31)) * 2; }
__device__ __forceinline__ int t_rd_base(int lane) { return ((lane & 3) << 3) | (((lane >> 2) & 3) << 6) | (((lane >> 4) & 1) << 5) | (((lane >> 5) & 1) << 8); }
template <int OFF> __device__ __forceinline__ s16x4 tr_read(int vb) { s16x4 r; asm volatile("ds_read_b64_tr_b16 %0, %1 offset:%2" : "=&v"(r) : "v"(vb), "i"(OFF) : "memory"); return r; }
#define TPK(L, H) (bf16x8){L[0], L[1], L[2], L[3], H[0], H[1], H[2], H[3]}

namespace att {
#ifndef ATT_K_AT
#define ATT_K_AT WS_KVRAW
#define ATT_LDK 1024
#define ATT_V_AT WS_VB
#define ATT_LDV 512
#define ATT_VOFF(h) ((h) * 64)
#endif
constexpr int NW = 8, QBLK = 32, KVBLK = 64, LDQ = 768, LDK = ATT_LDK, LDV = ATT_LDV, LDO = 1024;
#ifndef ATT_THR
#define ATT_THR 8.f
#endif
constexpr float QSCALE = 0.10206207261596575f * 1.4426950408889634f, THRL = ATT_THR * 1.4426950408889634f;
constexpr int SHM_V = 8192, SHM_K = 16384, OFF_V = 0, OFF_K = 2 * SHM_V, OFF_WS = OFF_K + 2 * SHM_K, LDS_NEED = OFF_WS + NW * 64 * 4;
#define KSWZ(row, colB) ((row) * 256 + ((colB) ^ (((row) & 7) << 4)))
__device__ __forceinline__ float max3f(float a, float b, float c) { return __builtin_fmaxf(__builtin_fmaxf(a, b), c); }
__device__ __forceinline__ void partialSM(f32x16& p0, f32x16& p1, float& mhat, f32x16& negm, float& alpha) {
    float a = max3f(p0[0], p0[1], p1[0]), b = max3f(p0[2], p0[3], p1[1]); a = max3f(a, p1[2], p1[3]);
#pragma unroll
    for (int r = 4; r < 16; r += 4) { a = max3f(a, p0[r], p0[r + 1]); b = max3f(b, p0[r + 2], p0[r + 3]); a = max3f(a, p1[r], p1[r + 1]); b = max3f(b, p1[r + 2], p1[r + 3]); }
    float rm = fmaxf(a, b);
    { auto rr = __builtin_amdgcn_permlane32_swap(__float_as_uint(rm), __float_as_uint(rm), false, false); rm = fmaxf(__uint_as_float(rr[0]), __uint_as_float(rr[1])); }
    if (__builtin_expect(__all(rm <= THRL), 1)) { alpha = 1.f; }
    else { const float dl = fmaxf(rm, 0.f); mhat += dl; alpha = __builtin_amdgcn_exp2f(-dl);
#pragma unroll
        for (int r = 0; r < 16; ++r) { p0[r] -= dl; p1[r] -= dl; }
#pragma unroll
        for (int r = 0; r < 16; ++r) negm[r] = -mhat; }
#pragma unroll
    for (int r = 0; r < 16; ++r) p0[r] = __builtin_amdgcn_exp2f(p0[r]);
}
__device__ __forceinline__ void finishSM(f32x16& p0, f32x16& p1, float alpha, float& l_reg, bf16x8& pa0, bf16x8& pa1, bf16x8& pa2, bf16x8& pa3) {
#pragma unroll
    for (int r = 0; r < 16; ++r) p1[r] = __builtin_amdgcn_exp2f(p1[r]);
    float ps = 0;
#pragma unroll
    for (int r = 0; r < 16; ++r) ps += p0[r];
#pragma unroll
    for (int r = 0; r < 16; ++r) ps += p1[r];
    { auto rr = __builtin_amdgcn_permlane32_swap(__float_as_uint(ps), __float_as_uint(ps), false, false); ps = __uint_as_float(rr[0]) + __uint_as_float(rr[1]); }
    l_reg = l_reg * alpha + ps;
#define PK4(P, BASE, OUT) do { unsigned a0 = cvtpk(P[BASE + 0], P[BASE + 1]), a1 = cvtpk(P[BASE + 2], P[BASE + 3]);   \
    unsigned b0 = cvtpk(P[BASE + 4], P[BASE + 5]), b1 = cvtpk(P[BASE + 6], P[BASE + 7]);                              \
    auto r0 = __builtin_amdgcn_permlane32_swap(a0, b0, false, false); auto r1 = __builtin_amdgcn_permlane32_swap(a1, b1, false, false); \
    u32x4 w = {r0[0], r1[0], r0[1], r1[1]}; OUT = *reinterpret_cast<bf16x8*>(&w); } while (0)
    PK4(p0, 0, pa0); PK4(p0, 8, pa1); PK4(p1, 0, pa2); PK4(p1, 8, pa3);
#undef PK4
}
__device__ __forceinline__ void qkt(f32x16& p0, f32x16& p1, const char* Ks, const bf16x8* qr, const f32x16& negm, int r32, int hi) {
#pragma unroll
    for (int d0 = 0; d0 < 6; ++d0) { const int cb = (d0 * 16 + hi * 8) * 2;
        const bf16x8 b0 = *reinterpret_cast<const bf16x8*>(Ks + KSWZ(r32, cb));
        const bf16x8 b1 = *reinterpret_cast<const bf16x8*>(Ks + KSWZ(32 + r32, cb));
        if (d0 == 0) { p0 = __builtin_amdgcn_mfma_f32_32x32x16_bf16(b0, qr[0], negm, 0, 0, 0); p1 = __builtin_amdgcn_mfma_f32_32x32x16_bf16(b1, qr[0], negm, 0, 0, 0); }
        else { p0 = __builtin_amdgcn_mfma_f32_32x32x16_bf16(b0, qr[d0], p0, 0, 0, 0); p1 = __builtin_amdgcn_mfma_f32_32x32x16_bf16(b1, qr[d0], p1, 0, 0, 0); } }
}
constexpr int v_rd_off(int d0, int ks, int half) { return d0 * 512 + ks * 2048 + half * 1024; }
template <int D0> __device__ __forceinline__ void pv_one(f32x16& od, int vb, bf16x8 pa0, bf16x8 pa1, bf16x8 pa2, bf16x8 pa3) {
    const s16x4 l0 = tr_read<v_rd_off(D0, 0, 0)>(vb), h0 = tr_read<v_rd_off(D0, 0, 1)>(vb), l1 = tr_read<v_rd_off(D0, 1, 0)>(vb), h1 = tr_read<v_rd_off(D0, 1, 1)>(vb);
    const s16x4 l2 = tr_read<v_rd_off(D0, 2, 0)>(vb), h2 = tr_read<v_rd_off(D0, 2, 1)>(vb), l3 = tr_read<v_rd_off(D0, 3, 0)>(vb), h3 = tr_read<v_rd_off(D0, 3, 1)>(vb);
    asm volatile("s_waitcnt lgkmcnt(0)" ::: "memory"); SBAR();
    od = __builtin_amdgcn_mfma_f32_32x32x16_bf16(pa0, TPK(l0, h0), od, 0, 0, 0);
    od = __builtin_amdgcn_mfma_f32_32x32x16_bf16(pa1, TPK(l1, h1), od, 0, 0, 0);
    od = __builtin_amdgcn_mfma_f32_32x32x16_bf16(pa2, TPK(l2, h2), od, 0, 0, 0);
    od = __builtin_amdgcn_mfma_f32_32x32x16_bf16(pa3, TPK(l3, h3), od, 0, 0, 0);
}
__device__ __forceinline__ void pv_d0(f32x16* o, int vb, bf16x8 pa0, bf16x8 pa1, bf16x8 pa2, bf16x8 pa3) { pv_one<0>(o[0], vb, pa0, pa1, pa2, pa3); pv_one<1>(o[1], vb, pa0, pa1, pa2, pa3); }

__device__ __forceinline__ void attn_unit(const bf16_t* __restrict__ Qb, const bf16_t* __restrict__ Kh, const bf16_t* __restrict__ Vh, bf16_t* __restrict__ Ob, int q0, char* lds) {
    const int tid = threadIdx.x, wid = tid >> 6, lane = tid & 63, r32 = lane & 31, hi = lane >> 5;
    char* V_lds = lds + OFF_V; char* K_lds = lds + OFF_K;
    float* wsf = (float*)(lds + OFF_WS) + wid * 64; float* li_l = wsf; float* al_l = wsf + 32;
    float mhat = 0.f, l_reg = 0; f32x16 o[2] = {}; bf16x8 qr[6]; f32x16 negm = {};
    const bf16_t* Qw = Qb + (long)(wid * QBLK + r32) * LDQ + hi * 8;
#pragma unroll
    for (int d0 = 0; d0 < 6; ++d0) qr[d0] = *reinterpret_cast<const bf16x8*>(Qw + d0 * 16);
    const int srow = tid >> 3, sch = tid & 7;
    const int vst = t_st<2>(srow, sch * 8), kst0 = KSWZ(srow, sch * 16), kst1 = KSWZ(srow, (sch + 8) * 16);
    const int vb0 = (int)(uintptr_t)V_lds + t_rd_base(lane);
    const int koff1 = (sch & 4) ? 32 : 64;
    struct { bf16x8 k0, k1, v0; } sr_[1];
#define SLOAD(i, key0) do { const bf16_t* kp_ = Kh + (long)((key0) + srow) * LDK + sch * 8; sr_[i].k0 = *reinterpret_cast<const bf16x8*>(kp_); sr_[i].k1 = *reinterpret_cast<const bf16x8*>(kp_ + koff1); \
    sr_[i].v0 = *reinterpret_cast<const bf16x8*>(Vh + (long)((key0) + srow) * LDV + sch * 8); } while (0)
#define SWRITE(b, i) do { *(bf16x8*)(K_lds + (b) * SHM_K + kst0) = sr_[i].k0; *(bf16x8*)(K_lds + (b) * SHM_K + kst1) = sr_[i].k1; *(bf16x8*)(V_lds + (b) * SHM_V + vst) = sr_[i].v0; } while (0)
#define SWAIT() asm volatile("s_waitcnt vmcnt(0)" ::: "memory")
#define RESC(a) do { if (__any((a) < 1.f)) { if (hi == 0) al_l[r32] = (a); asm volatile("s_waitcnt lgkmcnt(0)" ::: "memory"); \
    _Pragma("unroll") for (int d = 0; d < 2; ++d) _Pragma("unroll") for (int r = 0; r < 16; ++r) o[d][r] *= al_l[crow(r, hi)]; } } while (0)
#define MASKT(P0, P1, t) do { if ((t) > tmaxw) { _Pragma("unroll") for (int r = 0; r < 16; ++r) { P0[r] = -1e30f; P1[r] = -1e30f; } } } while (0)
    f32x16 pA0, pA1, pB0, pB1; float alA, alB; bf16x8 pa0, pa1, pa2, pa3;
    const int NT = q0 / KVBLK + 4; const int tmaxw = (q0 + wid * QBLK) / KVBLK;
    constexpr int SE = 0, SO = 0;
    SLOAD(SE, 0); asm volatile("s_waitcnt vmcnt(0)" ::: "memory"); SWRITE(0, SE); __syncthreads();
    qkt(pA0, pA1, K_lds, qr, negm, r32, hi); partialSM(pA0, pA1, mhat, negm, alA);
    SLOAD(SO, KVBLK);
    SWAIT(); SWRITE(1, SO); __syncthreads();
    for (int j = 1; j + 1 < NT; j += 2) {
        SBAR(); qkt(pB0, pB1, K_lds + SHM_K, qr, negm, r32, hi); MASKT(pB0, pB1, j);
        finishSM(pA0, pA1, alA, l_reg, pa0, pa1, pa2, pa3); SBAR();
        SLOAD(SO, (j + 1) * KVBLK); SBAR();
        pv_d0(o, vb0, pa0, pa1, pa2, pa3); partialSM(pB0, pB1, mhat, negm, alB);
        __syncthreads(); SWAIT(); SWRITE(0, SE);
        RESC(alB); __syncthreads();
        SBAR(); qkt(pA0, pA1, K_lds, qr, negm, r32, hi); MASKT(pA0, pA1, j + 1);
        finishSM(pB0, pB1, alB, l_reg, pa0, pa1, pa2, pa3); SBAR();
        SLOAD(SE, (j + 2) * KVBLK); SBAR();
        pv_d0(o, vb0 + SHM_V, pa0, pa1, pa2, pa3); partialSM(pA0, pA1, mhat, negm, alA);
        __syncthreads(); SWAIT(); SWRITE(1, SO);
        RESC(alA); __syncthreads();
    }
    SBAR(); qkt(pB0, pB1, K_lds + SHM_K, qr, negm, r32, hi); MASKT(pB0, pB1, NT - 1);
    finishSM(pA0, pA1, alA, l_reg, pa0, pa1, pa2, pa3); SBAR();
    pv_d0(o, vb0, pa0, pa1, pa2, pa3); partialSM(pB0, pB1, mhat, negm, alB);
    __syncthreads(); RESC(alB);
    finishSM(pB0, pB1, alB, l_reg, pa0, pa1, pa2, pa3); SBAR();
    pv_d0(o, vb0 + SHM_V, pa0, pa1, pa2, pa3);
    if (hi == 0) li_l[r32] = l_reg; asm volatile("s_waitcnt lgkmcnt(0)" ::: "memory");
    float rli[16];
#pragma unroll
    for (int r = 0; r < 16; ++r) rli[r] = __builtin_amdgcn_rcpf(li_l[crow(r, hi)]);
    bf16_t* Ow = Ob + (long)(wid * QBLK) * LDO;
#pragma unroll
    for (int r = 0; r < 16; ++r) { const int orow = crow(r, hi);
#pragma unroll
        for (int d0 = 0; d0 < 2; ++d0) Ow[(long)orow * LDO + d0 * 32 + r32] = f2bf(o[d0][r] * rli[r]); }
    __syncthreads();
#undef SLOAD
#undef SWRITE
#undef SWAIT
#undef RESC
#undef MASKT
}
__device__ __forceinline__ void attn_phase(unsigned char* ws, char* lds, int vcu, int G) {
    const bf16_t* q = (const bf16_t*)(ws + WS_QRAW); const bf16_t* k = (const bf16_t*)(ws + ATT_K_AT); const bf16_t* v = (const bf16_t*)(ws + ATT_V_AT);
#ifdef ATT_DEBUG_ALT
    bf16_t* mix = (bf16_t*)(ws + WS_XB);
#else
    bf16_t* mix = (bf16_t*)(ws + WS_MIX);
#endif
    for (int pi = vcu; pi < 256; pi += G) {
        const int bh = pi >> 3, s = pi & 7, b = bh >> 3, h = bh & 7;
        const size_t rb = (size_t)b * SEQ;
#pragma unroll 1
        for (int u = 0; u < 2; ++u) { const int qb = u ? 15 - s : s, q0 = qb * 256;
#ifdef ATT_QBMASK
            if (!((ATT_QBMASK >> qb) & 1)) continue;
#endif
            attn_unit(q + (rb + q0) * LDQ + h * 96, k + rb * LDK + h * 96, v + rb * LDV + ATT_VOFF(h), mix + (rb + q0) * LDO + 512 + h * 64, q0, lds); }
    }
}
#undef KSWZ
}

template <int CTRL> __device__ __forceinline__ float dppf(float x) { return __builtin_bit_cast(float, __builtin_amdgcn_update_dpp(0, __builtin_bit_cast(int, x), CTRL, 0xF, 0xF, true)); }
__device__ __forceinline__ float sum8(float x) { x += dppf<0xB1>(x); x += dppf<0x4E>(x); x += dppf<0x141>(x); return x; }
__device__ __forceinline__ float sum64(float x) { x = sum8(x); x += dppf<0x140>(x);
    { auto rr = __builtin_amdgcn_permlane16_swap(__float_as_uint(x), __float_as_uint(x), false, false); x = __uint_as_float(rr[0]) + __uint_as_float(rr[1]); }
    { auto rr = __builtin_amdgcn_permlane32_swap(__float_as_uint(x), __float_as_uint(x), false, false); x = __uint_as_float(rr[0]) + __uint_as_float(rr[1]); } return x; }
__device__ __forceinline__ float lo16(unsigned u) { return __uint_as_float(u << 16); }
__device__ __forceinline__ float hi16(unsigned u) { return __uint_as_float(u & 0xffff0000u); }
__device__ __forceinline__ float sq8(u32x4 w) { float s = 0.f; s += lo16(w.x) * lo16(w.x) + hi16(w.x) * hi16(w.x); s += lo16(w.y) * lo16(w.y) + hi16(w.y) * hi16(w.y); s += lo16(w.z) * lo16(w.z) + hi16(w.z) * hi16(w.z); s += lo16(w.w) * lo16(w.w) + hi16(w.w) * hi16(w.w); return s; }


namespace mlaf {
constexpr int PQ = 784, PKV = 528;
__device__ __forceinline__ float sq8b(bf16x8 v) { const u32x4 w = *reinterpret_cast<const u32x4*>(&v); return sq8(w); }
#define TRIG(cs_, sn_, rev_) asm volatile("v_cos_f32 %0, %2\n\tv_sin_f32 %1, %2\n\ts_nop 7\n\ts_nop 7\n\ts_nop 7" : "=&v"(cs_), "=&v"(sn_) : "v"(rev_))
__device__ __forceinline__ float rsq_guarded(float x) { float r; asm volatile("v_rsq_f32 %0, %1\n\ts_nop 7\n\ts_nop 7" : "=&v"(r) : "v"(x)); return r; }
__device__ __forceinline__ float swap32_sum(float x) { auto rr = __builtin_amdgcn_permlane32_swap(__float_as_uint(x), __float_as_uint(x), false, false); return __uint_as_float(rr[0]) + __uint_as_float(rr[1]); }
struct Ctx { const bf16_t* zb; bf16_t* qo; bf16_t* ko; bf16_t* vo; char* lds; const float* qn; const float* kn; const float* invm; int h, r32, hi; };
constexpr int WBUF = 96 * PQ;
static_assert(128 * PKV <= WBUF && 2 * WBUF + 832 <= 160 * 1024 - 1024, "two weight buffers + the gains fit the LDS");
__device__ __forceinline__ void ld_wq(const bf16_t* Wq, int h, int tid, bf16x8 (&w)[9]) {
#pragma unroll
    for (int i = 0; i < 9; ++i) { const int cc = tid + 512 * i, n = cc / 48, kc = cc % 48; w[i] = *reinterpret_cast<const bf16x8*>(Wq + (size_t)(96 * h + n) * 384 + 8 * kc); } }
__device__ __forceinline__ void st_wq(char* buf, int tid, const bf16x8 (&w)[9]) {
#pragma unroll
    for (int i = 0; i < 9; ++i) { const int cc = tid + 512 * i, n = cc / 48, kc = cc % 48; *(bf16x8*)(buf + n * PQ + 16 * kc) = w[i]; } }
__device__ __forceinline__ void ld_wkv(const bf16_t* Wkv, int h, int tid, bf16x8 (&w)[8]) {
#pragma unroll
    for (int i = 0; i < 8; ++i) { const int cc = tid + 512 * i, n = cc >> 5, kc = cc & 31; w[i] = *reinterpret_cast<const bf16x8*>(Wkv + (size_t)(128 * h + n) * 256 + 8 * kc); } }
__device__ __forceinline__ void st_wkv(char* buf, int tid, const bf16x8 (&w)[8]) {
#pragma unroll
    for (int i = 0; i < 8; ++i) { const int cc = tid + 512 * i, n = cc >> 5, kc = cc & 31; *(bf16x8*)(buf + n * PKV + 16 * kc) = w[i]; } }
__device__ __forceinline__ void q_epi(const Ctx& c, int h, int tok, float pos, float rq, const f32x16& a0, const f32x16& a1, const f32x16& a2) {
    const int hi = c.hi;
    float s = 0.f;
#pragma unroll
    for (int r = 0; r < 16; ++r) s += a0[r] * a0[r] + a1[r] * a1[r] + a2[r] * a2[r];
    const float rn = rsq_guarded(swap32_sum(s) * (rq * rq) * (1.f / MQK) + EPS) * (att::QSCALE * rq);
    bf16_t* qrow = c.qo + (size_t)tok * 768 + h * 96 + 4 * hi; const float* gq = (const float*)(c.lds + 2 * WBUF) + 4 * hi;
#pragma unroll
    for (int g = 0; g < 4; ++g) { const f32x4 gn = *(const f32x4*)(gq + 8 * g);
        u32x2 w; w.x = cvtpk(a0[4 * g] * rn * gn[0], a0[4 * g + 1] * rn * gn[1]); w.y = cvtpk(a0[4 * g + 2] * rn * gn[2], a0[4 * g + 3] * rn * gn[3]);
        *(u32x2*)(qrow + 8 * g) = w; asm volatile("" ::: "memory"); }
#pragma unroll
    for (int g = 0; g < 4; ++g) { const f32x4 gn = *(const f32x4*)(gq + 32 + 8 * g);
        u32x2 w; w.x = cvtpk(a1[4 * g] * rn * gn[0], a1[4 * g + 1] * rn * gn[1]); w.y = cvtpk(a1[4 * g + 2] * rn * gn[2], a1[4 * g + 3] * rn * gn[3]);
        *(u32x2*)(qrow + 32 + 8 * g) = w; asm volatile("" ::: "memory"); }
#pragma unroll
    for (int g = 0; g < 2; ++g) { const f32x4 g1 = *(const f32x4*)(gq + 64 + 8 * g), g2 = *(const f32x4*)(gq + 80 + 8 * g), iv = *(const f32x4*)(c.lds + 2 * WBUF + 768 + 16 * hi + 32 * g);
        float o1[4], o2[4];
#pragma unroll
        for (int j = 0; j < 4; ++j) { const float x1 = a2[4 * g + j] * rn * g1[j], x2 = a2[4 * g + 8 + j] * rn * g2[j];
            const float rev = __builtin_amdgcn_fractf(pos * iv[j]); float cs, sn; TRIG(cs, sn, rev);
            o1[j] = x1 * cs - x2 * sn; o2[j] = x2 * cs + x1 * sn; }
        u32x2 w; w.x = cvtpk(o1[0], o1[1]); w.y = cvtpk(o1[2], o1[3]); *(u32x2*)(qrow + 64 + 8 * g) = w;
        w.x = cvtpk(o2[0], o2[1]); w.y = cvtpk(o2[2], o2[3]); *(u32x2*)(qrow + 80 + 8 * g) = w; asm volatile("" ::: "memory"); }
}
__device__ __forceinline__ void kv_epi(const Ctx& c, int h, int tok, float pos, float rk, const float (&pf)[4][4], float sp, const f32x16& a0, const f32x16& a1, const f32x16& a2, const f32x16& a3) {
    const int hi = c.hi;
    float s = 0.f;
#pragma unroll
    for (int r = 0; r < 16; ++r) s += a0[r] * a0[r] + a1[r] * a1[r];
    const float rp = rsq_guarded(swap32_sum(s * (rk * rk) + sp) * (1.f / MQK) + EPS), rn = rp * rk;
    bf16_t* krow = c.ko + (size_t)tok * 1024 + h * 96 + 4 * hi; bf16_t* vrow = c.vo + (size_t)tok * 512 + h * 64 + 4 * hi; const float* gk = (const float*)(c.lds + 2 * WBUF) + 96 + 4 * hi;
#pragma unroll
    for (int g = 0; g < 4; ++g) { const f32x4 gn = *(const f32x4*)(gk + 8 * g);
        u32x2 w; w.x = cvtpk(a0[4 * g] * rn * gn[0], a0[4 * g + 1] * rn * gn[1]); w.y = cvtpk(a0[4 * g + 2] * rn * gn[2], a0[4 * g + 3] * rn * gn[3]);
        *(u32x2*)(krow + 8 * g) = w; asm volatile("" ::: "memory"); }
#pragma unroll
    for (int g = 0; g < 4; ++g) { const f32x4 gn = *(const f32x4*)(gk + 32 + 8 * g);
        u32x2 w; w.x = cvtpk(a1[4 * g] * rn * gn[0], a1[4 * g + 1] * rn * gn[1]); w.y = cvtpk(a1[4 * g + 2] * rn * gn[2], a1[4 * g + 3] * rn * gn[3]);
        *(u32x2*)(krow + 32 + 8 * g) = w; asm volatile("" ::: "memory"); }
#pragma unroll
    for (int g = 0; g < 2; ++g) { const f32x4 g1 = *(const f32x4*)(gk + 64 + 8 * g), g2 = *(const f32x4*)(gk + 80 + 8 * g), iv = *(const f32x4*)(c.lds + 2 * WBUF + 768 + 16 * hi + 32 * g);
        float o1[4], o2[4];
#pragma unroll
        for (int j = 0; j < 4; ++j) { const float x1 = pf[g][j] * rp * g1[j], x2 = pf[g + 2][j] * rp * g2[j];
            const float rev = __builtin_amdgcn_fractf(pos * iv[j]); float cs, sn; TRIG(cs, sn, rev);
            o1[j] = x1 * cs - x2 * sn; o2[j] = x2 * cs + x1 * sn; }
        u32x2 w; w.x = cvtpk(o1[0], o1[1]); w.y = cvtpk(o1[2], o1[3]); *(u32x2*)(krow + 64 + 8 * g) = w;
        w.x = cvtpk(o2[0], o2[1]); w.y = cvtpk(o2[2], o2[3]); *(u32x2*)(krow + 80 + 8 * g) = w; asm volatile("" ::: "memory"); }
#pragma unroll
    for (int g = 0; g < 4; ++g) { u32x2 w; w.x = cvtpk(a2[4 * g] * rk, a2[4 * g + 1] * rk); w.y = cvtpk(a2[4 * g + 2] * rk, a2[4 * g + 3] * rk); *(u32x2*)(vrow + 8 * g) = w;
        w.x = cvtpk(a3[4 * g] * rk, a3[4 * g + 1] * rk); w.y = cvtpk(a3[4 * g + 2] * rk, a3[4 * g + 3] * rk); *(u32x2*)(vrow + 32 + 8 * g) = w; asm volatile("" ::: "memory"); }
}
__device__ __forceinline__ void mla_fused_phase(const Ptrs& p, const bf16_t* Wq, const bf16_t* Wkv, char* lds, int vcu) {
    const int tid = threadIdx.x, wid = tid >> 6, lane = tid & 63, r32 = lane & 31, hi = lane >> 5;
    Ctx c; c.zb = (const bf16_t*)(p.ws + WS_ZB); c.qo = (bf16_t*)(p.ws + WS_QRAW); c.ko = (bf16_t*)(p.ws + WS_KVRAW); c.vo = (bf16_t*)(p.ws + WS_VB); c.lds = lds;
    c.qn = p.in[IN_Q_NORM]; c.kn = p.in[IN_K_NORM]; c.invm = (const float*)(p.ws + WS_INVM);
    c.r32 = r32; c.hi = hi; c.h = 0;
    const int h0 = 2 * (vcu & 3), pm = 8 * (vcu >> 5) + ((vcu & 31) >> 2), tok = 256 * pm + 32 * wid + r32;
    const bf16_t* arow = c.zb + (size_t)tok * ZLD + 8 * hi;
    const float pos = (float)(tok & (SEQ - 1));
    char* buf0 = lds; char* buf1 = lds + WBUF;
    if (tid < 52) { const f32x4 gv = (tid < 24) ? *(const f32x4*)(c.qn + 4 * tid) : (tid < 48) ? *(const f32x4*)(c.kn + 4 * (tid - 24)) : *(const f32x4*)(c.invm + 4 * (tid - 48)); *(f32x4*)(lds + 2 * WBUF + 16 * tid) = gv; }
    constexpr int DQ = 8, DK = 4;
    bf16x8 af[DQ];
#pragma unroll
    for (int i = 0; i < DQ; ++i) af[i] = *reinterpret_cast<const bf16x8*>(arow + ZO_CQ + 16 * i);
    { bf16x8 w[9]; ld_wq(Wq, h0, tid, w); st_wq(buf0, tid, w); }
    { bf16x8 w[9]; ld_wq(Wq, h0 + 1, tid, w); st_wq(buf1, tid, w); }
    __syncthreads();
    bf16x8 wk0[8], wk1[8];
    {
        f32x16 acc[6] = {}; float ssa = 0.f;
        const char* wb0 = buf0 + r32 * PQ + 16 * hi; const char* wb1 = buf1 + r32 * PQ + 16 * hi;
        bf16x8 wf[2][6];
#pragma unroll
        for (int tt = 0; tt < 3; ++tt) { wf[0][tt] = *reinterpret_cast<const bf16x8*>(wb0 + tt * 32 * PQ); wf[0][3 + tt] = *reinterpret_cast<const bf16x8*>(wb1 + tt * 32 * PQ); }
#pragma unroll
        for (int ks = 0; ks < 24; ++ks) { const bf16x8 cur = af[ks % DQ]; ssa += sq8b(cur);
            if (ks + 1 < 24) {
#pragma unroll
                for (int tt = 0; tt < 3; ++tt) { wf[(ks + 1) & 1][tt] = *reinterpret_cast<const bf16x8*>(wb0 + tt * 32 * PQ + 32 * (ks + 1)); wf[(ks + 1) & 1][3 + tt] = *reinterpret_cast<const bf16x8*>(wb1 + tt * 32 * PQ + 32 * (ks + 1)); } }
            SBAR();
#pragma unroll
            for (int tt = 0; tt < 6; ++tt) acc[tt] = __builtin_amdgcn_mfma_f32_32x32x16_bf16(wf[ks & 1][tt], cur, acc[tt], 0, 0, 0);
            SBAR();
            if (ks + DQ < 24) af[ks % DQ] = *reinterpret_cast<const bf16x8*>(arow + ZO_CQ + 16 * (ks + DQ)); }
        ld_wkv(Wkv, h0, tid, wk0); ld_wkv(Wkv, h0 + 1, tid, wk1);
        const float rq = rsq_guarded(swap32_sum(ssa) * (1.f / MQR) + EPS);
        q_epi(c, h0, tok, pos, rq, acc[0], acc[1], acc[2]);
        q_epi(c, h0 + 1, tok, pos, rq, acc[3], acc[4], acc[5]);
    }
    __syncthreads();
    st_wkv(buf0, tid, wk0); st_wkv(buf1, tid, wk1);
    bf16x8 ak[DK];
#pragma unroll
    for (int i = 0; i < DK; ++i) ak[i] = *reinterpret_cast<const bf16x8*>(arow + ZO_CKV + 16 * i);
    u32x2 pe[4];
#pragma unroll
    for (int g = 0; g < 4; ++g) pe[g] = *(const u32x2*)(c.zb + (size_t)tok * ZLD + ZO_KPE + 8 * g + 4 * hi);
    __syncthreads();
    {
        f32x16 acc[8] = {}; float ssk = 0.f;
        const char* wb0 = buf0 + r32 * PKV + 16 * hi; const char* wb1 = buf1 + r32 * PKV + 16 * hi;
#pragma unroll
        for (int ks = 0; ks < 16; ++ks) { const bf16x8 cur = ak[ks % DK]; ssk += sq8b(cur);
            bf16x8 wk8[8];
#pragma unroll
            for (int tt = 0; tt < 4; ++tt) { wk8[tt] = *reinterpret_cast<const bf16x8*>(wb0 + tt * 32 * PKV + 32 * ks); wk8[4 + tt] = *reinterpret_cast<const bf16x8*>(wb1 + tt * 32 * PKV + 32 * ks); }
            SBAR();
#pragma unroll
            for (int tt = 0; tt < 8; ++tt) acc[tt] = __builtin_amdgcn_mfma_f32_32x32x16_bf16(wk8[tt], cur, acc[tt], 0, 0, 0);
            SBAR();
            if (ks + DK < 16) ak[ks % DK] = *reinterpret_cast<const bf16x8*>(arow + ZO_CKV + 16 * (ks + DK)); }
        const float rk = rsq_guarded(swap32_sum(ssk) * (1.f / MKVR) + EPS);
        float pf[4][4], sp = 0.f;
#pragma unroll
        for (int g = 0; g < 4; ++g) { pf[g][0] = __uint_as_float(pe[g].x << 16); pf[g][1] = __uint_as_float(pe[g].x & 0xffff0000u); pf[g][2] = __uint_as_float(pe[g].y << 16); pf[g][3] = __uint_as_float(pe[g].y & 0xffff0000u);
            sp += (pf[g][0] * pf[g][0] + pf[g][1] * pf[g][1]) + (pf[g][2] * pf[g][2] + pf[g][3] * pf[g][3]); }
        kv_epi(c, h0, tok, pos, rk, pf, sp, acc[0], acc[1], acc[2], acc[3]);
        kv_epi(c, h0 + 1, tok, pos, rk, pf, sp, acc[4], acc[5], acc[6], acc[7]);
    }
    __syncthreads();
}
}

__device__ __forceinline__ void gating_phase(const Ptrs& p, char* lds, int vcu, int G) {
    const int tid = threadIdx.x, wid = tid >> 6, lane = tid & 63, r32 = lane & 31, hi = lane >> 5;
    const bf16_t* zb = (const bf16_t*)(p.ws + WS_ZB); bf16_t* mix = (bf16_t*)(p.ws + WS_MIX); const bf16_t* Wsp = (const bf16_t*)(p.ws + WS_WSP);
    const int vb = (int)(uintptr_t)lds + t_rd_base(lane);
    for (int it2 = 0; it2 < 2; ++it2) {
        const int k = 2 * (vcu & 31) + it2, g = k & 3, blk = 16 * (vcu >> 5) + (k >> 2), row0 = blk * 128;
        {
            const int r = tid >> 2, qd = tid & 3; const bf16_t* vr = zb + (size_t)(row0 + r) * ZLD + ZO_V + g * 128 + qd * 32; const float* vn = p.in[IN_GM_V_NORM] + g * 128 + qd * 32;
            bf16x8 x[4]; float s = 0.f;
#pragma unroll
            for (int i = 0; i < 4; ++i) { x[i] = *reinterpret_cast<const bf16x8*>(vr + i * 8);
#pragma unroll
                for (int u = 0; u < 8; ++u) { const float f = bf2f((bf16_t)x[i][u]); s += f * f; } }
            s += __shfl_xor(s, 1); s += __shfl_xor(s, 2);
            const float rn = rsqrtf(s * (1.f / 128.f) + EPS);
#pragma unroll
            for (int i = 0; i < 4; ++i) { u32x4 w; const f32x4 g0 = *(const f32x4*)(vn + i * 8), g1 = *(const f32x4*)(vn + i * 8 + 4);
                w.x = pk2(bf2f((bf16_t)x[i][0]) * rn * g0[0], bf2f((bf16_t)x[i][1]) * rn * g0[1]); w.y = pk2(bf2f((bf16_t)x[i][2]) * rn * g0[2], bf2f((bf16_t)x[i][3]) * rn * g0[3]);
                w.z = pk2(bf2f((bf16_t)x[i][4]) * rn * g1[0], bf2f((bf16_t)x[i][5]) * rn * g1[1]); w.w = pk2(bf2f((bf16_t)x[i][6]) * rn * g1[2], bf2f((bf16_t)x[i][7]) * rn * g1[3]);
                *(u32x4*)(lds + t_st<4>(r, qd * 32 + i * 8)) = w; }
        }
        __syncthreads();
        const int mt = wid >> 1, cb0 = (wid & 1) * 2;
        f32x16 acc0 = {}, acc1 = {};
        const bf16_t* wrow = Wsp + (size_t)g * 16384 + (size_t)(mt * 32 + r32) * 128 + hi * 8;
        const int nks = (mt < 2) ? 4 : 8;
        bf16x8 afr[8];
#pragma unroll
        for (int ks = 0; ks < 8; ++ks) afr[ks] = *reinterpret_cast<const bf16x8*>(wrow + ks * 16);
        const float* bs = p.in[IN_GM_B_S] + g * 128 + mt * 32;
        bf16_t ur0[16], ur1[16]; float br[16];
#pragma unroll
        for (int r = 0; r < 16; ++r) { const int t = crow(r, hi); const size_t row = (size_t)(row0 + mt * 32 + t); const int c0 = g * 128 + cb0 * 32 + r32;
            ur0[r] = zb[row * ZLD + ZO_U + c0]; ur1[r] = zb[row * ZLD + ZO_U + c0 + 32]; br[r] = bs[t]; }
#pragma unroll
        for (int ks = 0; ks < 8; ++ks) { if (ks < nks) {
            const bf16x8 a = afr[ks];
            s16x4 l0, h0, l1, h1; const int off = vb + ks * 4096 + cb0 * 512;
            asm volatile("ds_read_b64_tr_b16 %0, %1" : "=&v"(l0) : "v"(off) : "memory"); asm volatile("ds_read_b64_tr_b16 %0, %1 offset:2048" : "=&v"(h0) : "v"(off) : "memory");
            asm volatile("ds_read_b64_tr_b16 %0, %1 offset:512" : "=&v"(l1) : "v"(off) : "memory"); asm volatile("ds_read_b64_tr_b16 %0, %1 offset:2560" : "=&v"(h1) : "v"(off) : "memory");
            asm volatile("s_waitcnt lgkmcnt(0)" ::: "memory"); SBAR();
            acc0 = __builtin_amdgcn_mfma_f32_32x32x16_bf16(a, TPK(l0, h0), acc0, 0, 0, 0);
            acc1 = __builtin_amdgcn_mfma_f32_32x32x16_bf16(a, TPK(l1, h1), acc1, 0, 0, 0); } }
#pragma unroll
        for (int r = 0; r < 16; ++r) { const int t = crow(r, hi); const float b = br[r]; const size_t row = (size_t)(row0 + mt * 32 + t);
            const int c0 = g * 128 + cb0 * 32 + r32;
            const float u0 = bf2f(ur0[r]), u1 = bf2f(ur1[r]);
            mix[row * 1024 + c0] = f2bf(u0 * (acc0[r] + b)); mix[row * 1024 + c0 + 32] = f2bf(u1 * (acc1[r] + b)); }
        __syncthreads();
    }
}

__device__ __forceinline__ void amat_phase(unsigned char* ws, int gw, int ngw, int lane) {
    const int r32 = lane & 31, hi = lane >> 5;
    {
        const int x = gw >> 8, wl = gw & 255, il = wl >> 1, mt = wl & 1, h = il & 3, chunk = 32 * (x & 1) + (il >> 2), b = x >> 1, bh = b * 4 + h, item = bh * 64 + chunk;
        const size_t row0 = (size_t)b * SEQ + chunk * 64;
        const bf16_t* qp = (const bf16_t*)(ws + WS_QP) + (row0 + mt * 32 + r32) * 1024 + h * 256 + hi * 8;
        const bf16_t* kp = (const bf16_t*)(ws + WS_KPP) + (row0 + r32) * 1024 + h * 256 + hi * 8;
        f32x16 a0 = {}, a1 = {};
#pragma unroll 4
        for (int ks = 0; ks < 16; ++ks) { const bf16x8 a = *reinterpret_cast<const bf16x8*>(qp + ks * 16);
            const u32x4 k0 = *reinterpret_cast<const u32x4*>(kp + ks * 16), k1 = *reinterpret_cast<const u32x4*>(kp + 32 * 1024 + ks * 16);
            auto s0 = __builtin_amdgcn_permlane32_swap(k0.x, k0.z, false, false); auto s1 = __builtin_amdgcn_permlane32_swap(k0.y, k0.w, false, false);
            auto s2 = __builtin_amdgcn_permlane32_swap(k1.x, k1.z, false, false); auto s3 = __builtin_amdgcn_permlane32_swap(k1.y, k1.w, false, false);
            u32x4 w0 = {s0[0], s1[0], s0[1], s1[1]}, w1 = {s2[0], s3[0], s2[1], s3[1]};
            a0 = __builtin_amdgcn_mfma_f32_32x32x16_bf16(a, *reinterpret_cast<bf16x8*>(&w0), a0, 0, 0, 0); a1 = __builtin_amdgcn_mfma_f32_32x32x16_bf16(a, *reinterpret_cast<bf16x8*>(&w1), a1, 0, 0, 0); }
        bf16_t* A = (bf16_t*)(ws + WS_AMAT) + (size_t)item * 4096;
#pragma unroll
        for (int r = 0; r < 16; ++r) { const int j = mt * 32 + crow(r, hi); const int m0 = r32, m1 = 32 + r32;
            A[j * 64 + m0] = (j >= m0) ? f2bf(a0[r]) : (bf16_t)0; A[j * 64 + m1] = (j >= m1) ? f2bf(a1[r]) : (bf16_t)0; }
    }
}
namespace scan {
constexpr int KSL = 4160;
constexpr int OFF_K = 0, OFF_V = 2 * 8 * KSL, OFF_RED = OFF_V + 2 * 4096, OFF_OT = OFF_RED + 2 * 32768, OFF_SS = OFF_OT + 2 * 4096, LDS_NEED = OFF_SS + 2 * 256;
template <int CTRL> __device__ __forceinline__ float dpp_f(float x) { return __builtin_bit_cast(float, __builtin_amdgcn_update_dpp(0, __builtin_bit_cast(int, x), CTRL, 0xF, 0xF, true)); }
__device__ __forceinline__ float sum32(float x) {
    x += dpp_f<0xB1>(x); x += dpp_f<0x4E>(x); x += dpp_f<0x141>(x); x += dpp_f<0x140>(x);
    auto rr = __builtin_amdgcn_permlane16_swap(__float_as_uint(x), __float_as_uint(x), false, false);
    return __uint_as_float(rr[0]) + __uint_as_float(rr[1]);
}
struct Stage { bf16x8 kq[4], vq, qf[2][2], af; };
__device__ __forceinline__ void scan_phase(unsigned char* ws, char* lds, int vcu, int G) {
    const int tid = threadIdx.x, wid = __builtin_amdgcn_readfirstlane(tid >> 6), lane = tid & 63, r32 = lane & 31, hi = lane >> 5;
    float* ssp = (float*)(ws + WS_SSP);
    const int lds0 = (int)(uintptr_t)lds, rdb = t_rd_base(lane);
    int kdst[4];
#pragma unroll
    for (int i2 = 0; i2 < 4; ++i2) { const int idx = tid + 512 * i2, m = idx >> 5, c = idx & 31; kdst[i2] = OFF_K + (c >> 2) * KSL + t_st<1>(m, 8 * (c & 3)); }
    const int vdst = OFF_V + t_st<1>(tid >> 2, 8 * (tid & 3));
    for (int item = vcu; item < 256; item += G) {
        const int bh = item >> 4, sl = item & 15, b = bh >> 2, h = bh & 3;
        const float g = __builtin_amdgcn_exp2f(64.f * __log2f(1.f - __builtin_amdgcn_exp2f(-5.f - (float)h)));
        const bf16_t* qbase = (const bf16_t*)(ws + WS_QP) + (size_t)b * SEQ * 1024 + h * 256 + 32 * wid + 8 * hi + (size_t)r32 * 1024;
        const bf16_t* kfull = (const bf16_t*)(ws + WS_KPP) + (size_t)b * SEQ * 1024 + h * 256 + (size_t)(tid >> 5) * 1024 + 8 * (tid & 31);
        bf16_t* vbase = (bf16_t*)(ws + WS_VO) + (size_t)b * SEQ * 2048 + h * 512 + 32 * sl;
        const bf16_t* vld = vbase + (size_t)(tid >> 2) * 2048 + 8 * (tid & 3);
        const bf16_t* abase = (const bf16_t*)(ws + WS_AMAT) + (size_t)bh * 64 * 4096 + (32 * (wid & 1) + r32) * 64 + 16 * (wid >> 1) + 8 * hi;
        float* sspb = ssp + (size_t)(sl * 4 + h) * M_ + (size_t)b * SEQ;
        f32x16 S = {};
        Stage st0, st1;
#define SC_LOADKV(ST, i) do { const size_t ro_ = (size_t)(i) * 64; \
        _Pragma("unroll") for (int i2 = 0; i2 < 4; ++i2) ST.kq[i2] = *reinterpret_cast<const bf16x8*>(kfull + (ro_ + 16 * i2) * 1024); \
        if (tid < 256) ST.vq = *reinterpret_cast<const bf16x8*>(vld + ro_ * 2048); } while (0)
#define SC_LOADQA(ST, i) do { const size_t ro_ = (size_t)(i) * 64; \
        _Pragma("unroll") for (int mt = 0; mt < 2; ++mt) _Pragma("unroll") for (int s2 = 0; s2 < 2; ++s2) ST.qf[mt][s2] = *reinterpret_cast<const bf16x8*>(qbase + (ro_ + 32 * mt) * 1024 + 16 * s2); \
        ST.af = *reinterpret_cast<const bf16x8*>(abase + (size_t)(i) * 4096); } while (0)
#define SC_WRITE(ST, bsel) do { _Pragma("unroll") for (int i2 = 0; i2 < 4; ++i2) *(bf16x8*)(lds + (bsel) * 8 * KSL + kdst[i2]) = ST.kq[i2]; if (tid < 256) *(bf16x8*)(lds + (bsel) * 4096 + vdst) = ST.vq; } while (0)
#define SC_FLUSH(i, BSEL) do { if (tid < 256) { const u32x4 w = *(const u32x4*)(lds + OFF_OT + (BSEL) * 4096 + tid * 16); *(u32x4*)(vbase + (size_t)((i) * 64 + (tid >> 2)) * 2048 + 8 * (tid & 3)) = w; } \
        else if (tid < 320) sspb[(i) * 64 + (tid - 256)] = ((const float*)(lds + OFF_SS + (BSEL) * 256))[tid - 256]; } while (0)
#define SC_STEP(i, CUR, OTH, BSEL) do { \
            const int row0 = (i) * 64; const int ld_ = ((i) + 2 < 64) ? (i) + 2 : 63; \
            SC_LOADKV(CUR, ld_); \
            bf16x8 sb[2]; \
            _Pragma("unroll") for (int s2 = 0; s2 < 2; ++s2) { u32x4 w = {cvtpk(S[8 * s2 + 0], S[8 * s2 + 1]), cvtpk(S[8 * s2 + 2], S[8 * s2 + 3]), cvtpk(S[8 * s2 + 4], S[8 * s2 + 5]), cvtpk(S[8 * s2 + 6], S[8 * s2 + 7])}; sb[s2] = *reinterpret_cast<bf16x8*>(&w); } \
            f32x16 op0 = {}, op1 = {}; \
            op0 = __builtin_amdgcn_mfma_f32_32x32x16_bf16(CUR.qf[0][0], sb[0], op0, 0, 0, 0); op1 = __builtin_amdgcn_mfma_f32_32x32x16_bf16(CUR.qf[1][0], sb[0], op1, 0, 0, 0); \
            op0 = __builtin_amdgcn_mfma_f32_32x32x16_bf16(CUR.qf[0][1], sb[1], op0, 0, 0, 0); op1 = __builtin_amdgcn_mfma_f32_32x32x16_bf16(CUR.qf[1][1], sb[1], op1, 0, 0, 0); \
            const int kvb = lds0 + OFF_K + (BSEL) * 8 * KSL + wid * KSL + rdb, vvb = lds0 + OFF_V + (BSEL) * 4096 + rdb; \
            s16x4 kl[4], kh[4], vl[4], vh[4], xl, xh; \
            kl[0] = tr_read<0>(kvb); kh[0] = tr_read<512>(kvb); kl[1] = tr_read<1024>(kvb); kh[1] = tr_read<1536>(kvb); kl[2] = tr_read<2048>(kvb); kh[2] = tr_read<2560>(kvb); kl[3] = tr_read<3072>(kvb); kh[3] = tr_read<3584>(kvb); \
            vl[0] = tr_read<0>(vvb); vh[0] = tr_read<512>(vvb); vl[1] = tr_read<1024>(vvb); vh[1] = tr_read<1536>(vvb); vl[2] = tr_read<2048>(vvb); vh[2] = tr_read<2560>(vvb); vl[3] = tr_read<3072>(vvb); vh[3] = tr_read<3584>(vvb); \
            { const int xo = vvb + (wid >> 1) * 1024; xl = tr_read<0>(xo); xh = tr_read<512>(xo); } \
            asm volatile("s_waitcnt lgkmcnt(0)" ::: "memory"); SBAR(); \
            if (wid & 1) op1 = __builtin_amdgcn_mfma_f32_32x32x16_bf16(CUR.af, TPK(xl, xh), op1, 0, 0, 0); \
            else         op0 = __builtin_amdgcn_mfma_f32_32x32x16_bf16(CUR.af, TPK(xl, xh), op0, 0, 0, 0); \
            _Pragma("unroll") for (int ks = 0; ks < 4; ++ks) S = __builtin_amdgcn_mfma_f32_32x32x16_bf16(TPK(kl[ks], kh[ks]), TPK(vl[ks], vh[ks]), S, 0, 0, 0); \
            SC_LOADQA(CUR, ld_); \
            _Pragma("unroll") for (int r = 0; r < 16; ++r) S[r] *= g; \
            unsigned* red = (unsigned*)(lds + OFF_RED + (BSEL) * 32768); \
            _Pragma("unroll") for (int p = 0; p < 8; ++p) { red[((wid * 2 + 0) * 8 + p) * 64 + lane] = cvtpk(op0[2 * p], op0[2 * p + 1]); red[((wid * 2 + 1) * 8 + p) * 64 + lane] = cvtpk(op1[2 * p], op1[2 * p + 1]); } \
            SC_WRITE(OTH, (BSEL) ^ 1); \
            __syncthreads(); \
            if ((i) > 0) SC_FLUSH((i) - 1, (BSEL) ^ 1); \
            _Pragma("unroll") for (int q = 0; q < 2; ++q) { const int idx = wid * 2 + q, mt = idx >> 3, p = idx & 7; float v0 = 0.f, v1 = 0.f; \
                _Pragma("unroll") for (int w2 = 0; w2 < 8; ++w2) { const unsigned u = red[((w2 * 2 + mt) * 8 + p) * 64 + lane]; v0 += __uint_as_float(u << 16); v1 += __uint_as_float(u & 0xffff0000u); } \
                const int j = 32 * mt + crow(2 * p, hi); \
                bf16_t* ot = (bf16_t*)(lds + OFF_OT + (BSEL) * 4096) + j * 32 + r32; \
                ot[0] = f2bf(v0); ot[32] = f2bf(v1); \
                const float s0 = sum32(v0 * v0), s1 = sum32(v1 * v1); \
                if (r32 == 0) { float* sp = (float*)(lds + OFF_SS + (BSEL) * 256) + j; sp[0] = s0; sp[1] = s1; } } \
        } while (0)
        SC_LOADKV(st0, 0); SC_LOADQA(st0, 0); SC_LOADKV(st1, 1); SC_LOADQA(st1, 1);
        SC_WRITE(st0, 0);
        __syncthreads();
#pragma unroll 1
        for (int i = 0; i < 64; i += 2) { SC_STEP(i, st0, st1, 0); SC_STEP(i + 1, st1, st0, 1); }
        __syncthreads();
        SC_FLUSH(63, 1);
        __syncthreads();
#undef SC_LOADKV
#undef SC_LOADQA
#undef SC_WRITE
#undef SC_STEP
#undef SC_FLUSH
    }
}
}
}

constexpr int NWAVES = 8;
constexpr int RING_OFF = 0, RING_BYTES = 131072;
constexpr int LDS_BYTES = 163840;
constexpr int LDSCTL_OFF = LDS_BYTES - 1024, MISC_OFF = LDSCTL_OFF + 320;
constexpr int LDS_BYTES_UNUSED_ = 0;
constexpr int CW_TMO = 0, CW_CODE = 1, CW_BAR = 4096;

constexpr size_t WO_IN0 = 0;
constexpr size_t WO_UQ = WO_IN0 + (size_t)1792 * 1024;
constexpr size_t WO_UKV = WO_UQ + (size_t)768 * 384;
constexpr size_t WO_OUT0 = WO_UKV + (size_t)1024 * 256;
constexpr size_t WO_GU0 = WO_OUT0 + (size_t)1024 * 1024;
constexpr size_t WO_DN0 = WO_GU0 + (size_t)5632 * 1024;
constexpr size_t WO_IN1 = WO_DN0 + (size_t)1024 * 2816;
constexpr size_t WO_OUT1 = WO_IN1 + (size_t)6144 * 1024;
constexpr size_t WO_GU1 = WO_OUT1 + (size_t)1024 * 2048;
constexpr size_t WO_DN1 = WO_GU1 + (size_t)5632 * 1024;
constexpr size_t WO_END = WO_DN1 + (size_t)1024 * 2816;
static_assert(WS_W + WO_END * 2 <= WS_XB, "bf16 weight copies fit [8,64) MiB");

#define GAS __attribute__((address_space(1)))
#define LAS __attribute__((address_space(3)))
typedef unsigned v4u __attribute__((ext_vector_type(4)));
typedef GAS unsigned gu32;
typedef GAS unsigned long long gu64;
#define RLX_AGENT __ATOMIC_RELAXED, __HIP_MEMORY_SCOPE_AGENT
#define LDS_WAIT() asm volatile("s_waitcnt lgkmcnt(0)" ::: "memory")
#define VM_WAIT() asm volatile("s_waitcnt vmcnt(0)" ::: "memory")
__device__ __forceinline__ unsigned long long rt() { return __builtin_amdgcn_s_memrealtime(); }

#define XB_TMO      128
#define XB_XCNT(j)  (256  + 64 * (j))
#define XB_XSUB(j)  (1280 + 64 * (j))
#define XB_XGEN(j)  (2304 + 64 * (j))
#define XB_TOP      3328
#define XB_TOPGEN   3392
#define XCD_BAR_WORDS 3456
#define XB_SPIN_CAP (1u << 18)

__device__ __forceinline__ unsigned xb_ld(unsigned* p)              { return __hip_atomic_load(p, __ATOMIC_RELAXED, __HIP_MEMORY_SCOPE_AGENT); }
__device__ __forceinline__ unsigned xb_add(unsigned* p, unsigned v) { return __hip_atomic_fetch_add(p, v, __ATOMIC_RELAXED, __HIP_MEMORY_SCOPE_AGENT); }
__device__ __forceinline__ unsigned xb_xcc_id() { return (unsigned)__builtin_amdgcn_s_getreg((3 << 11) | 20) & 0xFu; }
#define XB_SPIN(cond, bar) do { unsigned _sp = 0; while (cond) { __builtin_amdgcn_s_sleep(1); \
    if ((++_sp & 255u) == 0u) { if (xb_ld(&(bar)[XB_TMO])) break; if (_sp > XB_SPIN_CAP) { atomicAdd(&(bar)[XB_TMO], 1u); break; } } } } while (0)

struct XcdBarrier {
    unsigned* bar; unsigned x;
    volatile LAS unsigned* st;
};

__device__ __forceinline__ XcdBarrier xcd_barrier_post(unsigned* bar, volatile LAS unsigned* st) {
    XcdBarrier b; b.bar = bar; b.x = xb_xcc_id(); b.st = st;
    if (threadIdx.x == 0) st[2] = xb_add(&bar[XB_XCNT(b.x)], 1u);
    return b;
}
__device__ __forceinline__ void xcd_barrier_complete(unsigned* bar, unsigned x, unsigned& nloc, unsigned& nx) {
    const unsigned G = gridDim.x * gridDim.y * gridDim.z;
    unsigned sum, cnt, mine, sp = 0u;
    for (;;) {
        sum = 0u; cnt = 0u; mine = 0u;
#pragma unroll
        for (unsigned j = 0; j < 16; ++j) { const unsigned c = xb_ld(&bar[XB_XCNT(j)]); sum += c; cnt += (c > 0u) ? 1u : 0u; mine = (j == x) ? c : mine; }
        if (sum == G) break;
        __builtin_amdgcn_s_sleep(1);
        if ((++sp & 255u) == 0u) { if (xb_ld(&bar[XB_TMO])) break; if (sp > XB_SPIN_CAP) { atomicAdd(&bar[XB_TMO], 1u); break; } }
    }
    nloc = mine > 0u ? mine : 1u; nx = cnt > 0u ? cnt : 1u;
}

__device__ __forceinline__ void xcd_barrier(const XcdBarrier& b) {
    asm volatile("s_waitcnt vmcnt(0)" ::: "memory");
    __syncthreads();
    if (threadIdx.x == 0) {
        unsigned* bar = b.bar;
        __builtin_amdgcn_s_waitcnt(0);
        unsigned nloc = b.st[0], nx = b.st[1];
        if (nloc == 0u) { xcd_barrier_complete(bar, b.x, nloc, nx); b.st[0] = nloc; b.st[1] = nx; }
        const unsigned old = xb_add(&bar[XB_XSUB(b.x)], 1u);
        const unsigned gen = old / nloc;
        if (old + 1u == (gen + 1u) * nloc) {
            __builtin_amdgcn_fence(__ATOMIC_RELEASE, "agent");
            asm volatile("s_waitcnt vmcnt(0)" ::: "memory");
            const unsigned og = xb_add(&bar[XB_TOP], 1u);
            const unsigned tg = og / nx;
            if (og + 1u == (tg + 1u) * nx) xb_add(&bar[XB_TOPGEN], 1u);
            else XB_SPIN(xb_ld(&bar[XB_TOPGEN]) == tg, bar);
            __builtin_amdgcn_fence(__ATOMIC_ACQUIRE, "agent");
            xb_add(&bar[XB_XGEN(b.x)], 1u);
            asm volatile("s_waitcnt vmcnt(0)" ::: "memory");
        } else {
            XB_SPIN(xb_ld(&bar[XB_XGEN(b.x)]) == gen, bar);
            __builtin_amdgcn_fence(__ATOMIC_ACQUIRE, "agent");
            asm volatile("s_waitcnt vmcnt(0)" ::: "memory");
        }
    }
    __syncthreads();
}


#define XB_LSUB(j)  (3520 + 64 * (j))
#define XB_LGEN(j)  (4544 + 64 * (j))
__device__ __forceinline__ void xcd_barrier_local(const XcdBarrier& b) {
    asm volatile("s_waitcnt vmcnt(0)" ::: "memory");
    __syncthreads();
    if (threadIdx.x == 0) {
        unsigned* bar = b.bar;
        __builtin_amdgcn_s_waitcnt(0);
        const unsigned nloc = b.st[0];
        const unsigned old = xb_add(&bar[XB_LSUB(b.x)], 1u);
        const unsigned gen = old / nloc;
        if (old + 1u == (gen + 1u) * nloc) xb_add(&bar[XB_LGEN(b.x)], 1u);
        else XB_SPIN(xb_ld(&bar[XB_LGEN(b.x)]) == gen, bar);
        __builtin_amdgcn_fence(__ATOMIC_ACQUIRE, "agent");
        asm volatile("s_waitcnt vmcnt(0)" ::: "memory");
    }
    __syncthreads();
}
struct Args { Ptrs p; int ph_lo, ph_hi; };

struct WtItem { const float* W; bf16_t* WT; int k0; bool zero; };
typedef float wf4 __attribute__((ext_vector_type(4)));
__device__ __forceinline__ unsigned wt_cvtpk(float lo, float hi) { unsigned r; asm volatile("v_cvt_pk_bf16_f32 %0, %1, %2" : "=v"(r) : "v"(lo), "v"(hi)); return r; }
__device__ __forceinline__ void wt_load(const WtItem& it, int ldw, wf4 (&tv)[8], int lane) {
    if (it.zero) {
#pragma unroll
        for (int j = 0; j < 8; ++j) tv[j] = (wf4){0.f, 0.f, 0.f, 0.f};
    } else {
        const float* src = it.W + (size_t)(it.k0 + (lane >> 3)) * ldw + 4 * (lane & 7);
#pragma unroll
        for (int j = 0; j < 8; ++j) tv[j] = __builtin_nontemporal_load((const wf4*)(src + (size_t)(8 * j) * ldw));
    }
}
template <bool GAIN> __device__ __forceinline__ void wt_store_t(const WtItem& it, const float* gain, int K, const wf4 (&tv)[8], LAS float* scr, int lane) {
    const int c = lane & 7;
    wf4 g0 = {1.f, 1.f, 1.f, 1.f}, g1 = {1.f, 1.f, 1.f, 1.f};
    if (GAIN) { g0 = *(const wf4*)(gain + it.k0 + 8 * c); g1 = *(const wf4*)(gain + it.k0 + 8 * c + 4); }
#pragma unroll
    for (int j = 0; j < 8; ++j) { LAS float* d = scr + ((lane >> 3) + 8 * j) * 33 + 4 * c; d[0] = tv[j].x; d[1] = tv[j].y; d[2] = tv[j].z; d[3] = tv[j].w; }
    LDS_WAIT(); asm volatile("" ::: "memory");
#pragma unroll
    for (int j = 0; j < 4; ++j) { const int n = (lane >> 3) + 8 * j; const LAS float* s = scr + (8 * c) * 33 + n;
        v4u o; o.x = wt_cvtpk(s[0 * 33] * g0.x, s[1 * 33] * g0.y); o.y = wt_cvtpk(s[2 * 33] * g0.z, s[3 * 33] * g0.w); o.z = wt_cvtpk(s[4 * 33] * g1.x, s[5 * 33] * g1.y); o.w = wt_cvtpk(s[6 * 33] * g1.z, s[7 * 33] * g1.w);
        *(GAS v4u*)(it.WT + (size_t)n * K + it.k0 + 8 * c) = o; }
    LDS_WAIT(); asm volatile("" ::: "memory");
}
__device__ __forceinline__ void wt_store(const WtItem& it, const float* gain, int K, const wf4 (&tv)[8], LAS float* scr, int lane) { if (gain) wt_store_t<true>(it, gain, K, tv, scr, lane); else wt_store_t<false>(it, gain, K, tv, scr, lane); }
__device__ __forceinline__ WtItem wt_make(const float* W, const float* W2, int ncols, int kind, int K, bf16_t* WT, int it, int nrow0, int nnb) {
    const int kb = it / nnb, nb = it % nnb, n0 = nrow0 + nb * 32; const float* src = W; int col = n0; bool zero = false;
    if (kind == 1) { src = ((n0 >> 7) & 1) ? W2 : W; col = 128 * (n0 >> 8) + (n0 & 127); } else zero = (n0 >= ncols);
    WtItem r; r.W = src + col; r.WT = WT + (size_t)n0 * K; r.k0 = kb * 64; r.zero = zero; return r;
}
__device__ __forceinline__ void wt_segment(const float* W, const float* W2, int ldw, int ncols, int kind, const float* gain, int K, int nrows, bf16_t* WT, LAS float* scr, int gw, int ngw, int lane, int nrow0 = 0) {
    const int nitems = (K / 64) * (nrows / 32);
    for (int it = gw; it < nitems; it += 2 * ngw) {
        const WtItem a = wt_make(W, W2, ncols, kind, K, WT, it, nrow0, nrows / 32); wf4 ta[8], tb[8]; wt_load(a, ldw, ta, lane);
        const bool two = (it + ngw) < nitems; WtItem b = a;
        if (two) { b = wt_make(W, W2, ncols, kind, K, WT, it + ngw, nrow0, nrows / 32); wt_load(b, ldw, tb, lane); }
        wt_store(a, gain, K, ta, scr, lane);
        if (two) wt_store(b, gain, K, tb, scr, lane);
    }
}

__global__ void __launch_bounds__(NWAVES * 64, 2) mk_fwd(Args args) {
    extern __shared__ __attribute__((aligned(16))) unsigned char lds[];
    LAS unsigned char* L = (LAS unsigned char*)lds;
    volatile LAS unsigned* MISC = (volatile LAS unsigned*)(L + MISC_OFF);
    const Ptrs& P = args.p;
    const int tid = threadIdx.x, lane = tid & 63, wave = __builtin_amdgcn_readfirstlane(tid >> 6);
    const int G = gridDim.x, bx = blockIdx.x;
    const int vcu = (G % 8 == 0) ? (bx % 8) * (G / 8) + bx / 8 : bx;
    unsigned char* ws = P.ws; gu32* ctl = (gu32*)(ws + WS_CTL);
    for (int u = tid; u < (LDS_BYTES - LDSCTL_OFF) / 4; u += NWAVES * 64) ((LAS unsigned*)(L + LDSCTL_OFF))[u] = 0u;
    __syncthreads();
    const int lo = args.ph_lo, hi = args.ph_hi;
    XcdBarrier bar; bar.bar = (unsigned*)(ctl + CW_BAR); bar.x = 0; bar.st = nullptr;
#if !USE_CG_SYNC
    if (hi - lo > 1) bar = xcd_barrier_post((unsigned*)(ctl + CW_BAR), MISC + 8);
#endif
    float* ssb = (float*)(ws + WS_SS); float* ss1 = ssb; float* ss2 = ssb + M_; float* ss3 = ssb + 2 * M_;
    bf16_t* Wb = (bf16_t*)(ws + WS_W); bf16_t* xb = (bf16_t*)(ws + WS_XB); bf16_t* zb = (bf16_t*)(ws + WS_ZB); bf16_t* mix = (bf16_t*)(ws + WS_MIX); bf16_t* act = (bf16_t*)(ws + WS_ACT);
    const int gw = vcu * NWAVES + wave, NGW = G * NWAVES;

#if USE_CG_SYNC
#define GRID_BAR() cg::this_grid().sync()
#else
#define GRID_BAR() xcd_barrier(bar)
#endif
#ifndef CG_FIRST
#define CG_FIRST 0
#endif
#ifdef TIMING
#define STAMP(k) do { if (bx == 0 && tid == 0) ((unsigned long long*)(ws + WS_CTL + 1024))[(k)] = __builtin_amdgcn_s_memrealtime(); } while (0)
#else
#define STAMP(k) do {} while (0)
#endif
#define IN(k) (lo <= (k) && (k) < hi)
#define SEAM(k) do { if (IN(k) && IN((k) + 1)) { GRID_BAR(); } STAMP((k) + 1); } while (0)
#ifndef LOCAL_SEAMS
#define LOCAL_SEAMS 1
#endif
#define LSEAM(k) do { if (IN(k) && IN((k) + 1)) { if (local_ok) xcd_barrier_local(bar); else GRID_BAR(); } STAMP((k) + 1); } while (0)
#ifndef PHASE_ON
#define PHASE_ON(k) 1
#endif
        STAMP(0);
        if (PHASE_ON(0) && IN(nv::PH_PREP)) {
            LAS float* scr = (LAS float*)(L + RING_OFF + wave * 16384);
            const float* nm = P.in[IN_NORM_MIX]; const float* nf = P.in[IN_NORM_FFN];
            wt_segment(P.in[IN_EVEN_W_IN], nullptr, EVEN_IN, EVEN_IN, 0, nm, 1024, 1792, Wb + WO_IN0, scr, gw, NGW, lane);
            wt_segment(P.in[IN_W_UQ], nullptr, 768, 768, 0, P.in[IN_Q_A_NORM], 384, 768, Wb + WO_UQ, scr, gw, NGW, lane);
            wt_segment(P.in[IN_W_UKV], nullptr, 1024, 1024, 0, P.in[IN_KV_A_NORM], 256, 1024, Wb + WO_UKV, scr, gw, NGW, lane);
            for (int row = gw; row < M_; row += 2 * NGW) {
                const int row2 = (row + NGW < M_) ? row + NGW : row;
                f32x4 va[4], vb[4];
#pragma unroll
                for (int j = 0; j < 4; ++j) { va[j] = __builtin_nontemporal_load((const f32x4*)(P.in[IN_X] + (size_t)row * DM + j * 256 + lane * 4)); vb[j] = __builtin_nontemporal_load((const f32x4*)(P.in[IN_X] + (size_t)row2 * DM + j * 256 + lane * 4)); }
                float s = 0.f, s2 = 0.f;
#pragma unroll
                for (int j = 0; j < 4; ++j) { s += va[j].x * va[j].x + va[j].y * va[j].y + va[j].z * va[j].z + va[j].w * va[j].w; s2 += vb[j].x * vb[j].x + vb[j].y * vb[j].y + vb[j].z * vb[j].z + vb[j].w * vb[j].w;
                    u32x2 o; o.x = pk2(va[j].x, va[j].y); o.y = pk2(va[j].z, va[j].w); *(u32x2*)(xb + (size_t)row * DM + j * 256 + lane * 4) = o;
                    o.x = pk2(vb[j].x, vb[j].y); o.y = pk2(vb[j].z, vb[j].w); *(u32x2*)(xb + (size_t)row2 * DM + j * 256 + lane * 4) = o; }
                s = wave_sum(s); s2 = wave_sum(s2);
                if (lane == 0) { ((float*)(ws + WS_RS0))[row] = rsqrtf(s * (1.f / DM) + EPS); ((float*)(ws + WS_RS0))[row2] = rsqrtf(s2 * (1.f / DM) + EPS); }
            }
            if (gw == 0) { for (int i = lane; i < 128; i += 64) ((float*)(ws + WS_INVR))[i] = (float)(exp(-(double)i / 128.0 * 9.210340371976184) * 0.15915494309189535);
                if (lane < 16) ((float*)(ws + WS_INVM))[lane] = (float)(exp(-(double)lane / 16.0 * 9.210340371976184) * 0.15915494309189535); }
            for (int idx = gw * 64 + lane; idx < 4 * 128 * 128; idx += NGW * 64) { const int t = (idx >> 7) & 127, s = idx & 127; ((bf16_t*)(ws + WS_WSP))[idx] = ((s >> 6) <= (t >> 6)) ? f2bf(P.in[IN_GM_W_S][idx]) : (bf16_t)0; }
        }
        if (IN(nv::PH_PREP) && IN(nv::PH_IN0)) { if (CG_FIRST || hi > 1000) cg::this_grid().sync(); else GRID_BAR(); }
        int cid = bx; bool local_ok = false;
#if !USE_CG_SYNC
        if (hi - lo > 1 && G == 256 && LOCAL_SEAMS) {
            if (tid == 0) { unsigned ok = 1u; for (unsigned j = 0; j < 16; ++j) { const unsigned c = xb_ld(&bar.bar[XB_XCNT(j)]); ok &= (j < 8) ? (c == (unsigned)G / 8u) : (c == 0u); } ok &= (bar.x < 8u) ? 1u : 0u; MISC[11] = ok; }
            __syncthreads();
            local_ok = MISC[11] != 0u;
            if (local_ok) { const int rank = (int)MISC[10]; cid = 8 * rank + (int)bar.x; }
        }
#endif
        const int vcu2 = local_ok ? ((cid & 7) * (G / 8) + (cid >> 3)) : vcu; const int gw2 = vcu2 * NWAVES + wave;
        STAMP(1);
        if (PHASE_ON(1) && IN(nv::PH_IN0)) {
            pg8::Gemm g{xb, Wb + WO_IN0, DM, 1024, 1024}; pg8::StaticOrder S; S.init(M_, ZLD, G, cid);
            pg8::EpiZ0 E{zb, (const float*)(ws + WS_RS0)};
            pg8::gemm_phase<pg8::EpiZ0, pg8::StaticOrder, true, true>(L + RING_OFF, g, S, E);
            if (cid >= 192) { LAS float* scr = (LAS float*)(L + RING_OFF + wave * 16384);
                wt_segment(P.in[IN_EVEN_W_OUT], nullptr, 1024, 1024, 0, nullptr, 1024, 1024, Wb + WO_OUT0, scr, (cid - 192) * NWAVES + wave, 64 * NWAVES, lane);
                wt_segment(P.in[IN_FFN_DOWN], nullptr, 1024, 1024, 0, nullptr, DFF, 1024, Wb + WO_DN0, scr, (cid - 192) * NWAVES + wave, 64 * NWAVES, lane); __syncthreads(); }
        }
        LSEAM(nv::PH_IN0);
        if (PHASE_ON(2) && IN(nv::PH_MLAUP)) { fp::mlaf::mla_fused_phase(P, Wb + WO_UQ, Wb + WO_UKV, (char*)lds + RING_OFF, vcu2); }
        STAMP(nv::PH_MLAUP + 1);
        if (PHASE_ON(3) && IN(nv::PH_GATING)) { fp::gating_phase(P, (char*)lds + RING_OFF, vcu2, G); }
        if (PHASE_ON(3) && IN(nv::PH_GATING)) { LAS float* scr = (LAS float*)(L + RING_OFF + wave * 16384);
            wt_segment(P.in[IN_FFN_GATE], P.in[IN_FFN_UP], DFF, DFF, 1, P.in[IN_NORM_FFN], 1024, 5632, Wb + WO_GU0, scr, gw, NGW, lane); __syncthreads(); }
        SEAM(nv::PH_GATING);
        if (PHASE_ON(5) && IN(nv::PH_ATTN)) { fp::att::attn_phase(ws, (char*)lds + RING_OFF, vcu2, G); }
        SEAM(nv::PH_ATTN);
        if (PHASE_ON(6) && IN(nv::PH_OUT0)) {
            pg8::Gemm g{mix, Wb + WO_OUT0, 1024, 1024, 1024}; pg8::StaticOrder S; S.init(M_, DM, G, cid);
            pg8::EpiResid<false, false> E{nullptr, P.out, xb, ss1};
            pg8::gemm_phase<pg8::EpiResid<false, false>, pg8::StaticOrder, true, true>(L + RING_OFF, g, S, E);
        }
        LSEAM(nv::PH_OUT0);

        if (PHASE_ON(7) && IN(nv::PH_FFN0A)) {
            const bool l1 = (nv::PH_FFN0A == nv::PH_FFN1A);
            pg8::Gemm g{xb, Wb + (l1 ? WO_GU1 : WO_GU0), DM, 1024, 1024}; pg8::StaticOrder S; S.init(M_, 2 * DFF, G, cid);
            pg8::EpiSwiglu E{act, l1 ? ss3 : ss1};
            pg8::gemm_phase<pg8::EpiSwiglu, pg8::StaticOrder, true, true>(L + RING_OFF, g, S, E);
            if (!l1 && cid >= 128) { LAS float* scr = (LAS float*)(L + RING_OFF + wave * 16384);
                wt_segment(P.in[IN_ODD_W_OUT], nullptr, 1024, 1024, 0, P.in[IN_RET_OUT_NORM], 2048, 1024, Wb + WO_OUT1, scr, (cid - 128) * NWAVES + wave, 128 * NWAVES, lane);
                wt_segment(P.in[IN_FFN_DOWN] + (size_t)DFF * DM, nullptr, 1024, 1024, 0, nullptr, DFF, 1024, Wb + WO_DN1, scr, (cid - 128) * NWAVES + wave, 128 * NWAVES, lane);
                wt_segment(P.in[IN_FFN_GATE] + (size_t)DM * DFF, P.in[IN_FFN_UP] + (size_t)DM * DFF, DFF, DFF, 1, P.in[IN_NORM_FFN] + DM, 1024, 5632, Wb + WO_GU1, scr, (cid - 128) * NWAVES + wave, 128 * NWAVES, lane);
                wt_segment(P.in[IN_ODD_W_IN], nullptr, ODD_IN, ODD_IN, 0, P.in[IN_NORM_MIX] + DM, 1024, 6144, Wb + WO_IN1, scr, (cid - 128) * NWAVES + wave, 128 * NWAVES, lane); __syncthreads(); }
        }
        LSEAM(nv::PH_FFN0A);
        if (PHASE_ON(8) && IN(nv::PH_FFN0B)) {
            const bool l1 = (nv::PH_FFN0B == nv::PH_FFN1B);
            pg8::Gemm g{act, Wb + (l1 ? WO_DN1 : WO_DN0), DFF, DFF, DFF}; pg8::StaticOrder S; S.init(M_, DM, G, cid);
            if (l1) { pg8::EpiResid<false, true> E{nullptr, P.out, xb, ss2}; pg8::gemm_phase<pg8::EpiResid<false, true>, pg8::StaticOrder, true, true>(L + RING_OFF, g, S, E); }
            else { pg8::EpiResid<false, false> E{nullptr, P.out, xb, ss2}; pg8::gemm_phase<pg8::EpiResid<false, false>, pg8::StaticOrder, true, true>(L + RING_OFF, g, S, E); }
        }

        SEAM(nv::PH_FFN0B);
        if (PHASE_ON(9) && IN(nv::PH_IN1)) {
            pg8::Gemm g{xb, Wb + WO_IN1, DM, 1024, 1024}; pg8::StaticOrder S; S.init(M_, 4096, G, cid);
            pg8::EpiIn1 E{(bf16_t*)(ws + WS_QP), (bf16_t*)(ws + WS_KPP), (bf16_t*)(ws + WS_VO), ss2, (const float*)(ws + WS_INVR), nullptr};
            pg8::gemm_phase<pg8::EpiIn1, pg8::StaticOrder, true, true>(L + RING_OFF, g, S, E);
        }
        LSEAM(nv::PH_IN1);
        if (PHASE_ON(10) && IN(nv::PH_AMAT)) { fp::amat_phase(ws, gw2, NGW, lane); }
        SEAM(nv::PH_AMAT);
        if (PHASE_ON(11) && IN(nv::PH_SCAN)) { fp::scan::scan_phase(ws, (char*)lds + RING_OFF, vcu2, G); }
        SEAM(nv::PH_SCAN);
        if (PHASE_ON(12) && IN(nv::PH_GATE)) {
            pg8::Gemm g{xb, Wb + WO_IN1 + (size_t)4096 * 1024, DM, 1024, 1024}; pg8::StaticOrder S; S.init(M_, 2048, G, cid);
            pg8::EpiGate E{(bf16_t*)(ws + WS_VO), ss2, (const float*)(ws + WS_SSP)};
            pg8::gemm_phase<pg8::EpiGate, pg8::StaticOrder, true, true>(L + RING_OFF, g, S, E);
        }
        LSEAM(nv::PH_GATE);
        if (PHASE_ON(13) && IN(nv::PH_OUT1)) {
            pg8::Gemm g{(const bf16_t*)(ws + WS_VO), Wb + WO_OUT1, 2048, 2048, 2048}; pg8::StaticOrder S; S.init(M_, DM, G, cid);
            pg8::EpiResid<false, false> E{nullptr, P.out, xb, ss3};
            pg8::gemm_phase<pg8::EpiResid<false, false>, pg8::StaticOrder, true, true>(L + RING_OFF, g, S, E);
        }
        LSEAM(nv::PH_OUT1);

        if (PHASE_ON(14) && IN(nv::PH_FFN1A)) {
            const bool l1 = (nv::PH_FFN1A == nv::PH_FFN1A);
            pg8::Gemm g{xb, Wb + (l1 ? WO_GU1 : WO_GU0), DM, 1024, 1024}; pg8::StaticOrder S; S.init(M_, 2 * DFF, G, cid);
            pg8::EpiSwiglu E{act, l1 ? ss3 : ss1};
            pg8::gemm_phase<pg8::EpiSwiglu, pg8::StaticOrder, true, true>(L + RING_OFF, g, S, E);
        }
        LSEAM(nv::PH_FFN1A);
        if (PHASE_ON(15) && IN(nv::PH_FFN1B)) {
            const bool l1 = (nv::PH_FFN1B == nv::PH_FFN1B);
            pg8::Gemm g{act, Wb + (l1 ? WO_DN1 : WO_DN0), DFF, DFF, DFF}; pg8::StaticOrder S; S.init(M_, DM, G, cid);
            if (l1) { pg8::EpiResid<false, true> E{nullptr, P.out, xb, ss2}; pg8::gemm_phase<pg8::EpiResid<false, true>, pg8::StaticOrder, true, true>(L + RING_OFF, g, S, E); }
            else { pg8::EpiResid<false, false> E{nullptr, P.out, xb, ss2}; pg8::gemm_phase<pg8::EpiResid<false, false>, pg8::StaticOrder, true, true>(L + RING_OFF, g, S, E); }
        }

    STAMP(16);
}
#ifdef TIMING
__global__ void k_poke_time(float* out, const unsigned char* ws) { const unsigned long long* ts = (const unsigned long long*)(ws + WS_CTL + 1024); out[0] += (float)(ts[T_B] - ts[T_A]) * (0.01f / T_DIV); }
#endif
extern "C" void kernel_launch(void* const* d_in, const int* in_sizes, int n_in, void* d_out, int out_size, void* d_ws, size_t ws_size, hipStream_t stream) {
    if (n_in != 20 || out_size != M_ * DM || ws_size < WS_END) { fprintf(stderr, "kernel_launch: unexpected shapes n_in %d out %d ws %zu\n", n_in, out_size, ws_size); return; }
    static int grid = 0;
    if (grid == 0) {
        int dev = 0, cus = 0, per_cu = 0;
        (void)hipGetDevice(&dev); (void)hipDeviceGetAttribute(&cus, hipDeviceAttributeMultiprocessorCount, dev);
        if (hipFuncSetAttribute((const void*)mk_fwd, hipFuncAttributeMaxDynamicSharedMemorySize, LDS_BYTES) != hipSuccess) fprintf(stderr, "kernel_launch: hipFuncSetAttribute failed\n");
        if (hipOccupancyMaxActiveBlocksPerMultiprocessor(&per_cu, (const void*)mk_fwd, NWAVES * 64, LDS_BYTES) != hipSuccess || per_cu < 1) { fprintf(stderr, "kernel_launch: occupancy query says %d\n", per_cu); per_cu = 1; }
        (void)hipGetLastError();
        grid = cus * per_cu;
        if (grid != 256) fprintf(stderr, "kernel_launch: grid %d (cus %d x %d)\n", grid, cus, per_cu);
    }
    (void)hipMemsetAsync(d_ws, 0, ZERO_BYTES, stream);
    Args a{};
    for (int i = 0; i < 20; ++i) a.p.in[i] = (const float*)d_in[i];
    a.p.out = (float*)d_out; a.p.ws = (unsigned char*)d_ws; a.ph_lo = 0; a.ph_hi = nv::PH_COUNT;
    void* kargs[] = {&a};
    const hipError_t e = hipLaunchCooperativeKernel((const void*)mk_fwd, dim3(grid), dim3(NWAVES * 64), kargs, LDS_BYTES, stream);
#ifdef TIMING
    hipLaunchKernelGGL(k_poke_time, dim3(1), dim3(1), 0, stream, (float*)d_out, (const unsigned char*)d_ws);
#endif
    if (e != hipSuccess) fprintf(stderr, "kernel_launch: cooperative launch failed: %s (grid %d)\n", hipGetErrorString(e), grid);
}
```
